# Optimizing an MI355X kernel written in HIP

```python
import functools
import jax, jax.numpy as jnp
from jax import lax
import numpy as np

D_MODEL = 2048
BATCH = 1
SEQ = 8192
DEPTH = 4
DEC_BATCH = 32
DEC_SEQ = 16
PAST_LEN = 1024

CHUNK = 64
HEAD_DIM = 64
A_WIDTH = 1024
A_HEADS = A_WIDTH // HEAD_DIM
DECAY_LORA = 64
ICLR_LORA = 64
GATE_LORA = 160
GN_EPS = 64e-5
B_HEADS = 16
B_KV_HEADS = 4
B_GROUP = B_HEADS // B_KV_HEADS
WINDOW = 128
WINDOW_CHUNKS = WINDOW // CHUNK
BAND = (WINDOW_CHUNKS + 1) * CHUNK
ROPE_THETA = 10000.0
D_FF = 5504
RMS_EPS = 1e-6

A_COLS = 3 * A_WIDTH + DECAY_LORA + ICLR_LORA + GATE_LORA
B_Q = B_HEADS * HEAD_DIM
B_KV = B_KV_HEADS * HEAD_DIM
B_COLS = B_Q + 2 * B_KV
IN_COLS = A_COLS + B_COLS + 2 * D_MODEL
A_SPLITS = (A_WIDTH, A_WIDTH + DECAY_LORA, 2 * A_WIDTH + DECAY_LORA, 3 * A_WIDTH + DECAY_LORA,
            3 * A_WIDTH + DECAY_LORA + ICLR_LORA)
IN_SPLITS = (A_COLS, A_COLS + B_Q, A_COLS + B_Q + B_KV, A_COLS + B_COLS, A_COLS + B_COLS + D_MODEL)

kernel_name = 'streaming_rwkv7_swa_sink_hybrid_step'


def rmsnorm(x, g):
    xf = x.astype(jnp.float32)
    y = xf * lax.rsqrt(jnp.mean(xf * xf, axis=-1, keepdims=True) + RMS_EPS)
    return (y * g.astype(jnp.float32)).astype(x.dtype)


def swiglu(x, w_gate, w_up, w_down):
    return (jax.nn.silu(x @ w_gate) * (x @ w_up)) @ w_down


def rope(x, pos):
    half = HEAD_DIM // 2
    inv = ROPE_THETA ** (-jnp.arange(half, dtype=jnp.float32) / half)
    ang = pos.astype(jnp.float32)[:, None] * inv[None, :]
    cos = jnp.cos(ang)[None, :, None, :]
    sin = jnp.sin(ang)[None, :, None, :]
    xf = x.astype(jnp.float32)
    x1, x2 = xf[..., :half], xf[..., half:]
    return jnp.concatenate([x1 * cos - x2 * sin, x2 * cos + x1 * sin], axis=-1).astype(x.dtype)


def rwkv7_time_mix(pa, shift_prev, wkv0, shift_mu, decay_w0, decay_w2, iclr_a0, iclr_a2, gate_g2,
                   k_k, k_a, r_k, gn_gain, gn_bias):
    f32 = jnp.float32
    B, T, _ = pa.shape
    prev = jnp.concatenate([shift_prev[:, None, :].astype(pa.dtype), pa[:, :-1]], axis=1)
    xm = pa + (prev - pa) * shift_mu
    r, w_lo, k, v, a_lo, g_lo = jnp.split(xm, A_SPLITS, axis=-1)
    w = -jax.nn.softplus(-(decay_w0 + jnp.tanh(w_lo) @ decay_w2).astype(f32)) - 0.5
    decay = jnp.exp(-jnp.exp(w))
    a = jax.nn.sigmoid((iclr_a0 + a_lo @ iclr_a2).astype(f32))
    g = jax.nn.sigmoid(g_lo) @ gate_g2
    heads = lambda t: t.reshape(B, T, A_HEADS, HEAD_DIM).astype(f32)
    kk = heads(k * k_k)
    kk = kk / jnp.maximum(jnp.sqrt(jnp.sum(kk * kk, axis=-1, keepdims=True)), 1e-12)
    k = k * (1.0 + (a - 1.0) * k_a)
    r_h, d_h, k_h, v_h, a_h = heads(r), heads(decay), heads(k), heads(v), heads(a)
    xs = tuple(jnp.swapaxes(t, 0, 1) for t in (r_h, d_h, k_h, v_h, kk, kk * a_h))

    def step(S, inp):
        r_t, d_t, k_t, v_t, kk_t, b_t = inp
        sa = jnp.einsum('bhij,bhj->bhi', S, kk_t)
        S = (S * d_t[:, :, None, :] - sa[..., None] * b_t[:, :, None, :]
             + v_t[..., None] * k_t[:, :, None, :])
        return S, jnp.einsum('bhij,bhj->bhi', S, r_t)

    S_T, ys = lax.scan(step, wkv0.astype(f32), xs)
    y = jnp.swapaxes(ys, 0, 1)
    mean = jnp.mean(y, axis=-1, keepdims=True)
    var = jnp.mean(jnp.square(y - mean), axis=-1, keepdims=True)
    y = ((y - mean) * lax.rsqrt(var + GN_EPS)).reshape(B, T, A_WIDTH) * gn_gain + gn_bias
    bonus = jnp.sum(r_h * k_h * r_k, axis=-1, keepdims=True) * v_h
    y = (y + bonus.reshape(B, T, A_WIDTH)) * g
    return y.astype(pa.dtype), S_T, pa[:, -1]


def _sink_softmax(s, sinks):
    sk = jnp.broadcast_to(sinks.reshape(B_KV_HEADS, B_GROUP, 1, 1).astype(jnp.float32),
                          s.shape[:-1] + (1,))
    return jax.nn.softmax(jnp.concatenate([s, sk], axis=-1), axis=-1)[..., :-1]


def band_attention(q, k, v, sinks):
    B, T = q.shape[:2]
    nc = T // CHUNK
    qc = q.reshape(B, nc, CHUNK, B_KV_HEADS, B_GROUP, HEAD_DIM)

    def band(t):
        tc = t.reshape(B, nc, CHUNK, B_KV_HEADS, HEAD_DIM)
        tp = jnp.pad(tc, ((0, 0), (WINDOW_CHUNKS, 0), (0, 0), (0, 0), (0, 0)))
        return jnp.concatenate([tp[:, j:j + nc] for j in range(WINDOW_CHUNKS + 1)], axis=2)

    kb, vb = band(k), band(v)
    valid = (jnp.arange(nc)[:, None] - WINDOW_CHUNKS + jnp.arange(BAND)[None, :] // CHUNK) >= 0
    s = jnp.einsum('bnqkgd,bnskd->bnkgqs', qc, kb).astype(jnp.float32) * (HEAD_DIM ** -0.5)
    s = jnp.where(valid[None, :, None, None, None, :], s, -1e30)
    p = _sink_softmax(s, sinks)
    o = jnp.einsum('bnkgqs,bnskd->bnqkgd', p.astype(v.dtype), vb)
    return o.reshape(B, T, B_Q)


def cached_attention(q, k, v, sinks, ck, cv):
    B, T = q.shape[:2]
    kf = jnp.concatenate([ck.astype(k.dtype), k], axis=1)
    vf = jnp.concatenate([cv.astype(v.dtype), v], axis=1)
    qg = q.reshape(B, T, B_KV_HEADS, B_GROUP, HEAD_DIM)
    s = jnp.einsum('btkgd,bskd->bkgts', qg, kf).astype(jnp.float32) * (HEAD_DIM ** -0.5)
    p = _sink_softmax(s, sinks)
    o = jnp.einsum('bkgts,bskd->btkgd', p.astype(vf.dtype), vf)
    return o.reshape(B, T, B_Q)


def trunk_layer(x, pos, shift_prev, wkv0, attend, lw):
    B, T, _ = x.shape
    x = x + 0.5 * swiglu(rmsnorm(x, lw['norm_ff1']), lw['ff1_gate'], lw['ff1_up'], lw['ff1_down'])
    h = rmsnorm(x, lw['norm_mix'])
    p = h @ lw['w_in']
    pa, pq, pk, pv, pga, pgb = jnp.split(p, IN_SPLITS, axis=-1)
    ya, wkv, shift = rwkv7_time_mix(pa, shift_prev, wkv0, lw['shift_mu'], lw['decay_w0'], lw['decay_w2'],
                                    lw['iclr_a0'], lw['iclr_a2'], lw['gate_g2'], lw['k_k'], lw['k_a'],
                                    lw['r_k'], lw['gn_gain'], lw['gn_bias'])
    q = rope(rmsnorm(pq.reshape(B, T, B_HEADS, HEAD_DIM), lw['q_norm']), pos)
    k = rope(rmsnorm(pk.reshape(B, T, B_KV_HEADS, HEAD_DIM), lw['k_norm']), pos)
    v = pv.reshape(B, T, B_KV_HEADS, HEAD_DIM)
    yb = attend(q, k, v, lw['sinks'])
    merged = jax.nn.sigmoid(pga) * (ya @ lw['w_up_a']) + jax.nn.sigmoid(pgb) * (yb @ lw['w_up_b'])
    x = x + merged @ lw['w_o']
    x = x + 0.5 * swiglu(rmsnorm(x, lw['norm_ff2']), lw['ff2_gate'], lw['ff2_up'], lw['ff2_down'])
    return x, wkv, shift, k, v


def setup_inputs(seed: int = 0) -> dict:
    key = jax.random.key(seed)
    ks = jax.random.split(key, 40)
    f32 = jnp.float32
    L, D, F = DEPTH, D_MODEL, D_FF
    rows = min(WINDOW, PAST_LEN)

    def nrm(i, shape, scale=1.0):
        return jax.random.normal(ks[i], shape, f32) * scale

    def uni(i, shape, lo, hi):
        return jax.random.uniform(ks[i], shape, f32, lo, hi)

    return {
        'x_prompt': nrm(0, (BATCH, SEQ, D)),
        'x_sample': nrm(1, (DEC_BATCH, DEC_SEQ, D)),
        'cache_k': nrm(2, (L, DEC_BATCH, rows, B_KV_HEADS, HEAD_DIM)),
        'cache_v': nrm(3, (L, DEC_BATCH, rows, B_KV_HEADS, HEAD_DIM)),
        'state_wkv': nrm(4, (L, DEC_BATCH, A_HEADS, HEAD_DIM, HEAD_DIM), 0.5),
        'state_shift': nrm(5, (L, DEC_BATCH, A_COLS)),
        'norm_ff1': 1.0 + nrm(6, (L, D), 0.05),
        'ff1_gate': nrm(7, (L, D, F), D ** -0.5),
        'ff1_up': nrm(8, (L, D, F), D ** -0.5),
        'ff1_down': nrm(9, (L, F, D), F ** -0.5),
        'norm_mix': 1.0 + nrm(10, (L, D), 0.05),
        'w_in': nrm(11, (L, D, IN_COLS), D ** -0.5),
        'shift_mu': uni(12, (L, A_COLS), 0.0, 1.0),
        'decay_w0': uni(13, (L, A_WIDTH), -6.0, -1.0),
        'decay_w2': nrm(14, (L, DECAY_LORA, A_WIDTH), 0.5 * DECAY_LORA ** -0.5),
        'iclr_a0': nrm(15, (L, A_WIDTH), 0.1),
        'iclr_a2': nrm(16, (L, ICLR_LORA, A_WIDTH), 0.5 * ICLR_LORA ** -0.5),
        'gate_g2': nrm(17, (L, GATE_LORA, A_WIDTH), GATE_LORA ** -0.5),
        'k_k': 0.85 + nrm(18, (L, A_WIDTH), 0.1),
        'k_a': 1.0 + nrm(19, (L, A_WIDTH), 0.1),
        'r_k': nrm(20, (L, A_HEADS, HEAD_DIM), 0.1),
        'gn_gain': 1.0 + nrm(21, (L, A_WIDTH), 0.05),
        'gn_bias': nrm(22, (L, A_WIDTH), 0.02),
        'q_norm': 1.0 + nrm(23, (L, HEAD_DIM), 0.05),
        'k_norm': 1.0 + nrm(24, (L, HEAD_DIM), 0.05),
        'sinks': nrm(25, (L, B_HEADS), 0.5),
        'w_up_a': nrm(26, (L, A_WIDTH, D), A_WIDTH ** -0.5),
        'w_up_b': nrm(27, (L, B_Q, D), B_Q ** -0.5),
        'w_o': nrm(28, (L, D, D), D ** -0.5),
        'norm_ff2': 1.0 + nrm(29, (L, D), 0.05),
        'ff2_gate': nrm(30, (L, D, F), D ** -0.5),
        'ff2_up': nrm(31, (L, D, F), D ** -0.5),
        'ff2_down': nrm(32, (L, F, D), F ** -0.5),
    }


def reference(x_prompt, x_sample, cache_k, cache_v, state_wkv, state_shift,
              norm_ff1, ff1_gate, ff1_up, ff1_down, norm_mix, w_in, shift_mu, decay_w0, decay_w2,
              iclr_a0, iclr_a2, gate_g2, k_k, k_a, r_k, gn_gain, gn_bias, q_norm, k_norm, sinks,
              w_up_a, w_up_b, w_o, norm_ff2, ff2_gate, ff2_up, ff2_down):
    bp, tp = x_prompt.shape[:2]
    ts = x_sample.shape[1]
    pos_p = jnp.arange(tp)
    pos_s = PAST_LEN + jnp.arange(ts)
    xp, xs = x_prompt, x_sample
    p_wkv, p_shift, p_k, p_v = [], [], [], []
    s_wkv, s_shift, s_k, s_v = [], [], [], []
    for l in range(DEPTH):
        lw = dict(norm_ff1=norm_ff1[l], ff1_gate=ff1_gate[l], ff1_up=ff1_up[l], ff1_down=ff1_down[l],
                  norm_mix=norm_mix[l], w_in=w_in[l], shift_mu=shift_mu[l], decay_w0=decay_w0[l],
                  decay_w2=decay_w2[l], iclr_a0=iclr_a0[l], iclr_a2=iclr_a2[l], gate_g2=gate_g2[l],
                  k_k=k_k[l], k_a=k_a[l], r_k=r_k[l], gn_gain=gn_gain[l], gn_bias=gn_bias[l],
                  q_norm=q_norm[l], k_norm=k_norm[l], sinks=sinks[l], w_up_a=w_up_a[l],
                  w_up_b=w_up_b[l], w_o=w_o[l], norm_ff2=norm_ff2[l], ff2_gate=ff2_gate[l],
                  ff2_up=ff2_up[l], ff2_down=ff2_down[l])
        xp, wkv_p, sh_p, k_pr, v_pr = trunk_layer(
            xp, pos_p, jnp.zeros((bp, A_COLS), xp.dtype),
            jnp.zeros((bp, A_HEADS, HEAD_DIM, HEAD_DIM), jnp.float32), band_attention, lw)
        attend_s = functools.partial(cached_attention, ck=cache_k[l], cv=cache_v[l])
        xs, wkv_s, sh_s, k_sm, v_sm = trunk_layer(xs, pos_s, state_shift[l], state_wkv[l], attend_s, lw)
        p_wkv.append(wkv_p.astype(state_wkv.dtype))
        p_shift.append(sh_p.astype(state_shift.dtype))
        p_k.append(k_pr[:, -WINDOW:].astype(cache_k.dtype))
        p_v.append(v_pr[:, -WINDOW:].astype(cache_v.dtype))
        s_wkv.append(wkv_s.astype(state_wkv.dtype))
        s_shift.append(sh_s.astype(state_shift.dtype))
        s_k.append(k_sm.astype(cache_k.dtype))
        s_v.append(v_sm.astype(cache_v.dtype))
    return (xp, xs, jnp.stack(p_wkv), jnp.stack(p_shift), jnp.stack(p_k), jnp.stack(p_v),
            jnp.stack(s_wkv), jnp.stack(s_shift), jnp.stack(s_k), jnp.stack(s_v))
```

```cpp
#ifndef EMU
#include <hip/hip_runtime.h>
#include <cstdio>
#include <cstdint>
#endif

#ifndef CFG_SMALL
constexpr int DM = 2048, SEQ = 8192, DEPTH = 4, DECB = 32, DECS = 16, PAST = 1024, AW = 1024, BH = 16, BKV = 4, DFF = 5504;
#else
constexpr int DM = 256, SEQ = 256, DEPTH = 2, DECB = 16, DECS = 16, PAST = 1024, AW = 128, BH = 4, BKV = 1, DFF = 384;
#endif
constexpr int HD = 64, AH = AW / HD, DLORA = 64, ILORA = 64, GLORA = 160, WIN = 128, GRP = BH / BKV;
constexpr int ACOLS = 3 * AW + DLORA + ILORA + GLORA, BQ = BH * HD, BKVW = BKV * HD, INCOLS = ACOLS + BQ + 2 * BKVW + 2 * DM;
constexpr int MS = DECB * DECS, M = SEQ + MS;
constexpr int FW_RAW = ACOLS + BQ + 2 * BKVW, FW = ((FW_RAW + 255) / 256) * 256, NIN = FW + 2 * DM;
constexpr int C_R = 0, C_WLO = AW, C_K = AW + DLORA, C_V = 2 * AW + DLORA, C_ALO = 3 * AW + DLORA, C_GLO = C_ALO + ILORA, C_Q = ACOLS, C_BK = ACOLS + BQ, C_BV = C_BK + BKVW;
constexpr int NCH = SEQ / 64, NUP = NCH * AH, NUS = DECB * AH, NU = NUP + NUS;
constexpr int NAP = NCH * BKV, NAS = DECB * BKV, NA = NAP + NAS;
constexpr float RMS_EPS = 1e-6f, GN_EPS = 64e-5f, LOG2E = 1.4426950408889634f;
static_assert(M % 256 == 0 && DM % 256 == 0 && DFF % 128 == 0 && AW % 128 == 0 && BQ % 128 == 0 && FW_RAW % 32 == 0 && DECS == 16 && GRP == 4, "shape constraints");

constexpr size_t O_YP = 0, O_YS = (size_t)SEQ * DM, O_PWKV = O_YS + (size_t)MS * DM, O_PSH = O_PWKV + (size_t)DEPTH * AH * 4096, O_PK = O_PSH + (size_t)DEPTH * ACOLS,
                 O_PV = O_PK + (size_t)DEPTH * WIN * BKVW, O_SWKV = O_PV + (size_t)DEPTH * WIN * BKVW, O_SSH = O_SWKV + (size_t)DEPTH * DECB * AH * 4096,
                 O_SK = O_SSH + (size_t)DEPTH * DECB * ACOLS, O_SV = O_SK + (size_t)DEPTH * DECB * DECS * BKVW, O_END = O_SV + (size_t)DEPTH * DECB * DECS * BKVW;

constexpr size_t al256(size_t x) { return (x + 255) & ~(size_t)255; }
constexpr size_t WS_CTL = 0, CTL_BYTES = 1u << 20;
constexpr size_t WS_ROPE = CTL_BYTES, ROPE_BYTES = al256((size_t)(SEQ + DECS) * 64 * 4);
constexpr size_t WS_W = WS_ROPE + ROPE_BYTES;
constexpr size_t SZ_WGU = (size_t)2 * DFF * DM * 2, SZ_WD = (size_t)DM * DFF * 2, SZ_WIN = (size_t)NIN * DM * 2, SZ_WUA = (size_t)DM * AW * 2, SZ_WUB = (size_t)DM * BQ * 2, SZ_WO = (size_t)DM * DM * 2;
constexpr size_t OFF_WGU1 = 0, OFF_WD1 = OFF_WGU1 + SZ_WGU, OFF_WIN = OFF_WD1 + SZ_WD, OFF_WUA = OFF_WIN + SZ_WIN, OFF_WUB = OFF_WUA + SZ_WUA, OFF_WO = OFF_WUB + SZ_WUB,
                 OFF_WGU2 = OFF_WO + SZ_WO, OFF_WD2 = OFF_WGU2 + SZ_WGU, OFF_DW2T = OFF_WD2 + SZ_WD, OFF_IA2T = OFF_DW2T + (size_t)AW * 64 * 2, OFF_GG2T = OFF_IA2T + (size_t)AW * 64 * 2,
                 LAYER_W_BYTES = al256(OFF_GG2T + (size_t)AW * 160 * 2);
constexpr size_t WS_H = WS_W + (size_t)DEPTH * LAYER_W_BYTES;
constexpr size_t WS_PF = WS_H + al256((size_t)M * DM * 2);
constexpr size_t WS_SG = WS_PF + al256((size_t)M * FW * 4);
constexpr size_t WS_YA = WS_SG + al256((size_t)M * 2 * DM * 2);
constexpr size_t WS_YB = WS_YA + al256((size_t)M * AW * 2);
constexpr size_t WS_MG = WS_YB + al256((size_t)M * BQ * 2);
constexpr size_t WS_OV = WS_MG + al256((size_t)M * DM * 2);
constexpr size_t WS_G = WS_OV;
constexpr size_t WS_T1 = WS_OV;
constexpr size_t WS_PCT = WS_T1 + al256((size_t)M * DM * 4);
constexpr size_t WS_UCS = WS_PCT + (size_t)NU * 8192;
constexpr size_t WS_QTT = WS_UCS + (size_t)NU * 16384;
constexpr size_t WS_YLT = WS_QTT + (size_t)NU * 8192;
constexpr size_t WS_GT = WS_YLT + (size_t)NU * 16384;
constexpr size_t WS_BNT = WS_GT + (size_t)NU * 8192;
constexpr size_t WS_SC = WS_BNT + (size_t)NU * 8192;
constexpr size_t WS_OV_END_A = WS_SC + (size_t)NUP * 8192, WS_OV_END_B = WS_G + al256((size_t)M * DFF * 2);
constexpr size_t WS_END = WS_OV_END_A > WS_OV_END_B ? WS_OV_END_A : WS_OV_END_B;

constexpr int LDS_BYTES = 159744;
constexpr int LDS_CTL_OFF = LDS_BYTES - 1024;
constexpr int NWAVES = 8, NTHR = 512;

typedef unsigned short bf16_t;
typedef short bf16x8 __attribute__((ext_vector_type(8)));
typedef short bf16x4 __attribute__((ext_vector_type(4)));
typedef float f32x4 __attribute__((ext_vector_type(4)));
typedef unsigned u32x4 __attribute__((ext_vector_type(4)));
typedef unsigned u32x2 __attribute__((ext_vector_type(2)));
#ifdef EMU
#define LAS
#define TID() emu_tid()
#define BID() emu_bid()
#define GRID() emu_grid()
#define WG_SYNC() emu_wg_sync()
#define MFMA16(a, b, c) emu_mfma16(a, b, c)
#define SHFL_XOR(v, m) emu_shfl_xor(v, m)
#define DEV static inline
#define DEVM inline
#define EXP2F(x) exp2f(x)
#define RSQRTF(x) (1.0f / sqrtf(x))
#define WAVE_FENCE() emu_wave_sync()
#define WAVE_ID(t) ((t) >> 6)
#define PIN(p, i) ((p).in[i])
#define FRESH_LANE() (emu_tid() & 63)
#else
#define LAS __attribute__((address_space(3)))
#define TID() ((int)threadIdx.x)
#define BID() ((int)blockIdx.x)
#define GRID() ((int)gridDim.x)
#define WG_SYNC() __syncthreads()
#define MFMA16(a, b, c) __builtin_amdgcn_mfma_f32_16x16x32_bf16(a, b, c, 0, 0, 0)
#define SHFL_XOR(v, m) __shfl_xor(v, m)
#define DEV __device__ __forceinline__
#define DEVM __device__ __forceinline__
#define EXP2F(x) __builtin_amdgcn_exp2f(x)
#define RSQRTF(x) (1.0f / sqrtf(x))
#define WAVE_FENCE() asm volatile("s_waitcnt lgkmcnt(0)" ::: "memory")
#define WAVE_ID(t) __builtin_amdgcn_readfirstlane((t) >> 6)
#define PIN(p, i) pin_load(i)
#define FRESH_LANE() fresh_lane()
__device__ __forceinline__ int fresh_lane() { int l; asm volatile("v_mbcnt_lo_u32_b32 %0, -1, 0\n\tv_mbcnt_hi_u32_b32 %0, -1, %0" : "=v"(l)); return l; }
#endif
typedef LAS unsigned char* LDSP;
constexpr double TWO_PI = 6.283185307179586476925286766559;
#ifdef EMU
static const double ROPE_INV[32] = {1.0, 0.7498942093324559, 0.5623413251903491, 0.4216965034285822, 0.31622776601683794, 0.23713737056616552, 0.1778279410038923, 0.1333521432163324, 0.1, 0.07498942093324558, 0.05623413251903491, 0.042169650342858224, 0.03162277660168379, 0.023713737056616554, 0.01778279410038923, 0.01333521432163324, 0.01, 0.007498942093324558, 0.005623413251903491, 0.004216965034285823, 0.0031622776601683794, 0.0023713737056616554, 0.0017782794100389228, 0.001333521432163324, 0.001, 0.0007498942093324559, 0.0005623413251903491, 0.00042169650342858224, 0.00031622776601683794, 0.00023713737056616554, 0.00017782794100389227, 0.0001333521432163324};
#else
__device__ const double ROPE_INV[32] = {1.0, 0.7498942093324559, 0.5623413251903491, 0.4216965034285822, 0.31622776601683794, 0.23713737056616552, 0.1778279410038923, 0.1333521432163324, 0.1, 0.07498942093324558, 0.05623413251903491, 0.042169650342858224, 0.03162277660168379, 0.023713737056616554, 0.01778279410038923, 0.01333521432163324, 0.01, 0.007498942093324558, 0.005623413251903491, 0.004216965034285823, 0.0031622776601683794, 0.0023713737056616554, 0.0017782794100389228, 0.001333521432163324, 0.001, 0.0007498942093324559, 0.0005623413251903491, 0.00042169650342858224, 0.00031622776601683794, 0.00023713737056616554, 0.00017782794100389227, 0.0001333521432163324};
#endif

struct Params { const float* in[33]; float* out; unsigned char* ws; };
#ifndef EMU
__device__ __forceinline__ const float* pin_load(int i) {
    const __attribute__((address_space(4))) char* k = (const __attribute__((address_space(4))) char*)__builtin_amdgcn_kernarg_segment_ptr();
    asm volatile("" : "+s"(k));
    return *(const float* const __attribute__((address_space(4)))*)(k + 8 * i);
}
#endif
enum { I_XP = 0, I_XS, I_CK, I_CV, I_SWKV, I_SSH, I_NFF1, I_F1G, I_F1U, I_F1D, I_NMIX, I_WIN, I_MU, I_DW0, I_DW2, I_IA0, I_IA2, I_GG2, I_KK, I_KA, I_RK, I_GNG, I_GNB, I_QN, I_KN, I_SINK,
       I_WUA, I_WUB, I_WO, I_NFF2, I_F2G, I_F2U, I_F2D };

DEV unsigned f2bf(float f) { unsigned u = __builtin_bit_cast(unsigned, f); return (u + 0x7fffu + ((u >> 16) & 1u)) >> 16; }
DEV unsigned pk2(float lo, float hi) { return f2bf(lo) | (f2bf(hi) << 16); }
DEV float bf2f(unsigned h) { return __builtin_bit_cast(float, h << 16); }
DEV bf16_t* lwp(const Params& p, int l, size_t off) { return (bf16_t*)(p.ws + WS_W + (size_t)l * LAYER_W_BYTES + off); }
DEV float wave_sum(float v) {
#pragma unroll
    for (int o = 1; o < 64; o <<= 1) v += SHFL_XOR(v, o);
    return v;
}
DEV float sigmoidf_(float x) { return 1.0f / (1.0f + expf(-x)); }
DEV int swz(int row, int col) { return row * 128 + ((((col >> 3) ^ row) & 7) << 4) + ((col & 7) << 1); }
DEV int swz192(int row, int col) { const int ch = col >> 3; return row * 384 + (((ch & ~7) | ((ch ^ row) & 7)) << 4) + ((col & 7) << 1); }
DEV f32x4 mm64(LDSP A, int m0, LDSP B, int n0, f32x4 acc, int lane) {
    const int r = lane & 15, g4 = lane >> 4;
#pragma unroll
    for (int ks = 0; ks < 2; ++ks) {
        const bf16x8 a = *(const LAS bf16x8*)(A + swz(m0 + r, 32 * ks + 8 * g4));
        const bf16x8 b = *(const LAS bf16x8*)(B + swz(n0 + r, 32 * ks + 8 * g4));
        acc = MFMA16(a, b, acc);
    }
    return acc;
}
DEV void st_tile(LDSP O, int m0, int n0, f32x4 v, int lane) {
    const int r = lane & 15, g4 = lane >> 4;
#pragma unroll
    for (int reg = 0; reg < 4; ++reg) *(LAS bf16_t*)(O + swz(m0 + 4 * g4 + reg, n0 + r)) = (bf16_t)f2bf(v[reg]);
}
DEV void st_tile_T(LDSP O, int m0, int n0, f32x4 v, int lane) {
    const int r = lane & 15, g4 = lane >> 4;
    u32x2 w; w.x = pk2(v[0], v[1]); w.y = pk2(v[2], v[3]);
    *(LAS u32x2*)(O + swz(n0 + r, m0 + 4 * g4)) = w;
}
DEV bf16x8 pack8(f32x4 lo, f32x4 hi) {
    u32x4 w; w.x = pk2(lo[0], lo[1]); w.y = pk2(lo[2], lo[3]); w.z = pk2(hi[0], hi[1]); w.w = pk2(hi[2], hi[3]);
    return __builtin_bit_cast(bf16x8, w);
}

namespace pg8 {
#define PG8_LAS __attribute__((address_space(3)))
typedef unsigned short bf16_t;
typedef short bf16x8 __attribute__((ext_vector_type(8)));
typedef float f32x4 __attribute__((ext_vector_type(4)));
typedef unsigned u32x4 __attribute__((ext_vector_type(4)));
constexpr int BM = 256, BK = 64, HALF = 128, HTB = HALF * BK * 2  , STAGE_BYTES = 8 * HTB, NXCD = 8, WGM = 8;

__host__ __device__ __forceinline__ int lds_byte(int r, int c) { const int st = (r >> 4) * 2 + (c >> 5), rr = r & 15, cc = c & 31, ob = rr * 64 + cc * 2; return st * 1024 + (ob ^ (((ob >> 9) & 1) << 5)); }
__host__ __device__ __forceinline__ void stage_rc(int b, int& R, int& C) { const int st = b / 1024, sb = b % 1024, swz = sb ^ (((sb >> 9) & 1) << 5); R = (st >> 1) * 16 + swz / 64; C = (st & 1) * 32 + (swz % 64) / 2; }
__host__ __device__ __forceinline__ int perm32(int rho) { const int n = rho >> 4, i = rho & 15; return 8 * (i >> 2) + 4 * n + (i & 3); }

struct Unit { int pm, pn; };
struct Gemm { const bf16_t* A; const bf16_t* Bt; int M, N, K; };

struct StaticOrder {
    int nM, nN, nwg, G, c;
    __host__ __device__ void init(int M, int N, int G_, int c_) { nM = M / BM; nN = N / BM; nwg = nM * nN; G = G_; c = c_; }
    __host__ __device__ bool next(int i, Unit& u) const {
        const long L = (long)i * G + c; if (L >= nwg) return false;
        int wgid = (int)L; { const int q = nwg / NXCD, r = nwg % NXCD, xcd = wgid % NXCD, off = wgid / NXCD; wgid = (xcd < r ? xcd * (q + 1) : r * (q + 1) + (xcd - r) * q) + off; }
        const int nig = WGM * nN, gid = wgid / nig, fm = gid * WGM, gsz = (nM - fm) < WGM ? (nM - fm) : WGM;
        u.pm = fm + ((wgid % nig) % gsz); u.pn = (wgid % nig) / gsz; return true;
    }
    __device__ __forceinline__ void a_ready(const Unit&) const {}
    __device__ __forceinline__ void done(const Unit&) const {}
};

#ifndef EMU
template <class Epi, class Sched, bool ALIGN_EPI = false, bool SP2 = false>
__device__ __forceinline__ void gemm_phase(PG8_LAS unsigned char* lds, const Gemm g, const Sched& S, const Epi& E, const int wid) {
    const int lane = ::fresh_lane(), tid = wid * 64 + lane, wr = wid >> 2, wc = wid & 3, fr = lane & 15, fq = lane >> 4;
    const int K = g.K, nt = K / BK;
    unsigned voffA[2], voffB[2];
#pragma unroll
    for (int i = 0; i < 2; ++i) { int R, C; stage_rc(tid * 16 + i * 8192, R, C); const int Rb = Epi::PERM ? ((R & ~31) + perm32(R & 31)) : R;
        voffA[i] = (unsigned)(R * K + C) * 2u; voffB[i] = (unsigned)(Rb * K + C) * 2u; }
    const size_t kstep = (size_t)(BK * 2);
    const size_t hstep = (size_t)HALF * K * 2;
    const size_t tstep = 2 * hstep;
    const unsigned ldsw = (unsigned)wid * 1024u;
    const int aoff = lds_byte(wr * 64 + fr, fq * 8), boff = lds_byte(wc * 32 + fr, fq * 8);
#define PG8_SA(b, h) (((b) * 2 + (h)) * HTB)
#define PG8_SB(b, h) ((4 + (b) * 2 + (h)) * HTB)
#define PG8_STAGE(bufoff, gbase, voff) do { _Pragma("unroll") for (int _i = 0; _i < 2; ++_i) \
        __builtin_amdgcn_global_load_lds((const unsigned*)((const char*)(gbase) + (voff)[_i]), (PG8_LAS unsigned*)(lds + (bufoff) + ldsw + _i * 8192), 16, 0, 0); } while (0)
#define PG8_LDA(dst, b, h) do { _Pragma("unroll") for (int m = 0; m < 4; ++m) _Pragma("unroll") for (int k = 0; k < 2; ++k) dst[m][k] = *(const PG8_LAS bf16x8*)(lds + PG8_SA(b, h) + aoff + m * 2048 + k * 1024); } while (0)
#define PG8_LDB(dst, b, h) do { _Pragma("unroll") for (int n = 0; n < 2; ++n) _Pragma("unroll") for (int k = 0; k < 2; ++k) dst[n][k] = *(const PG8_LAS bf16x8*)(lds + PG8_SB(b, h) + boff + n * 2048 + k * 1024); } while (0)
#define PG8_MMA(ai, bj, At, Bt) do { __builtin_amdgcn_s_setprio(1); _Pragma("unroll") for (int m = 0; m < 4; ++m) _Pragma("unroll") for (int n = 0; n < 2; ++n) _Pragma("unroll") for (int k = 0; k < 2; ++k) \
        acc[ai][bj][m][n] = __builtin_amdgcn_mfma_f32_16x16x32_bf16(Bt[n][k], At[m][k], acc[ai][bj][m][n], 0, 0, 0); __builtin_amdgcn_s_setprio(0); } while (0)
#define PG8_WAIT_V(n) asm volatile("s_waitcnt vmcnt(" #n ")" ::: "memory")
#define PG8_WAIT_L(n) asm volatile("s_waitcnt lgkmcnt(" #n ")" ::: "memory")
#define PG8_BAR __builtin_amdgcn_s_barrier()
#define PG8_SCHED __builtin_amdgcn_sched_barrier(0)
    Unit cur, nxt; int ui = 0;
    if (!S.next(0, cur)) return;
    f32x4 acc[2][2][4][2];
#pragma unroll
    for (int a = 0; a < 2; ++a)
#pragma unroll
        for (int b = 0; b < 2; ++b)
#pragma unroll
            for (int m = 0; m < 4; ++m)
#pragma unroll
                for (int n = 0; n < 2; ++n) acc[a][b][m][n] = (f32x4){0.f, 0.f, 0.f, 0.f};
    bf16x8 At[4][2], B0[2][2], B1[2][2];
    const char* cA = (const char*)g.A + (size_t)cur.pm * tstep; const char* cB = (const char*)g.Bt + (size_t)cur.pn * tstep;
    S.a_ready(cur);
    if constexpr (SP2) {
        PG8_STAGE(PG8_SB(0, 0), cB, voffB); PG8_STAGE(PG8_SB(0, 1), cB + hstep, voffB); PG8_STAGE(PG8_SA(0, 0), cA, voffA); PG8_STAGE(PG8_SA(0, 1), cA + hstep, voffA);
        if (wr == 1) PG8_BAR;
        PG8_WAIT_V(2); PG8_BAR;
        PG8_STAGE(PG8_SB(1, 0), cB + kstep, voffB); PG8_STAGE(PG8_SA(1, 0), cA + kstep, voffA); PG8_STAGE(PG8_SB(1, 1), cB + hstep + kstep, voffB);
        PG8_WAIT_V(6); PG8_BAR;
    } else {
        PG8_STAGE(PG8_SB(0, 0), cB, voffB); PG8_STAGE(PG8_SA(0, 0), cA, voffA); PG8_STAGE(PG8_SB(0, 1), cB + hstep, voffB); PG8_STAGE(PG8_SA(0, 1), cA + hstep, voffA);
        if (wr == 1) PG8_BAR;
        PG8_WAIT_V(4); PG8_BAR;
        PG8_STAGE(PG8_SB(1, 0), cB + kstep, voffB); PG8_STAGE(PG8_SA(1, 0), cA + kstep, voffA); PG8_STAGE(PG8_SB(1, 1), cB + hstep + kstep, voffB);
        PG8_WAIT_V(6); PG8_BAR;
    }
    for (;;) {
        const bool has_next = S.next(ui + 1, nxt);
        const char* nA = has_next ? (const char*)g.A + (size_t)nxt.pm * tstep : cA; const char* nB = has_next ? (const char*)g.Bt + (size_t)nxt.pn * tstep : cB;
        for (int t = 0; t < nt; t += 2) {
            const bool last = (t == nt - 2);
            const char* a1 = cA + (size_t)(t + 1) * kstep;
            const char* a2 = last ? nA : cA + (size_t)(t + 2) * kstep; const char* b2 = last ? nB : cB + (size_t)(t + 2) * kstep;
            const char* a3 = a2 + kstep; const char* b3 = b2 + kstep;
            if (last && has_next) S.a_ready(nxt);
            if constexpr (SP2) {
            PG8_LDB(B0, 0, 0); PG8_LDB(B1, 0, 1); PG8_SCHED; PG8_LDA(At, 0, 0); PG8_STAGE(PG8_SA(1, 1), a1 + hstep, voffA);
            PG8_WAIT_V(8); PG8_WAIT_L(0); PG8_BAR; PG8_MMA(0, 0, At, B0); PG8_MMA(0, 1, At, B1); PG8_BAR; PG8_SCHED;
            PG8_LDA(At, 0, 1); PG8_STAGE(PG8_SB(0, 0), b2, voffB); PG8_STAGE(PG8_SB(0, 1), b2 + hstep, voffB); PG8_STAGE(PG8_SA(0, 0), a2, voffA);
            PG8_WAIT_V(8); PG8_WAIT_L(0); PG8_BAR; PG8_MMA(1, 0, At, B0); PG8_MMA(1, 1, At, B1); PG8_BAR; PG8_SCHED;
            PG8_LDB(B0, 1, 0); PG8_LDB(B1, 1, 1); PG8_SCHED; PG8_LDA(At, 1, 0); PG8_STAGE(PG8_SA(0, 1), a2 + hstep, voffA);
            PG8_WAIT_V(8); PG8_WAIT_L(0); PG8_BAR; PG8_MMA(0, 0, At, B0); PG8_MMA(0, 1, At, B1); PG8_BAR; PG8_SCHED;
            PG8_LDA(At, 1, 1); PG8_STAGE(PG8_SB(1, 0), b3, voffB); PG8_STAGE(PG8_SB(1, 1), b3 + hstep, voffB); PG8_STAGE(PG8_SA(1, 0), a3, voffA);
            PG8_WAIT_V(8); PG8_WAIT_L(0); PG8_BAR; PG8_MMA(1, 0, At, B0); PG8_MMA(1, 1, At, B1); PG8_BAR; PG8_SCHED;
            } else {
            PG8_LDB(B0, 0, 0); PG8_SCHED; PG8_LDA(At, 0, 0); PG8_STAGE(PG8_SA(1, 1), a1 + hstep, voffA);
            PG8_WAIT_L(8); PG8_BAR; PG8_WAIT_L(0); PG8_MMA(0, 0, At, B0); PG8_BAR; PG8_SCHED;
            PG8_LDB(B1, 0, 1); PG8_STAGE(PG8_SB(0, 0), b2, voffB);
            PG8_BAR; PG8_WAIT_L(0); PG8_MMA(0, 1, At, B1); PG8_BAR;
            PG8_LDA(At, 0, 1); PG8_STAGE(PG8_SA(0, 0), a2, voffA);
            PG8_BAR; PG8_WAIT_L(0); PG8_MMA(1, 0, At, B0); PG8_BAR; PG8_SCHED;
            PG8_STAGE(PG8_SB(0, 1), b2 + hstep, voffB);
            PG8_WAIT_V(6); PG8_BAR; PG8_MMA(1, 1, At, B1); PG8_BAR;
            PG8_LDB(B0, 1, 0); PG8_SCHED; PG8_LDA(At, 1, 0); PG8_STAGE(PG8_SA(0, 1), a2 + hstep, voffA);
            PG8_WAIT_L(8); PG8_BAR; PG8_WAIT_L(0); PG8_MMA(0, 0, At, B0); PG8_BAR; PG8_SCHED;
            PG8_LDB(B1, 1, 1); PG8_STAGE(PG8_SB(1, 0), b3, voffB);
            PG8_BAR; PG8_WAIT_L(0); PG8_MMA(0, 1, At, B1); PG8_BAR;
            PG8_LDA(At, 1, 1); PG8_STAGE(PG8_SA(1, 0), a3, voffA);
            PG8_BAR; PG8_WAIT_L(0); PG8_MMA(1, 0, At, B0); PG8_BAR; PG8_SCHED;
            PG8_STAGE(PG8_SB(1, 1), b3 + hstep, voffB);
            PG8_WAIT_V(6); PG8_BAR; PG8_MMA(1, 1, At, B1); PG8_BAR;
            }
        }
        if constexpr (ALIGN_EPI) { if (wr == 0) PG8_BAR; }
        if constexpr (!Epi::AFTER_DRAIN) { E(acc, cur, wr, wc, fr, fq); S.done(cur); }
        if (!has_next) break;
#pragma unroll
        for (int a = 0; a < 2; ++a)
#pragma unroll
            for (int b = 0; b < 2; ++b)
#pragma unroll
                for (int m = 0; m < 4; ++m)
#pragma unroll
                    for (int n = 0; n < 2; ++n) acc[a][b][m][n] = (f32x4){0.f, 0.f, 0.f, 0.f};
        cur = nxt; cA = nA; cB = nB; ++ui;
        if constexpr (ALIGN_EPI) { if (wr == 1) PG8_BAR; }
    }
    PG8_WAIT_V(0);
    if constexpr (!ALIGN_EPI) { if (wr == 0) PG8_BAR; }
    PG8_BAR;
    if constexpr (Epi::AFTER_DRAIN) { E.fused(acc, cur, wr, wc, fr, fq, lds, wid, lane); S.done(cur); }
#undef PG8_SA
#undef PG8_SB
#undef PG8_STAGE
#undef PG8_LDA
#undef PG8_LDB
#undef PG8_MMA
#undef PG8_WAIT_V
#undef PG8_WAIT_L
#undef PG8_BAR
#undef PG8_SCHED
}
}
#else
template <class Epi, class Sched, bool ALIGN_EPI = false, bool SP2 = false>
static void gemm_phase(LDSP lds, const Gemm g, const Sched& S, const Epi& E, const int wid_) {
    const int tid = TID(), wid = tid >> 6, lane = tid & 63, wr = wid >> 2, wc = wid & 3, fr = lane & 15, fq = lane >> 4;
    Unit u;
    for (int i = 0; S.next(i, u); ++i) {
        f32x4 acc[2][2][4][2];
        for (int ai = 0; ai < 2; ++ai) for (int bj = 0; bj < 2; ++bj) for (int m = 0; m < 4; ++m) for (int n = 0; n < 2; ++n) for (int e = 0; e < 4; ++e) {
            const int row = 256 * u.pm + 128 * ai + 64 * wr + 16 * m + fr;
            const int col = 256 * u.pn + 128 * bj + 32 * wc + (Epi::PERM ? 8 * fq + 4 * n + e : 16 * n + 4 * fq + e);
            const bf16_t* a = g.A + (size_t)row * g.K; const bf16_t* b = g.Bt + (size_t)col * g.K; float s = 0.f;
            for (int k = 0; k < g.K; ++k) s += ::bf2f(a[k]) * ::bf2f(b[k]);
            acc[ai][bj][m][n][e] = s; }
        E(acc, u, wr, wc, fr, fq);
    }
}
}
#endif

struct EpiSwiglu {
    static constexpr bool PERM = true, AFTER_DRAIN = false;
    bf16_t* G;
    DEVM void operator()(const f32x4 (&acc)[2][2][4][2], const pg8::Unit& u, int wr, int wc, int fr, int fq) const {
        const int row0 = u.pm * 256 + wr * 64 + fr, col0 = u.pn * 128 + wc * 32 + 8 * fq;
#pragma unroll
        for (int ai = 0; ai < 2; ++ai)
#pragma unroll
            for (int m = 0; m < 4; ++m) {
                bf16_t* rowp = G + (size_t)(row0 + ai * 128 + m * 16) * DFF + col0;
                float o[8];
#pragma unroll
                for (int n = 0; n < 2; ++n)
#pragma unroll
                    for (int e = 0; e < 4; ++e) { const float g = acc[ai][0][m][n][e], up = acc[ai][1][m][n][e]; o[4 * n + e] = g * up / (1.0f + EXP2F(-g * LOG2E)); }
                u32x4 w; w.x = pk2(o[0], o[1]); w.y = pk2(o[2], o[3]); w.z = pk2(o[4], o[5]); w.w = pk2(o[6], o[7]);
                *(u32x4*)rowp = w;
            }
    }
};
struct EpiResid {
    static constexpr bool PERM = false, AFTER_DRAIN = false;
    float* X; float scale;
    DEVM void operator()(const f32x4 (&acc)[2][2][4][2], const pg8::Unit& u, int wr, int wc, int fr, int fq) const {
        const int row0 = u.pm * 256 + wr * 64 + fr, col0 = u.pn * 256 + wc * 32 + 4 * fq;
#pragma unroll
        for (int ai = 0; ai < 2; ++ai)
#pragma unroll
            for (int m = 0; m < 4; ++m) {
                float* rowp = X + (size_t)(row0 + ai * 128 + m * 16) * DM + col0;
#pragma unroll
                for (int bj = 0; bj < 2; ++bj)
#pragma unroll
                    for (int n = 0; n < 2; ++n) { f32x4* q = (f32x4*)(rowp + bj * 128 + n * 16); *q = *q + acc[ai][bj][m][n] * scale; }
            }
    }
};
struct EpiWin {
    static constexpr bool PERM = false, AFTER_DRAIN = false;
    float* PF; bf16_t* SG;
    DEVM void operator()(const f32x4 (&acc)[2][2][4][2], const pg8::Unit& u, int wr, int wc, int fr, int fq) const {
        const int row0 = u.pm * 256 + wr * 64 + fr;
        if (u.pn < FW / 256) {
            const int col0 = u.pn * 256 + wc * 32 + 4 * fq;
#pragma unroll
            for (int ai = 0; ai < 2; ++ai)
#pragma unroll
                for (int m = 0; m < 4; ++m) {
                    float* rowp = PF + (size_t)(row0 + ai * 128 + m * 16) * FW + col0;
#pragma unroll
                    for (int bj = 0; bj < 2; ++bj)
#pragma unroll
                        for (int n = 0; n < 2; ++n) *(f32x4*)(rowp + bj * 128 + n * 16) = acc[ai][bj][m][n];
                }
        } else {
            const int col0 = (u.pn - FW / 256) * 256 + wc * 32 + 4 * fq;
#pragma unroll
            for (int ai = 0; ai < 2; ++ai)
#pragma unroll
                for (int m = 0; m < 4; ++m) {
                    bf16_t* rowp = SG + (size_t)(row0 + ai * 128 + m * 16) * (2 * DM) + col0;
#pragma unroll
                    for (int bj = 0; bj < 2; ++bj)
#pragma unroll
                        for (int n = 0; n < 2; ++n) { const f32x4 v = acc[ai][bj][m][n]; u32x2 w;
                            w.x = pk2(1.0f / (1.0f + EXP2F(-v[0] * LOG2E)), 1.0f / (1.0f + EXP2F(-v[1] * LOG2E))); w.y = pk2(1.0f / (1.0f + EXP2F(-v[2] * LOG2E)), 1.0f / (1.0f + EXP2F(-v[3] * LOG2E)));
                            *(u32x2*)(rowp + bj * 128 + n * 16) = w; }
                }
        }
    }
};
struct EpiUpA {
    static constexpr bool PERM = false, AFTER_DRAIN = false;
    const bf16_t* SG; float* T1;
    DEVM void operator()(const f32x4 (&acc)[2][2][4][2], const pg8::Unit& u, int wr, int wc, int fr, int fq) const {
        const int row0 = u.pm * 256 + wr * 64 + fr, col0 = u.pn * 256 + wc * 32 + 4 * fq;
#pragma unroll
        for (int ai = 0; ai < 2; ++ai)
#pragma unroll
            for (int m = 0; m < 4; ++m) {
                const size_t row = (size_t)(row0 + ai * 128 + m * 16);
#pragma unroll
                for (int bj = 0; bj < 2; ++bj)
#pragma unroll
                    for (int n = 0; n < 2; ++n) { const int c = col0 + bj * 128 + n * 16; const u32x2 s = *(const u32x2*)(SG + row * (2 * DM) + c); const f32x4 v = acc[ai][bj][m][n];
                        f32x4 o; o[0] = v[0] * bf2f(s.x & 0xffffu); o[1] = v[1] * bf2f(s.x >> 16); o[2] = v[2] * bf2f(s.y & 0xffffu); o[3] = v[3] * bf2f(s.y >> 16);
                        *(f32x4*)(T1 + row * DM + c) = o; }
            }
    }
};
struct EpiUpB {
    static constexpr bool PERM = false, AFTER_DRAIN = false;
    const bf16_t* SG; const float* T1; bf16_t* MG;
    DEVM void operator()(const f32x4 (&acc)[2][2][4][2], const pg8::Unit& u, int wr, int wc, int fr, int fq) const {
        const int row0 = u.pm * 256 + wr * 64 + fr, col0 = u.pn * 256 + wc * 32 + 4 * fq;
#pragma unroll
        for (int ai = 0; ai < 2; ++ai)
#pragma unroll
            for (int m = 0; m < 4; ++m) {
                const size_t row = (size_t)(row0 + ai * 128 + m * 16);
#pragma unroll
                for (int bj = 0; bj < 2; ++bj)
#pragma unroll
                    for (int n = 0; n < 2; ++n) { const int c = col0 + bj * 128 + n * 16; const u32x2 s = *(const u32x2*)(SG + row * (2 * DM) + DM + c); const f32x4 v = acc[ai][bj][m][n];
                        const f32x4 t = *(const f32x4*)(T1 + row * DM + c);
                        u32x2 w; w.x = pk2(t[0] + v[0] * bf2f(s.x & 0xffffu), t[1] + v[1] * bf2f(s.x >> 16)); w.y = pk2(t[2] + v[2] * bf2f(s.y & 0xffffu), t[3] + v[3] * bf2f(s.y >> 16));
                        *(u32x2*)(MG + row * DM + c) = w; }
            }
    }
};

DEV void conv_item(const float* W, int K, int N, bf16_t* WT, int mode, LAS float* scr, int item, int lane) {
    const int nblk = N / 32, kb = item / nblk, nb = item % nblk, k0 = 64 * kb, n0 = 32 * nb;
    int drow = n0;
    if (mode == 1) drow = (n0 >> 7) * 256 + (n0 & 127); else if (mode == 2) drow = (n0 >> 7) * 256 + 128 + (n0 & 127); else if (mode == 3) drow = n0 < FW_RAW ? n0 : FW + (n0 - FW_RAW);
#pragma unroll 8
    for (int i = 0; i < 32; ++i) { const int kk = 2 * i + (lane >> 5); scr[kk * 33 + (lane & 31)] = W[(size_t)(k0 + kk) * N + n0 + (lane & 31)]; }
    WAVE_FENCE();
    const int c = lane & 7;
#pragma unroll
    for (int j = 0; j < 4; ++j) { const int n = (lane >> 3) + 8 * j; const LAS float* s = scr + (8 * c) * 33 + n;
        u32x4 o; o.x = pk2(s[0 * 33], s[1 * 33]); o.y = pk2(s[2 * 33], s[3 * 33]); o.z = pk2(s[4 * 33], s[5 * 33]); o.w = pk2(s[6 * 33], s[7 * 33]);
        *(u32x4*)(WT + (size_t)(drow + n) * K + k0 + 8 * c) = o; }
    WAVE_FENCE();
}
constexpr int IT_G = (DM / 64) * (DFF / 32), IT_D = (DFF / 64) * (DM / 32), IT_IN = (DM / 64) * (INCOLS / 32), IT_UA = (AW / 64) * (DM / 32), IT_UB = (BQ / 64) * (DM / 32), IT_O = (DM / 64) * (DM / 32);
constexpr int IT_LAYER = 4 * IT_G + 2 * IT_D + IT_IN + IT_UA + IT_UB + IT_O;
DEV void prologue(const Params& p, LDSP lds, int gw, int NGW, int wave, int lane, int gtid, int NGT) {
    LAS float* scr = (LAS float*)(lds + wave * 8448);
    for (int it = gw; it < DEPTH * IT_LAYER; it += NGW) {
        const int l = it / IT_LAYER; int r = it % IT_LAYER;
        int src, K, N, mode; size_t doff, soff;
        if (r < IT_G) { src = I_F1G; K = DM; N = DFF; mode = 1; doff = OFF_WGU1; soff = (size_t)l * DM * DFF; }
        else if ((r -= IT_G) < IT_G) { src = I_F1U; K = DM; N = DFF; mode = 2; doff = OFF_WGU1; soff = (size_t)l * DM * DFF; }
        else if ((r -= IT_G) < IT_D) { src = I_F1D; K = DFF; N = DM; mode = 0; doff = OFF_WD1; soff = (size_t)l * DFF * DM; }
        else if ((r -= IT_D) < IT_IN) { src = I_WIN; K = DM; N = INCOLS; mode = 3; doff = OFF_WIN; soff = (size_t)l * DM * INCOLS; }
        else if ((r -= IT_IN) < IT_UA) { src = I_WUA; K = AW; N = DM; mode = 0; doff = OFF_WUA; soff = (size_t)l * AW * DM; }
        else if ((r -= IT_UA) < IT_UB) { src = I_WUB; K = BQ; N = DM; mode = 0; doff = OFF_WUB; soff = (size_t)l * BQ * DM; }
        else if ((r -= IT_UB) < IT_O) { src = I_WO; K = DM; N = DM; mode = 0; doff = OFF_WO; soff = (size_t)l * DM * DM; }
        else if ((r -= IT_O) < IT_G) { src = I_F2G; K = DM; N = DFF; mode = 1; doff = OFF_WGU2; soff = (size_t)l * DM * DFF; }
        else if ((r -= IT_G) < IT_G) { src = I_F2U; K = DM; N = DFF; mode = 2; doff = OFF_WGU2; soff = (size_t)l * DM * DFF; }
        else { r -= IT_G; src = I_F2D; K = DFF; N = DM; mode = 0; doff = OFF_WD2; soff = (size_t)l * DFF * DM; }
        conv_item(PIN(p, src) + soff, K, N, lwp(p, l, doff), mode, scr, r, lane);
    }
    for (int idx = gtid; idx < DEPTH * AW * 288; idx += NGT) {
        const int l = idx / (AW * 288), r = idx % (AW * 288), n = r / 288, k = r % 288;
        if (k < 64) lwp(p, l, OFF_DW2T)[n * 64 + k] = (bf16_t)f2bf(PIN(p, I_DW2)[((size_t)l * 64 + k) * AW + n]);
        else if (k < 128) lwp(p, l, OFF_IA2T)[n * 64 + (k - 64)] = (bf16_t)f2bf(PIN(p, I_IA2)[((size_t)l * 64 + (k - 64)) * AW + n]);
        else lwp(p, l, OFF_GG2T)[n * 160 + (k - 128)] = (bf16_t)f2bf(PIN(p, I_GG2)[((size_t)l * 160 + (k - 128)) * AW + n]);
    }
    float* rope = (float*)(p.ws + WS_ROPE);
    for (int idx = gtid; idx < (SEQ + DECS) * 32; idx += NGT) {
        const int slot = idx >> 5, i = idx & 31; const double pos = slot < SEQ ? (double)slot : (double)(PAST + slot - SEQ);
        const double ang = pos * ROPE_INV[i]; const double red = ang - TWO_PI * __builtin_rint(ang * (1.0 / TWO_PI));
        rope[2 * idx] = cosf((float)red); rope[2 * idx + 1] = sinf((float)red);
    }
}
DEV void norm_phase(const Params& p, const float* gain, bool first, int gw, int NGW, int lane) {
    float* X = p.out; bf16_t* H = (bf16_t*)(p.ws + WS_H);
    for (int m = gw; m < M; m += NGW) {
        const float* xr = first ? (m < SEQ ? PIN(p, I_XP) + (size_t)m * DM : PIN(p, I_XS) + (size_t)(m - SEQ) * DM) : X + (size_t)m * DM;
        f32x4 v[DM / 256]; float ss = 0.f;
#pragma unroll
        for (int j = 0; j < DM / 256; ++j) { v[j] = *(const f32x4*)(xr + 4 * lane + 256 * j); ss += (v[j][0] * v[j][0] + v[j][1] * v[j][1]) + (v[j][2] * v[j][2] + v[j][3] * v[j][3]); }
        if (first) {
#pragma unroll
            for (int j = 0; j < DM / 256; ++j) *(f32x4*)(X + (size_t)m * DM + 4 * lane + 256 * j) = v[j];
        }
        const float rinv = RSQRTF(wave_sum(ss) * (1.0f / DM) + RMS_EPS);
#pragma unroll
        for (int j = 0; j < DM / 256; ++j) { const f32x4 g = *(const f32x4*)(gain + 4 * lane + 256 * j); u32x2 w; w.x = pk2(v[j][0] * rinv * g[0], v[j][1] * rinv * g[1]); w.y = pk2(v[j][2] * rinv * g[2], v[j][3] * rinv * g[3]);
            *(u32x2*)(H + (size_t)m * DM + 4 * lane + 256 * j) = w; }
    }
}

constexpr int R1_RA = 3 * 64 * 65 * 4, R1_RB = 65536 + 64 * 65 * 4;
static_assert(R1_RA + R1_RB + 2304 <= LDS_CTL_OFF && 6 * 8192 <= R1_RA, "R1 LDS map");
DEV void r1_unit(const Params& p, int l, int u, LDSP lds, int tid) {
    const int lane = tid & 63, wave = WAVE_ID(tid), r = lane & 15, g4 = lane >> 4;
    const bool samp = u >= NUP;
    int c = 0, b = 0, h, ntok; size_t row0;
    if (!samp) { c = u / AH; h = u % AH; row0 = (size_t)64 * c; ntok = 64; } else { const int s = u - NUP; b = s / AH; h = s % AH; row0 = (size_t)SEQ + 16 * b; ntok = DECS; }
    const float* PF = (const float*)(p.ws + WS_PF);
    const float* mu = PIN(p, I_MU) + (size_t)l * ACOLS;
    LDSP RA = lds, RB = lds + R1_RA;
    LAS float* DWf = (LAS float*)RA; LAS float* IAf = DWf + 64 * 65; LAS float* GGf = IAf + 64 * 65;
    LDSP LW = RB, LA = RB + 8192, LG = RB + 16384;
    LDSP B0 = RB, B1 = RB + 8192, B2 = RB + 16384, B3 = RB + 24576, B4 = RB + 32768, B5 = RB + 40960, B6 = RB + 49152, B7 = RB + 57344;
    LAS float* RtF = (LAS float*)(RB + 65536);
    LDSP A0 = RA, A1 = RA + 8192, A2 = RA + 16384, A3 = RA + 24576, A4 = RA + 32768, A5 = RA + 40960;
    LAS float* part = (LAS float*)(lds + R1_RA + R1_RB); LAS float* gam = part + 512;
    {
        const int t = tid >> 3, sub = tid & 7; const bool valid = t < ntok;
        const float* cur = PF + (row0 + t) * FW; const float* prv = cur - FW; float ps = 1.f;
        if (t == 0) { if (samp) prv = PIN(p, I_SSH) + ((size_t)l * DECB + b) * ACOLS; else if (c == 0) { prv = cur; ps = 0.f; } }
        u32x4 wv = (u32x4){0u, 0u, 0u, 0u}, av = wv;
        if (valid) {
            float x[8], y[8];
#pragma unroll
            for (int e = 0; e < 8; ++e) { const int cw = C_WLO + 8 * sub + e, ca = C_ALO + 8 * sub + e;
                const float a_ = cur[cw], b_ = cur[ca]; x[e] = tanhf(a_ + (prv[cw] * ps - a_) * mu[cw]); y[e] = b_ + (prv[ca] * ps - b_) * mu[ca]; }
            wv.x = pk2(x[0], x[1]); wv.y = pk2(x[2], x[3]); wv.z = pk2(x[4], x[5]); wv.w = pk2(x[6], x[7]);
            av.x = pk2(y[0], y[1]); av.y = pk2(y[2], y[3]); av.z = pk2(y[4], y[5]); av.w = pk2(y[6], y[7]);
        }
        *(LAS u32x4*)(LW + swz(t, 8 * sub)) = wv; *(LAS u32x4*)(LA + swz(t, 8 * sub)) = av;
#pragma unroll
        for (int q = 0; q < 5; ++q) { const int col = 20 * sub + 4 * q; u32x2 w = (u32x2){0u, 0u};
            if (valid) { float z[4];
#pragma unroll
                for (int e = 0; e < 4; ++e) { const int cg = C_GLO + col + e; const float a_ = cur[cg]; z[e] = sigmoidf_(a_ + (prv[cg] * ps - a_) * mu[cg]); }
                w.x = pk2(z[0], z[1]); w.y = pk2(z[2], z[3]); }
            *(LAS u32x2*)(LG + swz192(t, col)) = w; }
    }
    WG_SYNC();
#pragma unroll 1
    for (int q = 0; q < 6; ++q) {
        const int ti = wave + 8 * q, mat = ti >> 4, mt = (ti >> 2) & 3, nt = ti & 3;
        f32x4 acc = (f32x4){0.f, 0.f, 0.f, 0.f};
        if (mat < 2) {
            const bf16_t* W = lwp(p, l, mat == 0 ? OFF_DW2T : OFF_IA2T) + (size_t)(64 * h + 16 * nt + r) * 64; LDSP A = mat == 0 ? LW : LA;
#pragma unroll
            for (int ks = 0; ks < 2; ++ks) { const bf16x8 a = *(const LAS bf16x8*)(A + swz(16 * mt + r, 32 * ks + 8 * g4)); const bf16x8 bb = *(const bf16x8*)(W + 32 * ks + 8 * g4); acc = MFMA16(a, bb, acc); }
        } else {
            const bf16_t* W = lwp(p, l, OFF_GG2T) + (size_t)(64 * h + 16 * nt + r) * 160;
#pragma unroll
            for (int ks = 0; ks < 5; ++ks) { const bf16x8 a = *(const LAS bf16x8*)(LG + swz192(16 * mt + r, 32 * ks + 8 * g4)); const bf16x8 bb = *(const bf16x8*)(W + 32 * ks + 8 * g4); acc = MFMA16(a, bb, acc); }
        }
        LAS float* O = mat == 0 ? DWf : (mat == 1 ? IAf : GGf);
#pragma unroll
        for (int reg = 0; reg < 4; ++reg) O[(16 * mt + 4 * g4 + reg) * 65 + 16 * nt + r] = acc[reg];
    }
    WG_SYNC();
    {
        const int j = lane, tq = wave, ch = 64 * h + j;
        const float w0 = PIN(p, I_DW0)[(size_t)l * AW + ch], a0 = PIN(p, I_IA0)[(size_t)l * AW + ch], kkw = PIN(p, I_KK)[(size_t)l * AW + ch], kaw = PIN(p, I_KA)[(size_t)l * AW + ch], rkw = PIN(p, I_RK)[(size_t)l * AW + ch];
        const float mur = mu[C_R + ch], muk = mu[C_K + ch], muv = mu[C_V + ch];
        float pr = 0.f, pk = 0.f, pv = 0.f;
        { const int t0 = 8 * tq; const float* pp = nullptr;
          if (t0 > 0) { if (t0 - 1 < ntok) pp = PF + (row0 + t0 - 1) * FW; } else if (samp) pp = PIN(p, I_SSH) + ((size_t)l * DECB + b) * ACOLS; else if (c > 0) pp = PF + (row0 - 1) * FW;
          if (pp) { pr = pp[C_R + ch]; pk = pp[C_K + ch]; pv = pp[C_V + ch]; } }
        float rr[8], kq[8], kp[8], av[8], vv[8], ld[8], Lc[8], bs[8]; float Lacc = 0.f;
#pragma unroll
        for (int tt = 0; tt < 8; ++tt) {
            const int t = 8 * tq + tt; const bool valid = t < ntok;
            float cr = 0.f, ck = 0.f, cv = 0.f;
            if (valid) { const float* cp = PF + (row0 + t) * FW; cr = cp[C_R + ch]; ck = cp[C_K + ch]; cv = cp[C_V + ch]; }
            float r_ = cr + (pr - cr) * mur, k_ = ck + (pk - ck) * muk, v_ = cv + (pv - cv) * muv; pr = cr; pk = ck; pv = cv;
            const float x = w0 + DWf[t * 65 + j], z = -x, sp = z > 20.f ? z : log1pf(expf(z)), w = -sp - 0.5f;
            float logd = -expf(w);
            float a = sigmoidf_(a0 + IAf[t * 65 + j]);
            float kn = k_ * kkw; const float ss = wave_sum(kn * kn); kn = kn / fmaxf(sqrtf(ss), 1e-12f);
            float kpp = k_ * (1.0f + (a - 1.0f) * kaw);
            float bsum = wave_sum(r_ * kpp * rkw);
            if (!valid) { logd = 0.f; kn = 0.f; kpp = 0.f; r_ = 0.f; v_ = 0.f; a = 0.f; bsum = 0.f; }
            Lacc += logd; ld[tt] = logd; Lc[tt] = Lacc; rr[tt] = r_; kq[tt] = kn; kp[tt] = kpp; av[tt] = a; vv[tt] = v_; bs[tt] = bsum;
        }
        part[tq * 64 + j] = Lacc;
        WG_SYNC();
        float off = 0.f;
#pragma unroll
        for (int q = 0; q < 8; ++q) if (q < tq) off += part[q * 64 + j];
        float fa[8], fb[8], fk[8], gt[8], bn[8];
#pragma unroll
        for (int tt = 0; tt < 8; ++tt) {
            const int t = 8 * tq + tt; const float L = Lc[tt] + off, Lm = L - ld[tt], eL = expf(L), eLm = expf(Lm), enL = expf(-L);
            const float At = -kq[tt] * eLm, Bt = kq[tt] * av[tt] * enL, Kt = kp[tt] * enL, Rt = rr[tt] * eL;
            *(LAS bf16_t*)(B0 + swz(t, j)) = (bf16_t)f2bf(At); *(LAS bf16_t*)(B2 + swz(t, j)) = (bf16_t)f2bf(Bt); *(LAS bf16_t*)(B4 + swz(t, j)) = (bf16_t)f2bf(Kt); *(LAS bf16_t*)(B6 + swz(t, j)) = (bf16_t)f2bf(Rt);
            RtF[t * 65 + j] = Rt; fa[tt] = At; fb[tt] = Bt; fk[tt] = Kt; gt[tt] = GGf[t * 65 + j]; bn[tt] = bs[tt] * vv[tt];
            if (t == 63) gam[j] = eL;
        }
#define R1_PK8(a) ((u32x4){pk2(a[0], a[1]), pk2(a[2], a[3]), pk2(a[4], a[5]), pk2(a[6], a[7])})
        *(LAS u32x4*)(B1 + swz(j, 8 * tq)) = R1_PK8(fa); *(LAS u32x4*)(B3 + swz(j, 8 * tq)) = R1_PK8(fb); *(LAS u32x4*)(B5 + swz(j, 8 * tq)) = R1_PK8(fk); *(LAS u32x4*)(B7 + swz(j, 8 * tq)) = R1_PK8(vv);
        *(u32x4*)((bf16_t*)(p.ws + WS_GT) + (size_t)u * 4096 + j * 64 + 8 * tq) = R1_PK8(gt);
        *(u32x4*)((bf16_t*)(p.ws + WS_BNT) + (size_t)u * 4096 + j * 64 + 8 * tq) = R1_PK8(bn);
#undef R1_PK8
    }
    WG_SYNC();
    f32x4 accP[2];
    const f32x4 zero4 = (f32x4){0.f, 0.f, 0.f, 0.f};
#pragma unroll
    for (int q = 0; q < 2; ++q) {
        const int ti = 2 * wave + q, m0 = 16 * (ti >> 2), n0 = 16 * (ti & 3), s = n0 + r;
        f32x4 x = mm64(B0, m0, B2, n0, zero4, lane);
        f32x4 pI;
#pragma unroll
        for (int reg = 0; reg < 4; ++reg) { const int t = m0 + 4 * g4 + reg; if (!(t > s)) x[reg] = 0.f; pI[reg] = x[reg] + (t == s ? 1.f : 0.f); }
        st_tile(A0, m0, n0, x, lane); st_tile_T(A1, m0, n0, x, lane); st_tile(A2, m0, n0, pI, lane); accP[q] = pI;
        x = mm64(B0, m0, B4, n0, zero4, lane);
#pragma unroll
        for (int reg = 0; reg < 4; ++reg) { const int t = m0 + 4 * g4 + reg; if (!(t > s)) x[reg] = 0.f; }
        st_tile(A3, m0, n0, x, lane);
        x = mm64(B6, m0, B2, n0, zero4, lane);
#pragma unroll
        for (int reg = 0; reg < 4; ++reg) { const int t = m0 + 4 * g4 + reg; if (!(t >= s)) x[reg] = 0.f; }
        st_tile(A4, m0, n0, x, lane);
        x = mm64(B6, m0, B4, n0, zero4, lane);
#pragma unroll
        for (int reg = 0; reg < 4; ++reg) { const int t = m0 + 4 * g4 + reg; if (!(t >= s)) x[reg] = 0.f; }
        st_tile(A5, m0, n0, x, lane);
    }
    WG_SYNC();
#define R1_STAGE_A(Ys, YTs, Yd, YTd) do { _Pragma("unroll") for (int q = 0; q < 2; ++q) { const int ti = 2 * wave + q, m0 = 16 * (ti >> 2), n0 = 16 * (ti & 3); \
        const f32x4 x = mm64(Ys, m0, YTs, n0, zero4, lane); st_tile(Yd, m0, n0, x, lane); st_tile_T(YTd, m0, n0, x, lane); } } while (0)
#define R1_STAGE_B(Ps, YTn, Pd) do { _Pragma("unroll") for (int q = 0; q < 2; ++q) { const int ti = 2 * wave + q, m0 = 16 * (ti >> 2), n0 = 16 * (ti & 3); \
        accP[q] = mm64(Ps, m0, YTn, n0, accP[q], lane); st_tile(Pd, m0, n0, accP[q], lane); } } while (0)
    R1_STAGE_A(A0, A1, B0, B2);
    WG_SYNC();
#pragma unroll 1
    for (int it = 1; it <= 5; ++it) {
        const int nxt = it & 1;
        LDSP Ps = nxt ? A2 : B4, Pd = nxt ? B4 : A2, YTn = nxt ? B2 : A1;
        R1_STAGE_B(Ps, YTn, Pd);
        if (it < 5) { LDSP Ys = nxt ? B0 : A0, YTs = nxt ? B2 : A1, Yd = nxt ? A0 : B0, YTd = nxt ? A1 : B2; R1_STAGE_A(Ys, YTs, Yd, YTd); }
        WG_SYNC();
    }
#undef R1_STAGE_A
#undef R1_STAGE_B
#pragma unroll
    for (int q = 0; q < 2; ++q) {
        const int ti = 2 * wave + q, m0 = 16 * (ti >> 2), n0 = 16 * (ti & 3);
        st_tile(B6, m0, n0, mm64(B1, m0, B4, n0, zero4, lane), lane);
        st_tile(A0, m0, n0, mm64(B7, m0, A3, n0, zero4, lane), lane);
    }
    WG_SYNC();
#pragma unroll
    for (int q = 0; q < 2; ++q) {
        const int ti = 2 * wave + q, m0 = 16 * (ti >> 2), n0 = 16 * (ti & 3);
        st_tile(A1, m0, n0, mm64(A0, m0, B4, n0, zero4, lane), lane);
        f32x4 x = mm64(B6, m0, B3, n0, zero4, lane);
        { const int jp = n0 + r; const float gj = gam[jp]; u32x2 w;
          float y[4];
#pragma unroll
          for (int reg = 0; reg < 4; ++reg) y[reg] = (x[reg] + ((m0 + 4 * g4 + reg) == jp ? 1.f : 0.f)) * gj;
          w.x = pk2(y[0], y[1]); w.y = pk2(y[2], y[3]);
          *(u32x2*)((bf16_t*)(p.ws + WS_PCT) + (size_t)u * 4096 + jp * 64 + m0 + 4 * g4) = w; }
        x = mm64(A4, m0, B6, n0, zero4, lane);
        { bf16_t* Q = (bf16_t*)(p.ws + WS_QTT) + (size_t)u * 4096;
#pragma unroll
          for (int reg = 0; reg < 4; ++reg) { const int t = m0 + 4 * g4 + reg; Q[t * 64 + n0 + r] = (bf16_t)f2bf(x[reg] + RtF[t * 65 + n0 + r]); } }
    }
    WG_SYNC();
#pragma unroll
    for (int q = 0; q < 2; ++q) {
        const int ti = 2 * wave + q, m0 = 16 * (ti >> 2), n0 = 16 * (ti & 3);
        f32x4 x = mm64(B3, m0, A1, n0, zero4, lane); x = mm64(B5, m0, B7, n0, x, lane);
#pragma unroll
        for (int reg = 0; reg < 4; ++reg) x[reg] *= gam[m0 + 4 * g4 + reg];
        *(f32x4*)((float*)(p.ws + WS_UCS) + (size_t)u * 4096 + (n0 + r) * 64 + m0 + 4 * g4) = x;
        x = mm64(A4, m0, A1, n0, zero4, lane); x = mm64(A5, m0, B7, n0, x, lane);
        *(f32x4*)((float*)(p.ws + WS_YLT) + (size_t)u * 4096 + (ti * 64 + lane) * 4) = x;
    }
    WG_SYNC();
}

DEV void r2_chain(const Params& p, int l, int task, int lane) {
    const int h = task >> 2, q = task & 3, r = lane & 15, g4 = lane >> 4, i = 16 * q + r;
    const bf16_t* PCT = (const bf16_t*)(p.ws + WS_PCT); const float* UCS = (const float*)(p.ws + WS_UCS); bf16_t* SC = (bf16_t*)(p.ws + WS_SC);
    f32x4 S[4];
#pragma unroll
    for (int mt = 0; mt < 4; ++mt) S[mt] = (f32x4){0.f, 0.f, 0.f, 0.f};
    bf16x4 a0[4][2], a1[4][2]; f32x4 ci[4];
#define R2_LOAD(cc) do { const size_t u_ = (size_t)(cc) * AH + h; _Pragma("unroll") for (int mt = 0; mt < 4; ++mt) { ci[mt] = *(const f32x4*)(UCS + u_ * 4096 + i * 64 + 16 * mt + 4 * g4); \
        _Pragma("unroll") for (int ks = 0; ks < 2; ++ks) { a0[mt][ks] = *(const bf16x4*)(PCT + u_ * 4096 + (16 * mt + r) * 64 + 32 * ks + 4 * g4); a1[mt][ks] = *(const bf16x4*)(PCT + u_ * 4096 + (16 * mt + r) * 64 + 32 * ks + 16 + 4 * g4); } } } while (0)
    R2_LOAD(0);
#pragma unroll 1
    for (int c = 0; c < NCH; ++c) {
        const size_t u = (size_t)c * AH + h;
        bf16x8 pb[2];
#pragma unroll
        for (int ks = 0; ks < 2; ++ks) pb[ks] = pack8(S[2 * ks], S[2 * ks + 1]);
#pragma unroll
        for (int mt = 0; mt < 4; ++mt) { u32x2 w; w.x = pk2(S[mt][0], S[mt][1]); w.y = pk2(S[mt][2], S[mt][3]); *(u32x2*)(SC + u * 4096 + i * 64 + 16 * mt + 4 * g4) = w; }
        bf16x8 af[4][2]; f32x4 cc[4];
#pragma unroll
        for (int mt = 0; mt < 4; ++mt) { cc[mt] = ci[mt];
#pragma unroll
            for (int ks = 0; ks < 2; ++ks) af[mt][ks] = (bf16x8){a0[mt][ks][0], a0[mt][ks][1], a0[mt][ks][2], a0[mt][ks][3], a1[mt][ks][0], a1[mt][ks][1], a1[mt][ks][2], a1[mt][ks][3]}; }
        if (c + 1 < NCH) R2_LOAD(c + 1);
#pragma unroll
        for (int mt = 0; mt < 4; ++mt) { f32x4 x = MFMA16(af[mt][0], pb[0], cc[mt]); S[mt] = MFMA16(af[mt][1], pb[1], x); }
    }
#undef R2_LOAD
    float* o = p.out + O_PWKV + ((size_t)l * AH + h) * 4096;
#pragma unroll
    for (int mt = 0; mt < 4; ++mt) *(f32x4*)(o + i * 64 + 16 * mt + 4 * g4) = S[mt];
}
DEV void r2_sample(const Params& p, int l, int task, int lane) {
    const int q = task & 3, bh = task >> 2, r = lane & 15, g4 = lane >> 4, i = 16 * q + r;
    const size_t u = (size_t)NUP + bh;
    const bf16_t* PCT = (const bf16_t*)(p.ws + WS_PCT) + u * 4096; const float* UCS = (const float*)(p.ws + WS_UCS) + u * 4096;
    const float* S0 = PIN(p, I_SWKV) + ((size_t)l * DECB * AH + bh) * 4096;
    bf16x8 pb[2];
#pragma unroll
    for (int ks = 0; ks < 2; ++ks) { const f32x4 lo = *(const f32x4*)(S0 + i * 64 + 32 * ks + 8 * g4), hi = *(const f32x4*)(S0 + i * 64 + 32 * ks + 8 * g4 + 4); pb[ks] = pack8(lo, hi); }
    float* o = p.out + O_SWKV + ((size_t)l * DECB * AH + bh) * 4096;
#pragma unroll
    for (int mt = 0; mt < 4; ++mt) {
        f32x4 x = *(const f32x4*)(UCS + i * 64 + 16 * mt + 4 * g4);
#pragma unroll
        for (int ks = 0; ks < 2; ++ks) { const bf16x8 a = *(const bf16x8*)(PCT + (16 * mt + r) * 64 + 32 * ks + 8 * g4); x = MFMA16(a, pb[ks], x); }
        *(f32x4*)(o + i * 64 + 16 * mt + 4 * g4) = x;
    }
}

DEV void r3_work(const Params& p, int l, int u, int mt, int lane) {
    const bool samp = u >= NUP; int c = 0, b = 0, h;
    if (!samp) { c = u / AH; h = u % AH; } else { const int s = u - NUP; b = s / AH; h = s % AH; if (mt > 0) return; }
    const int r = lane & 15, g4 = lane >> 4;
    const bf16_t* Q = (const bf16_t*)(p.ws + WS_QTT) + (size_t)u * 4096;
    bf16x8 a[2];
#pragma unroll
    for (int ks = 0; ks < 2; ++ks) a[ks] = *(const bf16x8*)(Q + (16 * mt + r) * 64 + 32 * ks + 8 * g4);
    f32x4 acc[4];
#pragma unroll
    for (int nt = 0; nt < 4; ++nt) {
        acc[nt] = *(const f32x4*)((const float*)(p.ws + WS_YLT) + (size_t)u * 4096 + ((mt * 4 + nt) * 64 + lane) * 4);
#pragma unroll
        for (int ks = 0; ks < 2; ++ks) {
            bf16x8 bb;
            if (!samp) bb = *(const bf16x8*)((const bf16_t*)(p.ws + WS_SC) + (size_t)u * 4096 + (16 * nt + r) * 64 + 32 * ks + 8 * g4);
            else { const float* S0 = PIN(p, I_SWKV) + (((size_t)l * DECB + b) * AH + h) * 4096 + (16 * nt + r) * 64 + 32 * ks + 8 * g4; bb = pack8(*(const f32x4*)S0, *(const f32x4*)(S0 + 4)); }
            acc[nt] = MFMA16(a[ks], bb, acc[nt]);
        }
    }
    float mean[4], rs[4];
#pragma unroll
    for (int reg = 0; reg < 4; ++reg) {
        float s = (acc[0][reg] + acc[1][reg]) + (acc[2][reg] + acc[3][reg]);
        s += SHFL_XOR(s, 1); s += SHFL_XOR(s, 2); s += SHFL_XOR(s, 4); s += SHFL_XOR(s, 8);
        const float mn = s * (1.0f / 64.0f); float v = 0.f;
#pragma unroll
        for (int nt = 0; nt < 4; ++nt) { const float d = acc[nt][reg] - mn; v += d * d; }
        v += SHFL_XOR(v, 1); v += SHFL_XOR(v, 2); v += SHFL_XOR(v, 4); v += SHFL_XOR(v, 8);
        mean[reg] = mn; rs[reg] = RSQRTF(v * (1.0f / 64.0f) + GN_EPS);
    }
    bf16_t* YA = (bf16_t*)(p.ws + WS_YA);
#pragma unroll
    for (int nt = 0; nt < 4; ++nt) {
        const int i = 16 * nt + r; const float gain = PIN(p, I_GNG)[(size_t)l * AW + 64 * h + i], bias = PIN(p, I_GNB)[(size_t)l * AW + 64 * h + i];
        const u32x2 g2 = *(const u32x2*)((const bf16_t*)(p.ws + WS_GT) + (size_t)u * 4096 + i * 64 + 16 * mt + 4 * g4);
        const u32x2 b2 = *(const u32x2*)((const bf16_t*)(p.ws + WS_BNT) + (size_t)u * 4096 + i * 64 + 16 * mt + 4 * g4);
        const float gg[4] = {bf2f(g2.x & 0xffffu), bf2f(g2.x >> 16), bf2f(g2.y & 0xffffu), bf2f(g2.y >> 16)};
        const float bn[4] = {bf2f(b2.x & 0xffffu), bf2f(b2.x >> 16), bf2f(b2.y & 0xffffu), bf2f(b2.y >> 16)};
#pragma unroll
        for (int reg = 0; reg < 4; ++reg) {
            const int t = 16 * mt + 4 * g4 + reg; const size_t row = samp ? (size_t)SEQ + 16 * b + t : (size_t)64 * c + t;
            const float y = ((acc[nt][reg] - mean[reg]) * rs[reg] * gain + bias + bn[reg]) * gg[reg];
            YA[row * AW + 64 * h + i] = (bf16_t)f2bf(y);
        }
    }
}

constexpr int AT_KB = 0, AT_VT = 24576, AT_QB = 49152;
constexpr float QSCALE = 0.125f * LOG2E;
DEV void attn_unit(const Params& p, int l, int au, LDSP lds, int tid) {
    const int lane = tid & 63, wave = WAVE_ID(tid), r = lane & 15, g4 = lane >> 4;
    const bool samp = au >= NAP; int c = 0, b = 0, kh, nk, kbase = 0, nq;
    if (!samp) { c = au / BKV; kh = au % BKV; nk = 64 * (c + 1 < 3 ? c + 1 : 3); kbase = 64 * (c > 2 ? c - 2 : 0); nq = 64 * GRP; }
    else { const int s = au - NAP; b = s / BKV; kh = s % BKV; nk = WIN + DECS; nq = DECS * GRP; }
    const float* PF = (const float*)(p.ws + WS_PF); const float* rope = (const float*)(p.ws + WS_ROPE);
    LDSP Kb = lds + AT_KB, Vt = lds + AT_VT, Qb = lds + AT_QB;
    const int sub = tid & 7, rowi = tid >> 3;
#pragma unroll 1
    for (int pp = 0; pp < 3; ++pp) {
        const int kidx = pp * 64 + rowi;
        if (kidx < nk) {
            f32x4 k1, k2, v1, v2;
            if (samp && kidx < WIN) {
                const size_t o = ((((size_t)l * DECB + b) * WIN + kidx) * BKV + kh) * 64;
                k1 = *(const f32x4*)(PIN(p, I_CK) + o + 4 * sub); k2 = *(const f32x4*)(PIN(p, I_CK) + o + 32 + 4 * sub);
                v1 = *(const f32x4*)(PIN(p, I_CV) + o + 4 * sub); v2 = *(const f32x4*)(PIN(p, I_CV) + o + 32 + 4 * sub);
            }
            if (!(samp && kidx < WIN)) {
                const size_t tok = samp ? (size_t)SEQ + 16 * b + (kidx - WIN) : (size_t)kbase + kidx;
                const int slot = samp ? SEQ + (kidx - WIN) : (int)tok;
                const float* src = PF + tok * FW;
                const f32x4 x1 = *(const f32x4*)(src + C_BK + 64 * kh + 4 * sub), x2 = *(const f32x4*)(src + C_BK + 64 * kh + 32 + 4 * sub);
                v1 = *(const f32x4*)(src + C_BV + 64 * kh + 4 * sub); v2 = *(const f32x4*)(src + C_BV + 64 * kh + 32 + 4 * sub);
                float ss = (x1[0] * x1[0] + x1[1] * x1[1]) + (x1[2] * x1[2] + x1[3] * x1[3]) + (x2[0] * x2[0] + x2[1] * x2[1]) + (x2[2] * x2[2] + x2[3] * x2[3]);
                ss += SHFL_XOR(ss, 1); ss += SHFL_XOR(ss, 2); ss += SHFL_XOR(ss, 4);
                const float rinv = RSQRTF(ss * (1.0f / 64.0f) + RMS_EPS);
                const f32x4 gn1 = *(const f32x4*)(PIN(p, I_KN) + (size_t)l * 64 + 4 * sub), gn2 = *(const f32x4*)(PIN(p, I_KN) + (size_t)l * 64 + 32 + 4 * sub);
                const f32x4 cs0 = *(const f32x4*)(rope + (size_t)slot * 64 + 8 * sub), cs1 = *(const f32x4*)(rope + (size_t)slot * 64 + 8 * sub + 4);
                const float cc[4] = {cs0[0], cs0[2], cs1[0], cs1[2]}, sn[4] = {cs0[1], cs0[3], cs1[1], cs1[3]};
#pragma unroll
                for (int e = 0; e < 4; ++e) { const float y1 = x1[e] * rinv * gn1[e], y2 = x2[e] * rinv * gn2[e]; k1[e] = y1 * cc[e] - y2 * sn[e]; k2[e] = y2 * cc[e] + y1 * sn[e]; }
                if (samp) { const size_t o = ((((size_t)l * DECB + b) * DECS + (kidx - WIN)) * BKV + kh) * 64;
                    *(f32x4*)(p.out + O_SK + o + 4 * sub) = k1; *(f32x4*)(p.out + O_SK + o + 32 + 4 * sub) = k2; *(f32x4*)(p.out + O_SV + o + 4 * sub) = v1; *(f32x4*)(p.out + O_SV + o + 32 + 4 * sub) = v2; }
                else if (kidx >= nk - 64 && tok >= (size_t)(SEQ - WIN)) { const size_t o = (((size_t)l * WIN + (tok - (SEQ - WIN))) * BKV + kh) * 64;
                    *(f32x4*)(p.out + O_PK + o + 4 * sub) = k1; *(f32x4*)(p.out + O_PK + o + 32 + 4 * sub) = k2; *(f32x4*)(p.out + O_PV + o + 4 * sub) = v1; *(f32x4*)(p.out + O_PV + o + 32 + 4 * sub) = v2; }
            }
            u32x2 w; w.x = pk2(k1[0], k1[1]); w.y = pk2(k1[2], k1[3]); *(LAS u32x2*)(Kb + swz(kidx, 4 * sub)) = w;
            w.x = pk2(k2[0], k2[1]); w.y = pk2(k2[2], k2[3]); *(LAS u32x2*)(Kb + swz(kidx, 32 + 4 * sub)) = w;
#pragma unroll
            for (int e = 0; e < 4; ++e) { *(LAS bf16_t*)(Vt + swz192(4 * sub + e, kidx)) = (bf16_t)f2bf(v1[e]); *(LAS bf16_t*)(Vt + swz192(32 + 4 * sub + e, kidx)) = (bf16_t)f2bf(v2[e]); }
        } else if (kidx < ((nk + 31) & ~31)) {
#pragma unroll
            for (int e = 0; e < 4; ++e) { *(LAS bf16_t*)(Vt + swz192(4 * sub + e, kidx)) = 0; *(LAS bf16_t*)(Vt + swz192(32 + 4 * sub + e, kidx)) = 0; }
        }
    }
#pragma unroll 1
    for (int pp = 0; pp < GRP; ++pp) {
        const int q = pp * 64 + rowi;
        if (q < nq) {
            const int g = samp ? q >> 4 : q >> 6, t = samp ? q & 15 : q & 63, head = kh * GRP + g;
            const size_t tok = samp ? (size_t)SEQ + 16 * b + t : (size_t)64 * c + t; const int slot = samp ? SEQ + t : (int)tok;
            const float* src = PF + tok * FW + C_Q + 64 * head;
            const f32x4 x1 = *(const f32x4*)(src + 4 * sub), x2 = *(const f32x4*)(src + 32 + 4 * sub);
            float ss = (x1[0] * x1[0] + x1[1] * x1[1]) + (x1[2] * x1[2] + x1[3] * x1[3]) + (x2[0] * x2[0] + x2[1] * x2[1]) + (x2[2] * x2[2] + x2[3] * x2[3]);
            ss += SHFL_XOR(ss, 1); ss += SHFL_XOR(ss, 2); ss += SHFL_XOR(ss, 4);
            const float rinv = RSQRTF(ss * (1.0f / 64.0f) + RMS_EPS) * QSCALE;
            const f32x4 gn1 = *(const f32x4*)(PIN(p, I_QN) + (size_t)l * 64 + 4 * sub), gn2 = *(const f32x4*)(PIN(p, I_QN) + (size_t)l * 64 + 32 + 4 * sub);
            const f32x4 cs0 = *(const f32x4*)(rope + (size_t)slot * 64 + 8 * sub), cs1 = *(const f32x4*)(rope + (size_t)slot * 64 + 8 * sub + 4);
            const float cc[4] = {cs0[0], cs0[2], cs1[0], cs1[2]}, sn[4] = {cs0[1], cs0[3], cs1[1], cs1[3]};
            float o1[4], o2[4];
#pragma unroll
            for (int e = 0; e < 4; ++e) { const float y1 = x1[e] * rinv * gn1[e], y2 = x2[e] * rinv * gn2[e]; o1[e] = y1 * cc[e] - y2 * sn[e]; o2[e] = y2 * cc[e] + y1 * sn[e]; }
            u32x2 w; w.x = pk2(o1[0], o1[1]); w.y = pk2(o1[2], o1[3]); *(LAS u32x2*)(Qb + swz(q, 4 * sub)) = w;
            w.x = pk2(o2[0], o2[1]); w.y = pk2(o2[2], o2[3]); *(LAS u32x2*)(Qb + swz(q, 32 + 4 * sub)) = w;
        }
    }
    WG_SYNC();
    const int nqt = nq >> 4, nkt = nk >> 4;
    bf16_t* YB = (bf16_t*)(p.ws + WS_YB);
#pragma unroll 1
    for (int qt = wave; qt < nqt; qt += NWAVES) {
        const int g = samp ? qt : qt >> 2, head = kh * GRP + g;
        const float sink2 = PIN(p, I_SINK)[(size_t)l * BH + head] * LOG2E;
        bf16x8 bq[2];
#pragma unroll
        for (int ks = 0; ks < 2; ++ks) bq[ks] = *(const LAS bf16x8*)(Qb + swz(16 * qt + r, 32 * ks + 8 * g4));
        f32x4 s[12];
#pragma unroll
        for (int kt = 0; kt < 12; ++kt) { s[kt] = (f32x4){0.f, 0.f, 0.f, 0.f};
            if (kt < nkt) {
#pragma unroll
                for (int ks = 0; ks < 2; ++ks) { const bf16x8 a = *(const LAS bf16x8*)(Kb + swz(16 * kt + r, 32 * ks + 8 * g4)); s[kt] = MFMA16(a, bq[ks], s[kt]); } } }
        float mx = sink2;
#pragma unroll
        for (int kt = 0; kt < 12; ++kt) if (kt < nkt) mx = fmaxf(fmaxf(mx, fmaxf(s[kt][0], s[kt][1])), fmaxf(s[kt][2], s[kt][3]));
        mx = fmaxf(mx, SHFL_XOR(mx, 16)); mx = fmaxf(mx, SHFL_XOR(mx, 32));
        float sum = 0.f;
#pragma unroll
        for (int kt = 0; kt < 12; ++kt) if (kt < nkt) {
#pragma unroll
            for (int e = 0; e < 4; ++e) { s[kt][e] = EXP2F(s[kt][e] - mx); sum += s[kt][e]; } }
        sum += SHFL_XOR(sum, 16); sum += SHFL_XOR(sum, 32);
        const float rden = 1.0f / (sum + EXP2F(sink2 - mx));
        f32x4 o[4];
#pragma unroll
        for (int dt = 0; dt < 4; ++dt) o[dt] = (f32x4){0.f, 0.f, 0.f, 0.f};
#pragma unroll
        for (int s2 = 0; s2 < 6; ++s2) if (2 * s2 < nkt) {
            const bf16x8 pb = pack8(s[2 * s2], s[2 * s2 + 1]);
#pragma unroll
            for (int dt = 0; dt < 4; ++dt) {
                const bf16x4 lo = *(const LAS bf16x4*)(Vt + swz192(16 * dt + r, 32 * s2 + 4 * g4)), hi = *(const LAS bf16x4*)(Vt + swz192(16 * dt + r, 32 * s2 + 16 + 4 * g4));
                o[dt] = MFMA16(((bf16x8){lo[0], lo[1], lo[2], lo[3], hi[0], hi[1], hi[2], hi[3]}), pb, o[dt]);
            }
        }
        const int q = 16 * qt + r, t = samp ? q & 15 : q & 63; const size_t tok = samp ? (size_t)SEQ + 16 * b + t : (size_t)64 * c + t;
#pragma unroll
        for (int dt = 0; dt < 4; ++dt) { u32x2 w; w.x = pk2(o[dt][0] * rden, o[dt][1] * rden); w.y = pk2(o[dt][2] * rden, o[dt][3] * rden); *(u32x2*)(YB + tok * BQ + 64 * head + 16 * dt + 4 * g4) = w; }
    }
    WG_SYNC();
}

#ifndef EMU
#define XB_TMO      128
#define XB_XCNT(j)  (256  + 64 * (j))
#define XB_XSUB(j)  (1280 + 64 * (j))
#define XB_XGEN(j)  (2304 + 64 * (j))
#define XB_TOP      3328
#define XB_TOPGEN   3392
#define XCD_BAR_WORDS 3456
#define XB_SPIN_CAP (1u << 18)

__device__ __forceinline__ unsigned xb_ld(unsigned* p)              { return __hip_atomic_load(p, __ATOMIC_RELAXED, __HIP_MEMORY_SCOPE_AGENT); }
__device__ __forceinline__ unsigned xb_add(unsigned* p, unsigned v) { return __hip_atomic_fetch_add(p, v, __ATOMIC_RELAXED, __HIP_MEMORY_SCOPE_AGENT); }
__device__ __forceinline__ unsigned xb_xcc_id() { return (unsigned)__builtin_amdgcn_s_getreg((3 << 11) | 20) & 0xFu; }
#define XB_SPIN(cond, bar) do { unsigned _sp = 0; while (cond) { __builtin_amdgcn_s_sleep(1); \
    if ((++_sp & 255u) == 0u) { if (xb_ld(&(bar)[XB_TMO])) break; if (_sp > XB_SPIN_CAP) { atomicAdd(&(bar)[XB_TMO], 1u); break; } } } } while (0)

struct XcdBarrier {
    unsigned* bar; unsigned x;
    volatile LAS unsigned* st;
};

__device__ __forceinline__ XcdBarrier xcd_barrier_post(unsigned* bar, volatile LAS unsigned* st) {
    XcdBarrier b; b.bar = bar; b.x = xb_xcc_id(); b.st = st;
    if (threadIdx.x == 0) (void)xb_add(&bar[XB_XCNT(b.x)], 1u);
    return b;
}
__device__ __forceinline__ void xcd_barrier_complete(unsigned* bar, unsigned x, unsigned& nloc, unsigned& nx) {
    const unsigned G = gridDim.x * gridDim.y * gridDim.z;
    unsigned sum, cnt, mine, sp = 0u;
    for (;;) {
        sum = 0u; cnt = 0u; mine = 0u;
#pragma unroll
        for (unsigned j = 0; j < 16; ++j) { const unsigned c = xb_ld(&bar[XB_XCNT(j)]); sum += c; cnt += (c > 0u) ? 1u : 0u; mine = (j == x) ? c : mine; }
        if (sum == G) break;
        __builtin_amdgcn_s_sleep(1);
        if ((++sp & 255u) == 0u) { if (xb_ld(&bar[XB_TMO])) break; if (sp > XB_SPIN_CAP) { atomicAdd(&bar[XB_TMO], 1u); break; } }
    }
    nloc = mine > 0u ? mine : 1u; nx = cnt > 0u ? cnt : 1u;
}

__device__ __forceinline__ void xcd_barrier(const XcdBarrier& b) {
    asm volatile("s_waitcnt vmcnt(0)" ::: "memory");
    __syncthreads();
    if (threadIdx.x == 0) {
        unsigned* bar = b.bar;
        __builtin_amdgcn_s_waitcnt(0);
        unsigned nloc = b.st[0], nx = b.st[1];
        if (nloc == 0u) { xcd_barrier_complete(bar, b.x, nloc, nx); b.st[0] = nloc; b.st[1] = nx; }
        const unsigned old = xb_add(&bar[XB_XSUB(b.x)], 1u);
        const unsigned gen = old / nloc;
        if (old + 1u == (gen + 1u) * nloc) {
            __builtin_amdgcn_fence(__ATOMIC_RELEASE, "agent");
            asm volatile("s_waitcnt vmcnt(0)" ::: "memory");
            const unsigned og = xb_add(&bar[XB_TOP], 1u);
            const unsigned tg = og / nx;
            if (og + 1u == (tg + 1u) * nx) xb_add(&bar[XB_TOPGEN], 1u);
            else XB_SPIN(xb_ld(&bar[XB_TOPGEN]) == tg, bar);
            __builtin_amdgcn_fence(__ATOMIC_ACQUIRE, "agent");
            xb_add(&bar[XB_XGEN(b.x)], 1u);
            asm volatile("s_waitcnt vmcnt(0)" ::: "memory");
        } else {
            XB_SPIN(xb_ld(&bar[XB_XGEN(b.x)]) == gen, bar);
            __builtin_amdgcn_fence(__ATOMIC_ACQUIRE, "agent");
            asm volatile("s_waitcnt vmcnt(0)" ::: "memory");
        }
    }
    __syncthreads();
}
#endif

#ifndef EMU
#define GRID_BAR() xcd_barrier(bar)
constexpr int CW_BAR = 4096;
__global__ void __launch_bounds__(NTHR, 2) fwd(Params p) {
    extern __shared__ __attribute__((aligned(16))) unsigned char lds_raw[];
    LDSP lds = (LDSP)lds_raw;
    const int wave = __builtin_amdgcn_readfirstlane(TID() >> 6), G = GRID(), bid = BID();
    for (int u = TID(); u < (LDS_BYTES - LDS_CTL_OFF) / 4; u += NTHR) ((LAS unsigned*)(lds + LDS_CTL_OFF))[u] = 0u;
    __syncthreads();
    XcdBarrier bar = xcd_barrier_post((unsigned*)(p.ws + WS_CTL) + CW_BAR, (volatile LAS unsigned*)(lds + LDS_CTL_OFF + 32));
#else
#define GRID_BAR() emu_grid_sync()
static void fwd(Params p) {
    LDSP lds = emu_lds();
    const int wave = TID() >> 6, G = GRID(), bid = BID();
#endif
    const int gw = bid * NWAVES + wave, NGW = G * NWAVES, NGT = G * NTHR;
#define LANE_TID() const int lane = FRESH_LANE(), tid = wave * 64 + lane; (void)tid
    bf16_t* H = (bf16_t*)(p.ws + WS_H); float* X = p.out;


#ifndef SKIP_PRO
    { LANE_TID(); prologue(p, lds, gw, NGW, wave, lane, bid * NTHR + tid, NGT); }
#endif

#pragma unroll 1
    for (int it = 0; it < 2 * DEPTH; ++it) {
        const int l = it >> 1; const bool sec = (it & 1) != 0;
        { LANE_TID(); norm_phase(p, PIN(p, sec ? I_NFF2 : I_NFF1) + (size_t)l * DM, it == 0, gw, NGW, lane); }
        GRID_BAR();

#ifndef SKIP_GU
        { pg8::Gemm g{H, lwp(p, l, sec ? OFF_WGU2 : OFF_WGU1), M, 2 * DFF, DM}; pg8::StaticOrder S; S.init(M, 2 * DFF, G, bid);
          EpiSwiglu E{(bf16_t*)(p.ws + WS_G)};
          pg8::gemm_phase<EpiSwiglu, pg8::StaticOrder, true, true>(lds, g, S, E, wave); }
#endif

        GRID_BAR();

#ifndef SKIP_DOWN
        { pg8::Gemm g{(const bf16_t*)(p.ws + WS_G), lwp(p, l, sec ? OFF_WD2 : OFF_WD1), M, DM, DFF}; pg8::StaticOrder S; S.init(M, DM, G, bid);
          EpiResid E{X, 0.5f};
          pg8::gemm_phase<EpiResid, pg8::StaticOrder, true, true>(lds, g, S, E, wave); }
#endif

        if (it == 2 * DEPTH - 1) break;
        GRID_BAR();
        if (!sec) {
            { LANE_TID(); norm_phase(p, PIN(p, I_NMIX) + (size_t)l * DM, false, gw, NGW, lane); }
            GRID_BAR();

#ifndef SKIP_WIN
            { pg8::Gemm g{H, lwp(p, l, OFF_WIN), M, NIN, DM}; pg8::StaticOrder S; S.init(M, NIN, G, bid);
              EpiWin E{(float*)(p.ws + WS_PF), (bf16_t*)(p.ws + WS_SG)};
              pg8::gemm_phase<EpiWin, pg8::StaticOrder, true, true>(lds, g, S, E, wave); }
#endif

            GRID_BAR();

#ifndef SKIP_R1
#pragma unroll 1
            for (int u = bid; u < NU; u += G) { LANE_TID(); r1_unit(p, l, u, lds, tid); }
#endif

            GRID_BAR();

#ifndef SKIP_R2
            { constexpr int nchain = 4 * AH; LANE_TID();
              if (G > nchain) {
                  if (bid < nchain) { if (wave == 0) r2_chain(p, l, bid, lane); }
                  else { const int ob = bid - nchain, OG = G - nchain;
#pragma unroll 1
                      for (int au = ob; au < NA; au += OG) attn_unit(p, l, au, lds, tid);
#pragma unroll 1
                      for (int task = ob * NWAVES + wave; task < 4 * NUS; task += OG * NWAVES) r2_sample(p, l, task, lane); }
              } else {
                  if (wave == 0) {
#pragma unroll 1
                      for (int task = bid; task < nchain; task += G) r2_chain(p, l, task, lane); }
#pragma unroll 1
                  for (int au = bid; au < NA; au += G) attn_unit(p, l, au, lds, tid);
#pragma unroll 1
                  for (int task = gw; task < 4 * NUS; task += NGW) r2_sample(p, l, task, lane);
              } }
#endif

            GRID_BAR();

#ifndef SKIP_R3
            { const int worker = bid * 2 + (wave >> 2), NW = 2 * G; LANE_TID(); const int gtid = bid * NTHR + tid;
#pragma unroll 1
              for (int u = worker; u < NU; u += NW) r3_work(p, l, u, wave & 3, lane);
              const float* PF = (const float*)(p.ws + WS_PF);
              for (int idx = gtid; idx < (1 + DECB) * ACOLS; idx += NGT) { const int s = idx / ACOLS, col = idx % ACOLS;
                  if (s == 0) p.out[O_PSH + (size_t)l * ACOLS + col] = PF[(size_t)(SEQ - 1) * FW + col];
                  else p.out[O_SSH + ((size_t)l * DECB + (s - 1)) * ACOLS + col] = PF[((size_t)SEQ + 16 * (s - 1) + 15) * FW + col]; } }
#endif

            GRID_BAR();

#ifndef SKIP_UPA
            { pg8::Gemm g{(const bf16_t*)(p.ws + WS_YA), lwp(p, l, OFF_WUA), M, DM, AW}; pg8::StaticOrder S; S.init(M, DM, G, bid);
              EpiUpA E{(const bf16_t*)(p.ws + WS_SG), (float*)(p.ws + WS_T1)};
              pg8::gemm_phase<EpiUpA, pg8::StaticOrder, true, true>(lds, g, S, E, wave); }
#endif

            GRID_BAR();

#ifndef SKIP_UPB
            { pg8::Gemm g{(const bf16_t*)(p.ws + WS_YB), lwp(p, l, OFF_WUB), M, DM, BQ}; pg8::StaticOrder S; S.init(M, DM, G, bid);
              EpiUpB E{(const bf16_t*)(p.ws + WS_SG), (const float*)(p.ws + WS_T1), (bf16_t*)(p.ws + WS_MG)};
              pg8::gemm_phase<EpiUpB, pg8::StaticOrder, true, true>(lds, g, S, E, wave); }
#endif

            GRID_BAR();

#ifndef SKIP_WO
            { pg8::Gemm g{(const bf16_t*)(p.ws + WS_MG), lwp(p, l, OFF_WO), M, DM, DM}; pg8::StaticOrder S; S.init(M, DM, G, bid);
              EpiResid E{X, 1.0f};
              pg8::gemm_phase<EpiResid, pg8::StaticOrder, true, true>(lds, g, S, E, wave); }
#endif

            GRID_BAR();
        }
    }
}

#ifndef EMU
extern "C" void kernel_launch(void* const* d_in, const int* in_sizes, int n_in, void* d_out, int out_size, void* d_ws, size_t ws_size, hipStream_t stream) {
    static int grid = 0;
    if (grid == 0) {
        if (n_in != 33 || (size_t)out_size != O_END || ws_size < WS_END) { fprintf(stderr, "kernel_launch: unexpected shapes (n_in %d, out %d, ws %zu, need %zu)\n", n_in, out_size, ws_size, (size_t)WS_END); grid = -1; return; }
        int dev = 0, cus = 0, per_cu = 0;
        if (hipGetDevice(&dev) != hipSuccess || hipDeviceGetAttribute(&cus, hipDeviceAttributeMultiprocessorCount, dev) != hipSuccess) { grid = -1; return; }
        if (hipFuncSetAttribute((const void*)fwd, hipFuncAttributeMaxDynamicSharedMemorySize, LDS_BYTES) != hipSuccess) { fprintf(stderr, "kernel_launch: hipFuncSetAttribute failed\n"); grid = -1; return; }
        if (hipOccupancyMaxActiveBlocksPerMultiprocessor(&per_cu, (const void*)fwd, NTHR, LDS_BYTES) != hipSuccess || per_cu < 1) fprintf(stderr, "kernel_launch: occupancy query reports %d\n", per_cu);
        (void)hipGetLastError();
        grid = cus;
    }
    if (grid < 0) return;
    if (hipMemsetAsync((char*)d_ws + WS_CTL, 0, CTL_BYTES, stream) != hipSuccess) return;
    Params p{};
    for (int i = 0; i < 33; ++i) p.in[i] = (const float*)d_in[i];
    p.out = (float*)d_out; p.ws = (unsigned char*)d_ws;
    hipLaunchKernelGGL(fwd, dim3(grid), dim3(NTHR), LDS_BYTES, stream, p);
}
#endif
```

```cpp
#ifndef EMU
#include <hip/hip_runtime.h>
#include <cstdio>
#include <cstdint>
#endif

#ifndef CFG_SMALL
constexpr int DM = 2048, SEQ = 8192, DEPTH = 4, DECB = 32, DECS = 16, PAST = 1024, AW = 1024, BH = 16, BKV = 4, DFF = 5504;
#else
constexpr int DM = 256, SEQ = 256, DEPTH = 2, DECB = 16, DECS = 16, PAST = 1024, AW = 128, BH = 4, BKV = 1, DFF = 384;
#endif
constexpr int HD = 64, AH = AW / HD, DLORA = 64, ILORA = 64, GLORA = 160, WIN = 128, GRP = BH / BKV;
constexpr int ACOLS = 3 * AW + DLORA + ILORA + GLORA, BQ = BH * HD, BKVW = BKV * HD, INCOLS = ACOLS + BQ + 2 * BKVW + 2 * DM;
constexpr int MS = DECB * DECS, M = SEQ + MS;
constexpr int FW_RAW = ACOLS + BQ + 2 * BKVW, FW = ((FW_RAW + 255) / 256) * 256, NIN = FW + 2 * DM;
constexpr int C_R = 0, C_WLO = AW, C_K = AW + DLORA, C_V = 2 * AW + DLORA, C_ALO = 3 * AW + DLORA, C_GLO = C_ALO + ILORA, C_Q = ACOLS, C_BK = ACOLS + BQ, C_BV = C_BK + BKVW;
constexpr int NCH = SEQ / 64, NUP = NCH * AH, NUS = DECB * AH, NU = NUP + NUS;
constexpr int NAP = NCH * BKV, NAS = DECB * BKV, NA = NAP + NAS;
constexpr float RMS_EPS = 1e-6f, GN_EPS = 64e-5f, LOG2E = 1.4426950408889634f;
static_assert(M % 256 == 0 && DM % 256 == 0 && DFF % 128 == 0 && AW % 128 == 0 && BQ % 128 == 0 && FW_RAW % 32 == 0 && DECS == 16 && GRP == 4, "shape constraints");

constexpr size_t O_YP = 0, O_YS = (size_t)SEQ * DM, O_PWKV = O_YS + (size_t)MS * DM, O_PSH = O_PWKV + (size_t)DEPTH * AH * 4096, O_PK = O_PSH + (size_t)DEPTH * ACOLS,
                 O_PV = O_PK + (size_t)DEPTH * WIN * BKVW, O_SWKV = O_PV + (size_t)DEPTH * WIN * BKVW, O_SSH = O_SWKV + (size_t)DEPTH * DECB * AH * 4096,
                 O_SK = O_SSH + (size_t)DEPTH * DECB * ACOLS, O_SV = O_SK + (size_t)DEPTH * DECB * DECS * BKVW, O_END = O_SV + (size_t)DEPTH * DECB * DECS * BKVW;

constexpr size_t al256(size_t x) { return (x + 255) & ~(size_t)255; }
constexpr size_t WS_CTL = 0, CTL_BYTES = 1u << 20;
constexpr size_t WS_ROPE = CTL_BYTES, ROPE_BYTES = al256((size_t)(SEQ + DECS) * 64 * 4);
constexpr size_t WS_W = WS_ROPE + ROPE_BYTES;
constexpr size_t SZ_WGU = (size_t)2 * DFF * DM * 2, SZ_WD = (size_t)DM * DFF * 2, SZ_WIN = (size_t)NIN * DM * 2, SZ_WUA = (size_t)DM * AW * 2, SZ_WUB = (size_t)DM * BQ * 2, SZ_WO = (size_t)DM * DM * 2;
constexpr size_t OFF_WGU1 = 0, OFF_WD1 = OFF_WGU1 + SZ_WGU, OFF_WIN = OFF_WD1 + SZ_WD, OFF_WUA = OFF_WIN + SZ_WIN, OFF_WUB = OFF_WUA + SZ_WUA, OFF_WO = OFF_WUB + SZ_WUB,
                 OFF_WGU2 = OFF_WO + SZ_WO, OFF_WD2 = OFF_WGU2 + SZ_WGU, OFF_DW2T = OFF_WD2 + SZ_WD, OFF_IA2T = OFF_DW2T + (size_t)AW * 64 * 2, OFF_GG2T = OFF_IA2T + (size_t)AW * 64 * 2,
                 LAYER_W_BYTES = al256(OFF_GG2T + (size_t)AW * 160 * 2);
constexpr size_t WS_H = WS_W + (size_t)DEPTH * LAYER_W_BYTES;
constexpr size_t WS_PF = WS_H + al256((size_t)M * DM * 2);
constexpr size_t WS_SG = WS_PF + al256((size_t)M * FW * 4);
constexpr size_t WS_YA = WS_SG + al256((size_t)M * 2 * DM * 2);
constexpr size_t WS_YB = WS_YA + al256((size_t)M * AW * 2);
constexpr size_t WS_MG = WS_YB + al256((size_t)M * BQ * 2);
constexpr size_t WS_OV = WS_MG + al256((size_t)M * DM * 2);
constexpr size_t WS_G = WS_OV;
constexpr size_t WS_T1 = WS_OV;
constexpr size_t WS_PCT = WS_T1 + al256((size_t)M * DM * 4);
constexpr size_t WS_UCS = WS_PCT + (size_t)NU * 8192;
constexpr size_t WS_QTT = WS_UCS + (size_t)NU * 16384;
constexpr size_t WS_YLT = WS_QTT + (size_t)NU * 8192;
constexpr size_t WS_GT = WS_YLT + (size_t)NU * 16384;
constexpr size_t WS_BNT = WS_GT + (size_t)NU * 8192;
constexpr size_t WS_SC = WS_BNT + (size_t)NU * 8192;
constexpr size_t WS_OV_END_A = WS_SC + (size_t)NUP * 8192, WS_OV_END_B = WS_G + al256((size_t)M * DFF * 2);
constexpr size_t WS_END = WS_OV_END_A > WS_OV_END_B ? WS_OV_END_A : WS_OV_END_B;

constexpr int LDS_BYTES = 159744;
constexpr int LDS_CTL_OFF = LDS_BYTES - 1024;
constexpr int NWAVES = 8, NTHR = 512;

typedef unsigned short bf16_t;
typedef short bf16x8 __attribute__((ext_vector_type(8)));
typedef short bf16x4 __attribute__((ext_vector_type(4)));
typedef float f32x4 __attribute__((ext_vector_type(4)));
typedef unsigned u32x4 __attribute__((ext_vector_type(4)));
typedef unsigned u32x2 __attribute__((ext_vector_type(2)));
#ifdef EMU
#define LAS
#define TID() emu_tid()
#define BID() emu_bid()
#define GRID() emu_grid()
#define WG_SYNC() emu_wg_sync()
#define MFMA16(a, b, c) emu_mfma16(a, b, c)
#define SHFL_XOR(v, m) emu_shfl_xor(v, m)
#define DEV static inline
#define DEVM inline
#define EXP2F(x) exp2f(x)
#define RSQRTF(x) (1.0f / sqrtf(x))
#define WAVE_FENCE() emu_wave_sync()
#define WAVE_ID(t) ((t) >> 6)
#define PIN(p, i) ((p).in[i])
#define FRESH_LANE() (emu_tid() & 63)
#define SPIN_WAIT() emu_yield()
#define RCPF(x) (1.0f / (x))
#define LOG2F_(x) log2f(x)
static inline float sum8(float v) { v += emu_shfl_xor(v, 1); v += emu_shfl_xor(v, 2); v += emu_shfl_xor(v, 4); return v; }
static inline float sum16(float v) { v = sum8(v); v += emu_shfl_xor(v, 8); return v; }
static inline float sum64(float v) { v = sum16(v); v += emu_shfl_xor(v, 16); v += emu_shfl_xor(v, 32); return v; }
#define LDS_DRAIN() do { } while (0)
#define COMPILER_FENCE() do { } while (0)
#else
#define LAS __attribute__((address_space(3)))
#define TID() ((int)threadIdx.x)
#define BID() ((int)blockIdx.x)
#define GRID() ((int)gridDim.x)
#define WG_SYNC() __syncthreads()
#define MFMA16(a, b, c) __builtin_amdgcn_mfma_f32_16x16x32_bf16(a, b, c, 0, 0, 0)
#define SHFL_XOR(v, m) __shfl_xor(v, m)
#define DEV __device__ __forceinline__
#define DEVM __device__ __forceinline__
#define EXP2F(x) __builtin_amdgcn_exp2f(x)
#define RSQRTF(x) (1.0f / sqrtf(x))
#define WAVE_FENCE() asm volatile("s_waitcnt lgkmcnt(0)" ::: "memory")
#define WAVE_ID(t) __builtin_amdgcn_readfirstlane((t) >> 6)
#define PIN(p, i) pin_load(i)
#define FRESH_LANE() fresh_lane()
#define SPIN_WAIT() __builtin_amdgcn_s_sleep(1)
#define RCPF(x) __builtin_amdgcn_rcpf(x)
#define LOG2F_(x) __builtin_amdgcn_logf(x)
__device__ __forceinline__ float dpp_add(float v, const int ctrl_sel) {
    const int x = __builtin_bit_cast(int, v); int y;
    if (ctrl_sel == 0) y = __builtin_amdgcn_update_dpp(0, x, 0xB1, 0xF, 0xF, false); else if (ctrl_sel == 1) y = __builtin_amdgcn_update_dpp(0, x, 0x4E, 0xF, 0xF, false);
    else if (ctrl_sel == 2) y = __builtin_amdgcn_update_dpp(0, x, 0x141, 0xF, 0xF, false); else y = __builtin_amdgcn_update_dpp(0, x, 0x140, 0xF, 0xF, false);
    return v + __builtin_bit_cast(float, y);
}
__device__ __forceinline__ float sum8(float v) { v = dpp_add(v, 0); v = dpp_add(v, 1); v = dpp_add(v, 2); return v; }
__device__ __forceinline__ float sum16(float v) { v = sum8(v); v = dpp_add(v, 3); return v; }
__device__ __forceinline__ float sum64(float v) { v = sum16(v); v += __shfl_xor(v, 16); v += __shfl_xor(v, 32); return v; }
#define LDS_DRAIN() asm volatile("s_waitcnt lgkmcnt(0)" ::: "memory")
#define COMPILER_FENCE() asm volatile("" ::: "memory")
__device__ __forceinline__ int fresh_lane() { int l; asm volatile("v_mbcnt_lo_u32_b32 %0, -1, 0\n\tv_mbcnt_hi_u32_b32 %0, -1, %0" : "=v"(l)); return l; }
#endif
typedef LAS unsigned char* LDSP;
constexpr double TWO_PI = 6.283185307179586476925286766559;
#ifdef EMU
static const double ROPE_INV[32] = {1.0, 0.7498942093324559, 0.5623413251903491, 0.4216965034285822, 0.31622776601683794, 0.23713737056616552, 0.1778279410038923, 0.1333521432163324, 0.1, 0.07498942093324558, 0.05623413251903491, 0.042169650342858224, 0.03162277660168379, 0.023713737056616554, 0.01778279410038923, 0.01333521432163324, 0.01, 0.007498942093324558, 0.005623413251903491, 0.004216965034285823, 0.0031622776601683794, 0.0023713737056616554, 0.0017782794100389228, 0.001333521432163324, 0.001, 0.0007498942093324559, 0.0005623413251903491, 0.00042169650342858224, 0.00031622776601683794, 0.00023713737056616554, 0.00017782794100389227, 0.0001333521432163324};
#else
__device__ const double ROPE_INV[32] = {1.0, 0.7498942093324559, 0.5623413251903491, 0.4216965034285822, 0.31622776601683794, 0.23713737056616552, 0.1778279410038923, 0.1333521432163324, 0.1, 0.07498942093324558, 0.05623413251903491, 0.042169650342858224, 0.03162277660168379, 0.023713737056616554, 0.01778279410038923, 0.01333521432163324, 0.01, 0.007498942093324558, 0.005623413251903491, 0.004216965034285823, 0.0031622776601683794, 0.0023713737056616554, 0.0017782794100389228, 0.001333521432163324, 0.001, 0.0007498942093324559, 0.0005623413251903491, 0.00042169650342858224, 0.00031622776601683794, 0.00023713737056616554, 0.00017782794100389227, 0.0001333521432163324};
#endif

struct Params { const float* in[33]; float* out; unsigned char* ws; };
#ifndef EMU
__device__ __forceinline__ const float* pin_load(int i) {
    const __attribute__((address_space(4))) char* k = (const __attribute__((address_space(4))) char*)__builtin_amdgcn_kernarg_segment_ptr();
    asm volatile("" : "+s"(k));
    return *(const float* const __attribute__((address_space(4)))*)(k + 8 * i);
}
#endif
enum { I_XP = 0, I_XS, I_CK, I_CV, I_SWKV, I_SSH, I_NFF1, I_F1G, I_F1U, I_F1D, I_NMIX, I_WIN, I_MU, I_DW0, I_DW2, I_IA0, I_IA2, I_GG2, I_KK, I_KA, I_RK, I_GNG, I_GNB, I_QN, I_KN, I_SINK,
       I_WUA, I_WUB, I_WO, I_NFF2, I_F2G, I_F2U, I_F2D };

#ifdef EMU
DEV unsigned f2bf(float f) { unsigned u = __builtin_bit_cast(unsigned, f); return (u + 0x7fffu + ((u >> 16) & 1u)) >> 16; }
DEV unsigned pk2(float lo, float hi) { return f2bf(lo) | (f2bf(hi) << 16); }
#else
typedef float f32x2_t_ __attribute__((ext_vector_type(2))); typedef __bf16 bf16x2_t_ __attribute__((ext_vector_type(2)));
DEV unsigned pk2(float lo, float hi) { f32x2_t_ v = {lo, hi}; bf16x2_t_ b = __builtin_convertvector(v, bf16x2_t_); return __builtin_bit_cast(unsigned, b); }
DEV unsigned f2bf(float f) { return pk2(f, 0.f) & 0xffffu; }
#endif
DEV float bf2f(unsigned h) { return __builtin_bit_cast(float, h << 16); }
DEV bf16_t* lwp(const Params& p, int l, size_t off) { return (bf16_t*)(p.ws + WS_W + (size_t)l * LAYER_W_BYTES + off); }
DEV float wave_sum(float v) { return sum64(v); }
DEV float sigmoidf_(float x) { return RCPF(1.0f + EXP2F(-x * LOG2E)); }
DEV float tanhf_(float x) { return 1.0f - 2.0f * RCPF(1.0f + EXP2F(x * (2.0f * LOG2E))); }
DEV float expf_(float x) { return EXP2F(x * LOG2E); }
DEV float softplusf_(float z) { return fmaxf(z, 0.f) + LOG2F_(1.0f + EXP2F(-fabsf(z) * LOG2E)) * 0.6931471805599453f; }
DEV int swz(int row, int col) { return row * 128 + ((((col >> 3) ^ row) & 7) << 4) + ((col & 7) << 1); }
DEV int swz192(int row, int col) { const int ch = col >> 3; return row * 384 + (((ch & ~7) | ((ch ^ row) & 7)) << 4) + ((col & 7) << 1); }
DEV f32x4 mm64(LDSP A, int m0, LDSP B, int n0, f32x4 acc, int lane) {
    const int r = lane & 15, g4 = lane >> 4;
#pragma unroll
    for (int ks = 0; ks < 2; ++ks) {
        const bf16x8 a = *(const LAS bf16x8*)(A + swz(m0 + r, 32 * ks + 8 * g4));
        const bf16x8 b = *(const LAS bf16x8*)(B + swz(n0 + r, 32 * ks + 8 * g4));
        acc = MFMA16(a, b, acc);
    }
    return acc;
}
DEV void st_tile(LDSP O, int m0, int n0, f32x4 v, int lane) {
    const int r = lane & 15, g4 = lane >> 4;
#pragma unroll
    for (int reg = 0; reg < 4; ++reg) *(LAS bf16_t*)(O + swz(m0 + 4 * g4 + reg, n0 + r)) = (bf16_t)f2bf(v[reg]);
}
DEV void st_tile_T(LDSP O, int m0, int n0, f32x4 v, int lane) {
    const int r = lane & 15, g4 = lane >> 4;
    u32x2 w; w.x = pk2(v[0], v[1]); w.y = pk2(v[2], v[3]);
    *(LAS u32x2*)(O + swz(n0 + r, m0 + 4 * g4)) = w;
}
DEV bf16x8 pack8(f32x4 lo, f32x4 hi) {
    u32x4 w; w.x = pk2(lo[0], lo[1]); w.y = pk2(lo[2], lo[3]); w.z = pk2(hi[0], hi[1]); w.w = pk2(hi[2], hi[3]);
    return __builtin_bit_cast(bf16x8, w);
}

namespace pg8 {
#define PG8_LAS __attribute__((address_space(3)))
typedef unsigned short bf16_t;
typedef short bf16x8 __attribute__((ext_vector_type(8)));
typedef float f32x4 __attribute__((ext_vector_type(4)));
typedef unsigned u32x4 __attribute__((ext_vector_type(4)));
constexpr int BM = 256, BK = 64, HALF = 128, HTB = HALF * BK * 2  , STAGE_BYTES = 8 * HTB, NXCD = 8, WGM = 8;

__host__ __device__ __forceinline__ int lds_byte(int r, int c) { const int st = (r >> 4) * 2 + (c >> 5), rr = r & 15, cc = c & 31, ob = rr * 64 + cc * 2; return st * 1024 + (ob ^ (((ob >> 9) & 1) << 5)); }
__host__ __device__ __forceinline__ void stage_rc(int b, int& R, int& C) { const int st = b / 1024, sb = b % 1024, swz = sb ^ (((sb >> 9) & 1) << 5); R = (st >> 1) * 16 + swz / 64; C = (st & 1) * 32 + (swz % 64) / 2; }
__host__ __device__ __forceinline__ int perm32(int rho) { const int n = rho >> 4, i = rho & 15; return 8 * (i >> 2) + 4 * n + (i & 3); }

struct Unit { int pm, pn; };
struct Gemm { const bf16_t* A; const bf16_t* Bt; int M, N, K; };

struct StaticOrder {
    int nM, nN, nwg, G, c;
    __host__ __device__ void init(int M, int N, int G_, int c_) { nM = M / BM; nN = N / BM; nwg = nM * nN; G = G_; c = c_; }
    __host__ __device__ bool next(int i, Unit& u) const {
        const long L = (long)i * G + c; if (L >= nwg) return false;
        int wgid = (int)L; { const int q = nwg / NXCD, r = nwg % NXCD, xcd = wgid % NXCD, off = wgid / NXCD; wgid = (xcd < r ? xcd * (q + 1) : r * (q + 1) + (xcd - r) * q) + off; }
        const int nig = WGM * nN, gid = wgid / nig, fm = gid * WGM, gsz = (nM - fm) < WGM ? (nM - fm) : WGM;
        u.pm = fm + ((wgid % nig) % gsz); u.pn = (wgid % nig) / gsz; return true;
    }
    __device__ __forceinline__ void a_ready(const Unit&) const {}
    __device__ __forceinline__ void done(const Unit&) const {}
};

#ifndef EMU
template <class Epi, class Sched, bool ALIGN_EPI = false, bool SP2 = false>
__device__ __forceinline__ void gemm_phase(PG8_LAS unsigned char* lds, const Gemm g, const Sched& S, const Epi& E, const int wid) {
    const int lane = ::fresh_lane(), tid = wid * 64 + lane, wr = wid >> 2, wc = wid & 3, fr = lane & 15, fq = lane >> 4;
    const int K = g.K, nt = K / BK;
    unsigned voffA[2], voffB[2];
#pragma unroll
    for (int i = 0; i < 2; ++i) { int R, C; stage_rc(tid * 16 + i * 8192, R, C); const int Rb = Epi::PERM ? ((R & ~31) + perm32(R & 31)) : R;
        voffA[i] = (unsigned)(R * K + C) * 2u; voffB[i] = (unsigned)(Rb * K + C) * 2u; }
    const size_t kstep = (size_t)(BK * 2);
    const size_t hstep = (size_t)HALF * K * 2;
    const size_t tstep = 2 * hstep;
    const unsigned ldsw = (unsigned)wid * 1024u;
    const int aoff = lds_byte(wr * 64 + fr, fq * 8), boff = lds_byte(wc * 32 + fr, fq * 8);
#define PG8_SA(b, h) (((b) * 2 + (h)) * HTB)
#define PG8_SB(b, h) ((4 + (b) * 2 + (h)) * HTB)
#define PG8_STAGE(bufoff, gbase, voff) do { _Pragma("unroll") for (int _i = 0; _i < 2; ++_i) \
        __builtin_amdgcn_global_load_lds((const unsigned*)((const char*)(gbase) + (voff)[_i]), (PG8_LAS unsigned*)(lds + (bufoff) + ldsw + _i * 8192), 16, 0, 0); } while (0)
#define PG8_LDA(dst, b, h) do { _Pragma("unroll") for (int m = 0; m < 4; ++m) _Pragma("unroll") for (int k = 0; k < 2; ++k) dst[m][k] = *(const PG8_LAS bf16x8*)(lds + PG8_SA(b, h) + aoff + m * 2048 + k * 1024); } while (0)
#define PG8_LDB(dst, b, h) do { _Pragma("unroll") for (int n = 0; n < 2; ++n) _Pragma("unroll") for (int k = 0; k < 2; ++k) dst[n][k] = *(const PG8_LAS bf16x8*)(lds + PG8_SB(b, h) + boff + n * 2048 + k * 1024); } while (0)
#define PG8_MMA(ai, bj, At, Bt) do { __builtin_amdgcn_s_setprio(1); _Pragma("unroll") for (int m = 0; m < 4; ++m) _Pragma("unroll") for (int n = 0; n < 2; ++n) _Pragma("unroll") for (int k = 0; k < 2; ++k) \
        acc[ai][bj][m][n] = __builtin_amdgcn_mfma_f32_16x16x32_bf16(Bt[n][k], At[m][k], acc[ai][bj][m][n], 0, 0, 0); __builtin_amdgcn_s_setprio(0); } while (0)
#define PG8_WAIT_V(n) asm volatile("s_waitcnt vmcnt(" #n ")" ::: "memory")
#define PG8_WAIT_L(n) asm volatile("s_waitcnt lgkmcnt(" #n ")" ::: "memory")
#define PG8_BAR __builtin_amdgcn_s_barrier()
#define PG8_SCHED __builtin_amdgcn_sched_barrier(0)
    Unit cur, nxt; int ui = 0;
    if (!S.next(0, cur)) return;
    f32x4 acc[2][2][4][2];
#pragma unroll
    for (int a = 0; a < 2; ++a)
#pragma unroll
        for (int b = 0; b < 2; ++b)
#pragma unroll
            for (int m = 0; m < 4; ++m)
#pragma unroll
                for (int n = 0; n < 2; ++n) acc[a][b][m][n] = (f32x4){0.f, 0.f, 0.f, 0.f};
    bf16x8 At[4][2], B0[2][2], B1[2][2];
    const char* cA = (const char*)g.A + (size_t)cur.pm * tstep; const char* cB = (const char*)g.Bt + (size_t)cur.pn * tstep;
    S.a_ready(cur);
    if constexpr (SP2) {
        PG8_STAGE(PG8_SB(0, 0), cB, voffB); PG8_STAGE(PG8_SB(0, 1), cB + hstep, voffB); PG8_STAGE(PG8_SA(0, 0), cA, voffA); PG8_STAGE(PG8_SA(0, 1), cA + hstep, voffA);
        if (wr == 1) PG8_BAR;
        PG8_WAIT_V(2); PG8_BAR;
        PG8_STAGE(PG8_SB(1, 0), cB + kstep, voffB); PG8_STAGE(PG8_SA(1, 0), cA + kstep, voffA); PG8_STAGE(PG8_SB(1, 1), cB + hstep + kstep, voffB);
        PG8_WAIT_V(6); PG8_BAR;
    } else {
        PG8_STAGE(PG8_SB(0, 0), cB, voffB); PG8_STAGE(PG8_SA(0, 0), cA, voffA); PG8_STAGE(PG8_SB(0, 1), cB + hstep, voffB); PG8_STAGE(PG8_SA(0, 1), cA + hstep, voffA);
        if (wr == 1) PG8_BAR;
        PG8_WAIT_V(4); PG8_BAR;
        PG8_STAGE(PG8_SB(1, 0), cB + kstep, voffB); PG8_STAGE(PG8_SA(1, 0), cA + kstep, voffA); PG8_STAGE(PG8_SB(1, 1), cB + hstep + kstep, voffB);
        PG8_WAIT_V(6); PG8_BAR;
    }
    for (;;) {
        const bool has_next = S.next(ui + 1, nxt);
        const char* nA = has_next ? (const char*)g.A + (size_t)nxt.pm * tstep : cA; const char* nB = has_next ? (const char*)g.Bt + (size_t)nxt.pn * tstep : cB;
        for (int t = 0; t < nt; t += 2) {
            const bool last = (t == nt - 2);
            const char* a1 = cA + (size_t)(t + 1) * kstep;
            const char* a2 = last ? nA : cA + (size_t)(t + 2) * kstep; const char* b2 = last ? nB : cB + (size_t)(t + 2) * kstep;
            const char* a3 = a2 + kstep; const char* b3 = b2 + kstep;
            if (last && has_next) S.a_ready(nxt);
            if constexpr (SP2) {
            PG8_LDB(B0, 0, 0); PG8_LDB(B1, 0, 1); PG8_SCHED; PG8_LDA(At, 0, 0); PG8_STAGE(PG8_SA(1, 1), a1 + hstep, voffA);
            PG8_WAIT_V(8); PG8_WAIT_L(0); PG8_BAR; PG8_MMA(0, 0, At, B0); PG8_MMA(0, 1, At, B1); PG8_BAR; PG8_SCHED;
            PG8_LDA(At, 0, 1); PG8_STAGE(PG8_SB(0, 0), b2, voffB); PG8_STAGE(PG8_SB(0, 1), b2 + hstep, voffB); PG8_STAGE(PG8_SA(0, 0), a2, voffA);
            PG8_WAIT_V(8); PG8_WAIT_L(0); PG8_BAR; PG8_MMA(1, 0, At, B0); PG8_MMA(1, 1, At, B1); PG8_BAR; PG8_SCHED;
            PG8_LDB(B0, 1, 0); PG8_LDB(B1, 1, 1); PG8_SCHED; PG8_LDA(At, 1, 0); PG8_STAGE(PG8_SA(0, 1), a2 + hstep, voffA);
            PG8_WAIT_V(8); PG8_WAIT_L(0); PG8_BAR; PG8_MMA(0, 0, At, B0); PG8_MMA(0, 1, At, B1); PG8_BAR; PG8_SCHED;
            PG8_LDA(At, 1, 1); PG8_STAGE(PG8_SB(1, 0), b3, voffB); PG8_STAGE(PG8_SB(1, 1), b3 + hstep, voffB); PG8_STAGE(PG8_SA(1, 0), a3, voffA);
            PG8_WAIT_V(8); PG8_WAIT_L(0); PG8_BAR; PG8_MMA(1, 0, At, B0); PG8_MMA(1, 1, At, B1); PG8_BAR; PG8_SCHED;
            } else {
            PG8_LDB(B0, 0, 0); PG8_SCHED; PG8_LDA(At, 0, 0); PG8_STAGE(PG8_SA(1, 1), a1 + hstep, voffA);
            PG8_WAIT_L(8); PG8_BAR; PG8_WAIT_L(0); PG8_MMA(0, 0, At, B0); PG8_BAR; PG8_SCHED;
            PG8_LDB(B1, 0, 1); PG8_STAGE(PG8_SB(0, 0), b2, voffB);
            PG8_BAR; PG8_WAIT_L(0); PG8_MMA(0, 1, At, B1); PG8_BAR;
            PG8_LDA(At, 0, 1); PG8_STAGE(PG8_SA(0, 0), a2, voffA);
            PG8_BAR; PG8_WAIT_L(0); PG8_MMA(1, 0, At, B0); PG8_BAR; PG8_SCHED;
            PG8_STAGE(PG8_SB(0, 1), b2 + hstep, voffB);
            PG8_WAIT_V(6); PG8_BAR; PG8_MMA(1, 1, At, B1); PG8_BAR;
            PG8_LDB(B0, 1, 0); PG8_SCHED; PG8_LDA(At, 1, 0); PG8_STAGE(PG8_SA(0, 1), a2 + hstep, voffA);
            PG8_WAIT_L(8); PG8_BAR; PG8_WAIT_L(0); PG8_MMA(0, 0, At, B0); PG8_BAR; PG8_SCHED;
            PG8_LDB(B1, 1, 1); PG8_STAGE(PG8_SB(1, 0), b3, voffB);
            PG8_BAR; PG8_WAIT_L(0); PG8_MMA(0, 1, At, B1); PG8_BAR;
            PG8_LDA(At, 1, 1); PG8_STAGE(PG8_SA(1, 0), a3, voffA);
            PG8_BAR; PG8_WAIT_L(0); PG8_MMA(1, 0, At, B0); PG8_BAR; PG8_SCHED;
            PG8_STAGE(PG8_SB(1, 1), b3 + hstep, voffB);
            PG8_WAIT_V(6); PG8_BAR; PG8_MMA(1, 1, At, B1); PG8_BAR;
            }
        }
        if constexpr (ALIGN_EPI) { if (wr == 0) PG8_BAR; }
        if constexpr (!Epi::AFTER_DRAIN) { E(acc, cur, wr, wc, fr, fq); S.done(cur); }
        if (!has_next) break;
#pragma unroll
        for (int a = 0; a < 2; ++a)
#pragma unroll
            for (int b = 0; b < 2; ++b)
#pragma unroll
                for (int m = 0; m < 4; ++m)
#pragma unroll
                    for (int n = 0; n < 2; ++n) acc[a][b][m][n] = (f32x4){0.f, 0.f, 0.f, 0.f};
        cur = nxt; cA = nA; cB = nB; ++ui;
        if constexpr (ALIGN_EPI) { if (wr == 1) PG8_BAR; }
    }
    PG8_WAIT_V(0);
    if constexpr (!ALIGN_EPI) { if (wr == 0) PG8_BAR; }
    PG8_BAR;
    if constexpr (Epi::AFTER_DRAIN) { E.fused(acc, cur, wr, wc, fr, fq, lds, wid, lane); S.done(cur); }
#undef PG8_SA
#undef PG8_SB
#undef PG8_STAGE
#undef PG8_LDA
#undef PG8_LDB
#undef PG8_MMA
#undef PG8_WAIT_V
#undef PG8_WAIT_L
#undef PG8_BAR
#undef PG8_SCHED
}
}
#else
template <class Epi, class Sched, bool ALIGN_EPI = false, bool SP2 = false>
static void gemm_phase(LDSP lds, const Gemm g, const Sched& S, const Epi& E, const int wid_) {
    const int tid = TID(), wid = tid >> 6, lane = tid & 63, wr = wid >> 2, wc = wid & 3, fr = lane & 15, fq = lane >> 4;
    Unit u;
    for (int i = 0; S.next(i, u); ++i) {
        f32x4 acc[2][2][4][2];
        for (int ai = 0; ai < 2; ++ai) for (int bj = 0; bj < 2; ++bj) for (int m = 0; m < 4; ++m) for (int n = 0; n < 2; ++n) for (int e = 0; e < 4; ++e) {
            const int row = 256 * u.pm + 128 * ai + 64 * wr + 16 * m + fr;
            const int col = 256 * u.pn + 128 * bj + 32 * wc + (Epi::PERM ? 8 * fq + 4 * n + e : 16 * n + 4 * fq + e);
            const bf16_t* a = g.A + (size_t)row * g.K; const bf16_t* b = g.Bt + (size_t)col * g.K; float s = 0.f;
            for (int k = 0; k < g.K; ++k) s += ::bf2f(a[k]) * ::bf2f(b[k]);
            acc[ai][bj][m][n][e] = s; }
        E(acc, u, wr, wc, fr, fq);
    }
}
}
#endif

struct EpiSwiglu {
    static constexpr bool PERM = true, AFTER_DRAIN = false;
    bf16_t* G;
    DEVM void operator()(const f32x4 (&acc)[2][2][4][2], const pg8::Unit& u, int wr, int wc, int fr, int fq) const {
        const int row0 = u.pm * 256 + wr * 64 + fr, col0 = u.pn * 128 + wc * 32 + 8 * fq;
#pragma unroll
        for (int ai = 0; ai < 2; ++ai)
#pragma unroll
            for (int m = 0; m < 4; ++m) {
                bf16_t* rowp = G + (size_t)(row0 + ai * 128 + m * 16) * DFF + col0;
                float o[8];
#pragma unroll
                for (int n = 0; n < 2; ++n)
#pragma unroll
                    for (int e = 0; e < 4; ++e) { const float g = acc[ai][0][m][n][e], up = acc[ai][1][m][n][e]; o[4 * n + e] = g * up / (1.0f + EXP2F(-g * LOG2E)); }
                u32x4 w; w.x = pk2(o[0], o[1]); w.y = pk2(o[2], o[3]); w.z = pk2(o[4], o[5]); w.w = pk2(o[6], o[7]);
                *(u32x4*)rowp = w;
            }
    }
};
struct EpiResid {
    static constexpr bool PERM = false, AFTER_DRAIN = false;
    float* X; float scale;
    DEVM void apply4(size_t row, int col, f32x4 v) const { f32x4* q = (f32x4*)(X + row * DM + col); *q = *q + v * scale; }
    DEVM void operator()(const f32x4 (&acc)[2][2][4][2], const pg8::Unit& u, int wr, int wc, int fr, int fq) const {
        const int row0 = u.pm * 256 + wr * 64 + fr, col0 = u.pn * 256 + wc * 32 + 4 * fq;
#pragma unroll
        for (int ai = 0; ai < 2; ++ai)
#pragma unroll
            for (int m = 0; m < 4; ++m) {
                float* rowp = X + (size_t)(row0 + ai * 128 + m * 16) * DM + col0;
#pragma unroll
                for (int bj = 0; bj < 2; ++bj)
#pragma unroll
                    for (int n = 0; n < 2; ++n) { f32x4* q = (f32x4*)(rowp + bj * 128 + n * 16); *q = *q + acc[ai][bj][m][n] * scale; }
            }
    }
};
struct EpiWin {
    static constexpr bool PERM = false, AFTER_DRAIN = false;
    float* PF; bf16_t* SG;
    DEVM void operator()(const f32x4 (&acc)[2][2][4][2], const pg8::Unit& u, int wr, int wc, int fr, int fq) const {
        const int row0 = u.pm * 256 + wr * 64 + fr;
        if (u.pn < FW / 256) {
            const int col0 = u.pn * 256 + wc * 32 + 4 * fq;
#pragma unroll
            for (int ai = 0; ai < 2; ++ai)
#pragma unroll
                for (int m = 0; m < 4; ++m) {
                    float* rowp = PF + (size_t)(row0 + ai * 128 + m * 16) * FW + col0;
#pragma unroll
                    for (int bj = 0; bj < 2; ++bj)
#pragma unroll
                        for (int n = 0; n < 2; ++n) *(f32x4*)(rowp + bj * 128 + n * 16) = acc[ai][bj][m][n];
                }
        } else {
            const int col0 = (u.pn - FW / 256) * 256 + wc * 32 + 4 * fq;
#pragma unroll
            for (int ai = 0; ai < 2; ++ai)
#pragma unroll
                for (int m = 0; m < 4; ++m) {
                    bf16_t* rowp = SG + (size_t)(row0 + ai * 128 + m * 16) * (2 * DM) + col0;
#pragma unroll
                    for (int bj = 0; bj < 2; ++bj)
#pragma unroll
                        for (int n = 0; n < 2; ++n) { const f32x4 v = acc[ai][bj][m][n]; u32x2 w;
                            w.x = pk2(1.0f / (1.0f + EXP2F(-v[0] * LOG2E)), 1.0f / (1.0f + EXP2F(-v[1] * LOG2E))); w.y = pk2(1.0f / (1.0f + EXP2F(-v[2] * LOG2E)), 1.0f / (1.0f + EXP2F(-v[3] * LOG2E)));
                            *(u32x2*)(rowp + bj * 128 + n * 16) = w; }
                }
        }
    }
};
struct EpiUpA {
    static constexpr bool PERM = false, AFTER_DRAIN = false;
    const bf16_t* SG; float* T1;
    DEVM void apply4(size_t row, int col, f32x4 v) const { const u32x2 s = *(const u32x2*)(SG + row * (2 * DM) + col);
        f32x4 o; o[0] = v[0] * bf2f(s.x & 0xffffu); o[1] = v[1] * bf2f(s.x >> 16); o[2] = v[2] * bf2f(s.y & 0xffffu); o[3] = v[3] * bf2f(s.y >> 16); *(f32x4*)(T1 + row * DM + col) = o; }
    DEVM void operator()(const f32x4 (&acc)[2][2][4][2], const pg8::Unit& u, int wr, int wc, int fr, int fq) const {
        const int row0 = u.pm * 256 + wr * 64 + fr, col0 = u.pn * 256 + wc * 32 + 4 * fq;
#pragma unroll
        for (int ai = 0; ai < 2; ++ai)
#pragma unroll
            for (int m = 0; m < 4; ++m) {
                const size_t row = (size_t)(row0 + ai * 128 + m * 16);
#pragma unroll
                for (int bj = 0; bj < 2; ++bj)
#pragma unroll
                    for (int n = 0; n < 2; ++n) { const int c = col0 + bj * 128 + n * 16; const u32x2 s = *(const u32x2*)(SG + row * (2 * DM) + c); const f32x4 v = acc[ai][bj][m][n];
                        f32x4 o; o[0] = v[0] * bf2f(s.x & 0xffffu); o[1] = v[1] * bf2f(s.x >> 16); o[2] = v[2] * bf2f(s.y & 0xffffu); o[3] = v[3] * bf2f(s.y >> 16);
                        *(f32x4*)(T1 + row * DM + c) = o; }
            }
    }
};
struct EpiUpB {
    static constexpr bool PERM = false, AFTER_DRAIN = false;
    const bf16_t* SG; const float* T1; bf16_t* MG;
    DEVM void apply4(size_t row, int col, f32x4 v) const { const u32x2 s = *(const u32x2*)(SG + row * (2 * DM) + DM + col); const f32x4 t = *(const f32x4*)(T1 + row * DM + col);
        u32x2 w; w.x = pk2(t[0] + v[0] * bf2f(s.x & 0xffffu), t[1] + v[1] * bf2f(s.x >> 16)); w.y = pk2(t[2] + v[2] * bf2f(s.y & 0xffffu), t[3] + v[3] * bf2f(s.y >> 16)); *(u32x2*)(MG + row * DM + col) = w; }
    DEVM void operator()(const f32x4 (&acc)[2][2][4][2], const pg8::Unit& u, int wr, int wc, int fr, int fq) const {
        const int row0 = u.pm * 256 + wr * 64 + fr, col0 = u.pn * 256 + wc * 32 + 4 * fq;
#pragma unroll
        for (int ai = 0; ai < 2; ++ai)
#pragma unroll
            for (int m = 0; m < 4; ++m) {
                const size_t row = (size_t)(row0 + ai * 128 + m * 16);
#pragma unroll
                for (int bj = 0; bj < 2; ++bj)
#pragma unroll
                    for (int n = 0; n < 2; ++n) { const int c = col0 + bj * 128 + n * 16; const u32x2 s = *(const u32x2*)(SG + row * (2 * DM) + DM + c); const f32x4 v = acc[ai][bj][m][n];
                        const f32x4 t = *(const f32x4*)(T1 + row * DM + c);
                        u32x2 w; w.x = pk2(t[0] + v[0] * bf2f(s.x & 0xffffu), t[1] + v[1] * bf2f(s.x >> 16)); w.y = pk2(t[2] + v[2] * bf2f(s.y & 0xffffu), t[3] + v[3] * bf2f(s.y >> 16));
                        *(u32x2*)(MG + row * DM + c) = w; }
            }
    }
};


template <class Epi> DEV void sgemm_tile(const bf16_t* A, const bf16_t* Bt, int K, int m0, int n0, LDSP lds, int tid, const Epi& E) {
    const int lane = tid & 63, wave = WAVE_ID(tid), r = lane & 15, g4 = lane >> 4;
    f32x4 acc[4][4];
#pragma unroll
    for (int nt = 0; nt < 4; ++nt)
#pragma unroll
        for (int mt = 0; mt < 4; ++mt) acc[nt][mt] = (f32x4){0.f, 0.f, 0.f, 0.f};
    const bf16_t* ap = A + (size_t)(m0 + r) * K + 8 * g4; const bf16_t* bp = Bt + (size_t)(n0 + r) * K + 8 * g4;
    const int nks = K >> 5;
    bf16x8 a0[2][4], b0[2][4], a1[2][4], b1[2][4];
#define SG_LOAD(A_, B_, ksv) do { _Pragma("unroll") for (int t = 0; t < 4; ++t) { A_[0][t] = *(const bf16x8*)(ap + (size_t)16 * t * K + 32 * (ksv)); A_[1][t] = *(const bf16x8*)(ap + (size_t)16 * t * K + 32 * (ksv) + 32); \
        B_[0][t] = *(const bf16x8*)(bp + (size_t)16 * t * K + 32 * (ksv)); B_[1][t] = *(const bf16x8*)(bp + (size_t)16 * t * K + 32 * (ksv) + 32); } } while (0)
#define SG_MMA(A_, B_) do { _Pragma("unroll") for (int h = 0; h < 2; ++h) _Pragma("unroll") for (int nt = 0; nt < 4; ++nt) _Pragma("unroll") for (int mt = 0; mt < 4; ++mt) acc[nt][mt] = MFMA16(B_[h][nt], A_[h][mt], acc[nt][mt]); } while (0)
    int ks = 2 * wave;
    if (ks < nks) SG_LOAD(a0, b0, ks);
#pragma unroll 1
    for (; ks < nks; ks += 4 * NWAVES) {
        const int k1 = ks + 2 * NWAVES, k2 = ks + 4 * NWAVES;
        if (k1 < nks) SG_LOAD(a1, b1, k1);
        SG_MMA(a0, b0);
        if (k2 < nks) SG_LOAD(a0, b0, k2);
        if (k1 < nks) SG_MMA(a1, b1);
    }
#undef SG_LOAD
#undef SG_MMA
#pragma unroll
    for (int nt = 0; nt < 4; ++nt)
#pragma unroll
        for (int mt = 0; mt < 4; ++mt) *(LAS f32x4*)(lds + wave * 16384 + ((nt * 4 + mt) * 64 + lane) * 16) = acc[nt][mt];
    WG_SYNC();
#pragma unroll
    for (int s = tid; s < 1024; s += NTHR) {
        f32x4 v = *(const LAS f32x4*)(lds + s * 16);
#pragma unroll
        for (int w = 1; w < NWAVES; ++w) v = v + *(const LAS f32x4*)(lds + w * 16384 + s * 16);
        const int tile = s >> 6, ln = s & 63, nt = tile >> 2, mt = tile & 3;
        E.apply4((size_t)(m0 + 16 * mt + (ln & 15)), n0 + 16 * nt + 4 * (ln >> 4), v);
    }
    WG_SYNC();
}

DEV void conv_item(const float* W, int K, int N, bf16_t* WT, int mode, LAS float* scr, int item, int lane) {
    const int nblk = N / 32, kb = item / nblk, nb = item % nblk, k0 = 64 * kb, n0 = 32 * nb;
    int drow = n0;
    if (mode == 1) drow = (n0 >> 7) * 256 + (n0 & 127); else if (mode == 2) drow = (n0 >> 7) * 256 + 128 + (n0 & 127); else if (mode == 3) drow = n0 < FW_RAW ? n0 : FW + (n0 - FW_RAW);
#pragma unroll 8
    for (int i = 0; i < 32; ++i) { const int kk = 2 * i + (lane >> 5); scr[kk * 33 + (lane & 31)] = W[(size_t)(k0 + kk) * N + n0 + (lane & 31)]; }
    WAVE_FENCE();
    const int c = lane & 7;
#pragma unroll
    for (int j = 0; j < 4; ++j) { const int n = (lane >> 3) + 8 * j; const LAS float* s = scr + (8 * c) * 33 + n;
        u32x4 o; o.x = pk2(s[0 * 33], s[1 * 33]); o.y = pk2(s[2 * 33], s[3 * 33]); o.z = pk2(s[4 * 33], s[5 * 33]); o.w = pk2(s[6 * 33], s[7 * 33]);
        *(u32x4*)(WT + (size_t)(drow + n) * K + k0 + 8 * c) = o; }
    WAVE_FENCE();
}
constexpr int IT_G = (DM / 64) * (DFF / 32), IT_D = (DFF / 64) * (DM / 32), IT_IN = (DM / 64) * (INCOLS / 32), IT_UA = (AW / 64) * (DM / 32), IT_UB = (BQ / 64) * (DM / 32), IT_O = (DM / 64) * (DM / 32);
constexpr int IT_LAYER = 4 * IT_G + 2 * IT_D + IT_IN + IT_UA + IT_UB + IT_O;
DEV void prologue(const Params& p, LDSP lds, int gw, int NGW, int wave, int lane, int gtid, int NGT) {
    LAS float* scr = (LAS float*)(lds + wave * 8448);
    for (int it = gw; it < DEPTH * IT_LAYER; it += NGW) {
        const int l = it / IT_LAYER; int r = it % IT_LAYER;
        int src, K, N, mode; size_t doff, soff;
        if (r < IT_G) { src = I_F1G; K = DM; N = DFF; mode = 1; doff = OFF_WGU1; soff = (size_t)l * DM * DFF; }
        else if ((r -= IT_G) < IT_G) { src = I_F1U; K = DM; N = DFF; mode = 2; doff = OFF_WGU1; soff = (size_t)l * DM * DFF; }
        else if ((r -= IT_G) < IT_D) { src = I_F1D; K = DFF; N = DM; mode = 0; doff = OFF_WD1; soff = (size_t)l * DFF * DM; }
        else if ((r -= IT_D) < IT_IN) { src = I_WIN; K = DM; N = INCOLS; mode = 3; doff = OFF_WIN; soff = (size_t)l * DM * INCOLS; }
        else if ((r -= IT_IN) < IT_UA) { src = I_WUA; K = AW; N = DM; mode = 0; doff = OFF_WUA; soff = (size_t)l * AW * DM; }
        else if ((r -= IT_UA) < IT_UB) { src = I_WUB; K = BQ; N = DM; mode = 0; doff = OFF_WUB; soff = (size_t)l * BQ * DM; }
        else if ((r -= IT_UB) < IT_O) { src = I_WO; K = DM; N = DM; mode = 0; doff = OFF_WO; soff = (size_t)l * DM * DM; }
        else if ((r -= IT_O) < IT_G) { src = I_F2G; K = DM; N = DFF; mode = 1; doff = OFF_WGU2; soff = (size_t)l * DM * DFF; }
        else if ((r -= IT_G) < IT_G) { src = I_F2U; K = DM; N = DFF; mode = 2; doff = OFF_WGU2; soff = (size_t)l * DM * DFF; }
        else { r -= IT_G; src = I_F2D; K = DFF; N = DM; mode = 0; doff = OFF_WD2; soff = (size_t)l * DFF * DM; }
        conv_item(PIN(p, src) + soff, K, N, lwp(p, l, doff), mode, scr, r, lane);
    }
    for (int idx = gtid; idx < DEPTH * AW * 288; idx += NGT) {
        const int l = idx / (AW * 288), r = idx % (AW * 288), n = r / 288, k = r % 288;
        if (k < 64) lwp(p, l, OFF_DW2T)[n * 64 + k] = (bf16_t)f2bf(PIN(p, I_DW2)[((size_t)l * 64 + k) * AW + n]);
        else if (k < 128) lwp(p, l, OFF_IA2T)[n * 64 + (k - 64)] = (bf16_t)f2bf(PIN(p, I_IA2)[((size_t)l * 64 + (k - 64)) * AW + n]);
        else lwp(p, l, OFF_GG2T)[n * 160 + (k - 128)] = (bf16_t)f2bf(PIN(p, I_GG2)[((size_t)l * 160 + (k - 128)) * AW + n]);
    }
    float* rope = (float*)(p.ws + WS_ROPE);
    for (int idx = gtid; idx < (SEQ + DECS) * 32; idx += NGT) {
        const int slot = idx >> 5, i = idx & 31; const double pos = slot < SEQ ? (double)slot : (double)(PAST + slot - SEQ);
        const double ang = pos * ROPE_INV[i]; const double red = ang - TWO_PI * __builtin_rint(ang * (1.0 / TWO_PI));
        rope[2 * idx] = cosf((float)red); rope[2 * idx + 1] = sinf((float)red);
    }
}
DEV void norm_phase(const Params& p, const float* gain, bool first, int gw, int NGW, int lane) {
    float* X = p.out; bf16_t* H = (bf16_t*)(p.ws + WS_H);
    for (int m = gw; m < M; m += NGW) {
        const float* xr = first ? (m < SEQ ? PIN(p, I_XP) + (size_t)m * DM : PIN(p, I_XS) + (size_t)(m - SEQ) * DM) : X + (size_t)m * DM;
        f32x4 v[DM / 256]; float ss = 0.f;
#pragma unroll
        for (int j = 0; j < DM / 256; ++j) { v[j] = *(const f32x4*)(xr + 4 * lane + 256 * j); ss += (v[j][0] * v[j][0] + v[j][1] * v[j][1]) + (v[j][2] * v[j][2] + v[j][3] * v[j][3]); }
        if (first) {
#pragma unroll
            for (int j = 0; j < DM / 256; ++j) *(f32x4*)(X + (size_t)m * DM + 4 * lane + 256 * j) = v[j];
        }
        const float rinv = RSQRTF(wave_sum(ss) * (1.0f / DM) + RMS_EPS);
#pragma unroll
        for (int j = 0; j < DM / 256; ++j) { const f32x4 g = *(const f32x4*)(gain + 4 * lane + 256 * j); u32x2 w; w.x = pk2(v[j][0] * rinv * g[0], v[j][1] * rinv * g[1]); w.y = pk2(v[j][2] * rinv * g[2], v[j][3] * rinv * g[3]);
            *(u32x2*)(H + (size_t)m * DM + 4 * lane + 256 * j) = w; }
    }
}

constexpr int R1_RA = 3 * 64 * 65 * 4, R1_RB = 65536 + 64 * 65 * 4;
static_assert(R1_RA + R1_RB + 2304 <= LDS_CTL_OFF && 6 * 8192 <= R1_RA, "R1 LDS map");
DEV void r1_unit(const Params& p, int l, int u, LDSP lds, int tid) {
    const int lane = tid & 63, wave = WAVE_ID(tid), r = lane & 15, g4 = lane >> 4;
    const bool samp = u >= NUP;
    int c = 0, b = 0, h, ntok; size_t row0;
    if (!samp) { c = u / AH; h = u % AH; row0 = (size_t)64 * c; ntok = 64; } else { const int s = u - NUP; b = s / AH; h = s % AH; row0 = (size_t)SEQ + 16 * b; ntok = DECS; }
    const float* PF = (const float*)(p.ws + WS_PF);
    const float* mu = PIN(p, I_MU) + (size_t)l * ACOLS;
    LDSP RA = lds, RB = lds + R1_RA;
    LAS float* DWf = (LAS float*)RA; LAS float* IAf = DWf + 64 * 65; LAS float* GGf = IAf + 64 * 65;
    LDSP LW = RB, LA = RB + 8192, LG = RB + 16384;
    LDSP B0 = RB, B1 = RB + 8192, B2 = RB + 16384, B3 = RB + 24576, B4 = RB + 32768, B5 = RB + 40960, B6 = RB + 49152, B7 = RB + 57344;
    LAS float* RtF = (LAS float*)(RB + 65536);
    LDSP A0 = RA, A1 = RA + 8192, A2 = RA + 16384, A3 = RA + 24576, A4 = RA + 32768, A5 = RA + 40960;
    LAS float* part = (LAS float*)(lds + R1_RA + R1_RB); LAS float* gam = part + 512;
    const int mt1 = wave & 3, nh = wave >> 2;
    bf16x8 bw[2][2], ba[2][2], bg[2][5];
#pragma unroll
    for (int n = 0; n < 2; ++n) { const size_t wrow = (size_t)(64 * h + 16 * (2 * nh + n) + r);
#pragma unroll
        for (int ks = 0; ks < 2; ++ks) { bw[n][ks] = *(const bf16x8*)(lwp(p, l, OFF_DW2T) + wrow * 64 + 32 * ks + 8 * g4); ba[n][ks] = *(const bf16x8*)(lwp(p, l, OFF_IA2T) + wrow * 64 + 32 * ks + 8 * g4); }
#pragma unroll
        for (int ks = 0; ks < 5; ++ks) bg[n][ks] = *(const bf16x8*)(lwp(p, l, OFF_GG2T) + wrow * 160 + 32 * ks + 8 * g4); }
    {
        const int t = tid >> 3, sub = tid & 7; const bool valid = t < ntok;
        const float* cur = PF + (row0 + t) * FW; const float* prv = cur - FW; float ps = 1.f;
        if (t == 0) { if (samp) prv = PIN(p, I_SSH) + ((size_t)l * DECB + b) * ACOLS; else if (c == 0) { prv = cur; ps = 0.f; } }
        u32x4 wv = (u32x4){0u, 0u, 0u, 0u}, av = wv;
        if (valid) {
            float x[8], y[8];
#pragma unroll
            for (int hh = 0; hh < 2; ++hh) { const int cw = C_WLO + 8 * sub + 4 * hh, ca = C_ALO + 8 * sub + 4 * hh;
                const f32x4 c1 = *(const f32x4*)(cur + cw), p1 = *(const f32x4*)(prv + cw), m1 = *(const f32x4*)(mu + cw), c2 = *(const f32x4*)(cur + ca), p2 = *(const f32x4*)(prv + ca), m2 = *(const f32x4*)(mu + ca);
#pragma unroll
                for (int e = 0; e < 4; ++e) { x[4 * hh + e] = tanhf_(c1[e] + (p1[e] * ps - c1[e]) * m1[e]); y[4 * hh + e] = c2[e] + (p2[e] * ps - c2[e]) * m2[e]; } }
            wv.x = pk2(x[0], x[1]); wv.y = pk2(x[2], x[3]); wv.z = pk2(x[4], x[5]); wv.w = pk2(x[6], x[7]);
            av.x = pk2(y[0], y[1]); av.y = pk2(y[2], y[3]); av.z = pk2(y[4], y[5]); av.w = pk2(y[6], y[7]);
        }
        *(LAS u32x4*)(LW + swz(t, 8 * sub)) = wv; *(LAS u32x4*)(LA + swz(t, 8 * sub)) = av;
#pragma unroll
        for (int q = 0; q < 5; ++q) { const int col = 20 * sub + 4 * q; u32x2 w = (u32x2){0u, 0u};
            if (valid) { const int cg = C_GLO + col; const f32x4 c1 = *(const f32x4*)(cur + cg), p1 = *(const f32x4*)(prv + cg), m1 = *(const f32x4*)(mu + cg); float z[4];
#pragma unroll
                for (int e = 0; e < 4; ++e) z[e] = sigmoidf_(c1[e] + (p1[e] * ps - c1[e]) * m1[e]);
                w.x = pk2(z[0], z[1]); w.y = pk2(z[2], z[3]); }
            *(LAS u32x2*)(LG + swz192(t, col)) = w; }
    }
    WG_SYNC();
    if (16 * mt1 < ntok) {
        f32x4 aw[2], aa[2], ag[2];
#pragma unroll
        for (int n = 0; n < 2; ++n) { aw[n] = (f32x4){0.f, 0.f, 0.f, 0.f}; aa[n] = aw[n]; ag[n] = aw[n]; }
#pragma unroll
        for (int ks = 0; ks < 2; ++ks) { const bf16x8 a1 = *(const LAS bf16x8*)(LW + swz(16 * mt1 + r, 32 * ks + 8 * g4)), a2 = *(const LAS bf16x8*)(LA + swz(16 * mt1 + r, 32 * ks + 8 * g4));
#pragma unroll
            for (int n = 0; n < 2; ++n) { aw[n] = MFMA16(a1, bw[n][ks], aw[n]); aa[n] = MFMA16(a2, ba[n][ks], aa[n]); } }
#pragma unroll
        for (int ks = 0; ks < 5; ++ks) { const bf16x8 a3 = *(const LAS bf16x8*)(LG + swz192(16 * mt1 + r, 32 * ks + 8 * g4));
#pragma unroll
            for (int n = 0; n < 2; ++n) ag[n] = MFMA16(a3, bg[n][ks], ag[n]); }
#pragma unroll
        for (int n = 0; n < 2; ++n)
#pragma unroll
            for (int reg = 0; reg < 4; ++reg) { const int o = (16 * mt1 + 4 * g4 + reg) * 65 + 16 * (2 * nh + n) + r; DWf[o] = aw[n][reg]; IAf[o] = aa[n][reg]; GGf[o] = ag[n][reg]; }
    }
    WG_SYNC();
    {
        const int j = lane, tq = wave, ch = 64 * h + j;
        const float w0 = PIN(p, I_DW0)[(size_t)l * AW + ch], a0 = PIN(p, I_IA0)[(size_t)l * AW + ch], kkw = PIN(p, I_KK)[(size_t)l * AW + ch], kaw = PIN(p, I_KA)[(size_t)l * AW + ch], rkw = PIN(p, I_RK)[(size_t)l * AW + ch];
        const float mur = mu[C_R + ch], muk = mu[C_K + ch], muv = mu[C_V + ch];
        float pr = 0.f, pk = 0.f, pv = 0.f;
        { const int t0 = 8 * tq; const float* pp = nullptr;
          if (t0 > 0) { if (t0 - 1 < ntok) pp = PF + (row0 + t0 - 1) * FW; } else if (samp) pp = PIN(p, I_SSH) + ((size_t)l * DECB + b) * ACOLS; else if (c > 0) pp = PF + (row0 - 1) * FW;
          if (pp) { pr = pp[C_R + ch]; pk = pp[C_K + ch]; pv = pp[C_V + ch]; } }
        float rr[8], kq[8], kp[8], av[8], vv[8], ld[8], Lc[8], bs[8]; float Lacc = 0.f;
#pragma unroll
        for (int tt = 0; tt < 8; ++tt) {
            const int t = 8 * tq + tt; const bool valid = t < ntok;
            float cr = 0.f, ck = 0.f, cv = 0.f;
            if (valid) { const float* cp = PF + (row0 + t) * FW; cr = cp[C_R + ch]; ck = cp[C_K + ch]; cv = cp[C_V + ch]; }
            float r_ = cr + (pr - cr) * mur, k_ = ck + (pk - ck) * muk, v_ = cv + (pv - cv) * muv; pr = cr; pk = ck; pv = cv;
            const float w = -softplusf_(-(w0 + DWf[t * 65 + j])) - 0.5f;
            float logd = -expf_(w);
            float a = sigmoidf_(a0 + IAf[t * 65 + j]);
            float kn = k_ * kkw; const float ss = wave_sum(kn * kn); kn = kn * RCPF(fmaxf(sqrtf(ss), 1e-12f));
            float kpp = k_ * (1.0f + (a - 1.0f) * kaw);
            float bsum = wave_sum(r_ * kpp * rkw);
            if (!valid) { logd = 0.f; kn = 0.f; kpp = 0.f; r_ = 0.f; v_ = 0.f; a = 0.f; bsum = 0.f; }
            Lacc += logd; ld[tt] = logd; Lc[tt] = Lacc; rr[tt] = r_; kq[tt] = kn; kp[tt] = kpp; av[tt] = a; vv[tt] = v_; bs[tt] = bsum;
        }
        part[tq * 64 + j] = Lacc;
        WG_SYNC();
        float off = 0.f;
#pragma unroll
        for (int q = 0; q < 8; ++q) if (q < tq) off += part[q * 64 + j];
        float fa[8], fb[8], fk[8], gt[8], bn[8];
#pragma unroll
        for (int tt = 0; tt < 8; ++tt) {
            const int t = 8 * tq + tt; const float L = Lc[tt] + off, Lm = L - ld[tt], eL = expf_(L), eLm = expf_(Lm), enL = expf_(-L);
            const float At = -kq[tt] * eLm, Bt = kq[tt] * av[tt] * enL, Kt = kp[tt] * enL, Rt = rr[tt] * eL;
            *(LAS bf16_t*)(B0 + swz(t, j)) = (bf16_t)f2bf(At); *(LAS bf16_t*)(B2 + swz(t, j)) = (bf16_t)f2bf(Bt); *(LAS bf16_t*)(B4 + swz(t, j)) = (bf16_t)f2bf(Kt); *(LAS bf16_t*)(B6 + swz(t, j)) = (bf16_t)f2bf(Rt);
            RtF[t * 65 + j] = Rt; fa[tt] = At; fb[tt] = Bt; fk[tt] = Kt; gt[tt] = GGf[t * 65 + j]; bn[tt] = bs[tt] * vv[tt];
            if (t == 63) gam[j] = eL;
        }
#define R1_PK8(a) ((u32x4){pk2(a[0], a[1]), pk2(a[2], a[3]), pk2(a[4], a[5]), pk2(a[6], a[7])})
        *(LAS u32x4*)(B1 + swz(j, 8 * tq)) = R1_PK8(fa); *(LAS u32x4*)(B3 + swz(j, 8 * tq)) = R1_PK8(fb); *(LAS u32x4*)(B5 + swz(j, 8 * tq)) = R1_PK8(fk); *(LAS u32x4*)(B7 + swz(j, 8 * tq)) = R1_PK8(vv);
        *(u32x4*)((bf16_t*)(p.ws + WS_GT) + (size_t)u * 4096 + j * 64 + 8 * tq) = R1_PK8(gt);
        *(u32x4*)((bf16_t*)(p.ws + WS_BNT) + (size_t)u * 4096 + j * 64 + 8 * tq) = R1_PK8(bn);
#undef R1_PK8
    }
    WG_SYNC();
    f32x4 accP[2];
    const f32x4 zero4 = (f32x4){0.f, 0.f, 0.f, 0.f};
#pragma unroll
    for (int q = 0; q < 2; ++q) {
        const int ti = 2 * wave + q, m0 = 16 * (ti >> 2), n0 = 16 * (ti & 3), s = n0 + r;
        f32x4 x = mm64(B0, m0, B2, n0, zero4, lane);
        f32x4 pI;
#pragma unroll
        for (int reg = 0; reg < 4; ++reg) { const int t = m0 + 4 * g4 + reg; if (!(t > s)) x[reg] = 0.f; pI[reg] = x[reg] + (t == s ? 1.f : 0.f); }
        st_tile(A0, m0, n0, x, lane); st_tile_T(A1, m0, n0, x, lane); st_tile(A2, m0, n0, pI, lane); accP[q] = pI;
        x = mm64(B0, m0, B4, n0, zero4, lane);
#pragma unroll
        for (int reg = 0; reg < 4; ++reg) { const int t = m0 + 4 * g4 + reg; if (!(t > s)) x[reg] = 0.f; }
        st_tile(A3, m0, n0, x, lane);
        x = mm64(B6, m0, B2, n0, zero4, lane);
#pragma unroll
        for (int reg = 0; reg < 4; ++reg) { const int t = m0 + 4 * g4 + reg; if (!(t >= s)) x[reg] = 0.f; }
        st_tile(A4, m0, n0, x, lane);
        x = mm64(B6, m0, B4, n0, zero4, lane);
#pragma unroll
        for (int reg = 0; reg < 4; ++reg) { const int t = m0 + 4 * g4 + reg; if (!(t >= s)) x[reg] = 0.f; }
        st_tile(A5, m0, n0, x, lane);
    }
    WG_SYNC();
#define R1_STAGE_A(Ys, YTs, Yd, YTd) do { _Pragma("unroll") for (int q = 0; q < 2; ++q) { const int ti = 2 * wave + q, m0 = 16 * (ti >> 2), n0 = 16 * (ti & 3); \
        const f32x4 x = mm64(Ys, m0, YTs, n0, zero4, lane); st_tile(Yd, m0, n0, x, lane); st_tile_T(YTd, m0, n0, x, lane); } } while (0)
#define R1_STAGE_B(Ps, YTn, Pd) do { _Pragma("unroll") for (int q = 0; q < 2; ++q) { const int ti = 2 * wave + q, m0 = 16 * (ti >> 2), n0 = 16 * (ti & 3); \
        accP[q] = mm64(Ps, m0, YTn, n0, accP[q], lane); st_tile(Pd, m0, n0, accP[q], lane); } } while (0)
    R1_STAGE_A(A0, A1, B0, B2);
    WG_SYNC();
#pragma unroll 1
    for (int it = 1; it <= 5; ++it) {
        const int nxt = it & 1;
        LDSP Ps = nxt ? A2 : B4, Pd = nxt ? B4 : A2, YTn = nxt ? B2 : A1;
        R1_STAGE_B(Ps, YTn, Pd);
        if (it < 5) { LDSP Ys = nxt ? B0 : A0, YTs = nxt ? B2 : A1, Yd = nxt ? A0 : B0, YTd = nxt ? A1 : B2; R1_STAGE_A(Ys, YTs, Yd, YTd); }
        WG_SYNC();
    }
#undef R1_STAGE_A
#undef R1_STAGE_B
#pragma unroll
    for (int q = 0; q < 2; ++q) {
        const int ti = 2 * wave + q, m0 = 16 * (ti >> 2), n0 = 16 * (ti & 3);
        st_tile(B6, m0, n0, mm64(B1, m0, B4, n0, zero4, lane), lane);
        st_tile(A0, m0, n0, mm64(B7, m0, A3, n0, zero4, lane), lane);
    }
    WG_SYNC();
#pragma unroll
    for (int q = 0; q < 2; ++q) {
        const int ti = 2 * wave + q, m0 = 16 * (ti >> 2), n0 = 16 * (ti & 3);
        st_tile(A1, m0, n0, mm64(A0, m0, B4, n0, zero4, lane), lane);
        f32x4 x = mm64(B6, m0, B3, n0, zero4, lane);
        { const int jp = n0 + r; const float gj = gam[jp]; u32x2 w;
          float y[4];
#pragma unroll
          for (int reg = 0; reg < 4; ++reg) y[reg] = (x[reg] + ((m0 + 4 * g4 + reg) == jp ? 1.f : 0.f)) * gj;
          w.x = pk2(y[0], y[1]); w.y = pk2(y[2], y[3]);
          *(u32x2*)((bf16_t*)(p.ws + WS_PCT) + (size_t)u * 4096 + jp * 64 + m0 + 4 * g4) = w; }
        x = mm64(A4, m0, B6, n0, zero4, lane);
        { bf16_t* Q = (bf16_t*)(p.ws + WS_QTT) + (size_t)u * 4096;
#pragma unroll
          for (int reg = 0; reg < 4; ++reg) { const int t = m0 + 4 * g4 + reg; Q[t * 64 + n0 + r] = (bf16_t)f2bf(x[reg] + RtF[t * 65 + n0 + r]); } }
    }
    WG_SYNC();
#pragma unroll
    for (int q = 0; q < 2; ++q) {
        const int ti = 2 * wave + q, m0 = 16 * (ti >> 2), n0 = 16 * (ti & 3);
        f32x4 x = mm64(B3, m0, A1, n0, zero4, lane); x = mm64(B5, m0, B7, n0, x, lane);
#pragma unroll
        for (int reg = 0; reg < 4; ++reg) x[reg] *= gam[m0 + 4 * g4 + reg];
        *(f32x4*)((float*)(p.ws + WS_UCS) + (size_t)u * 4096 + (n0 + r) * 64 + m0 + 4 * g4) = x;
        x = mm64(A4, m0, A1, n0, zero4, lane); x = mm64(A5, m0, B7, n0, x, lane);
        *(f32x4*)((float*)(p.ws + WS_YLT) + (size_t)u * 4096 + (ti * 64 + lane) * 4) = x;
    }
    WG_SYNC();
}

DEV void r2_chain(const Params& p, int l, int task, int lane) {
    const int h = task >> 2, q = task & 3, r = lane & 15, g4 = lane >> 4, i = 16 * q + r;
    const bf16_t* PCT = (const bf16_t*)(p.ws + WS_PCT); const float* UCS = (const float*)(p.ws + WS_UCS); bf16_t* SC = (bf16_t*)(p.ws + WS_SC);
    f32x4 S[4];
#pragma unroll
    for (int mt = 0; mt < 4; ++mt) S[mt] = (f32x4){0.f, 0.f, 0.f, 0.f};
    bf16x4 a0[4][2], a1[4][2]; f32x4 ci[4];
#define R2_LOAD(cc) do { const size_t u_ = (size_t)(cc) * AH + h; _Pragma("unroll") for (int mt = 0; mt < 4; ++mt) { ci[mt] = *(const f32x4*)(UCS + u_ * 4096 + i * 64 + 16 * mt + 4 * g4); \
        _Pragma("unroll") for (int ks = 0; ks < 2; ++ks) { a0[mt][ks] = *(const bf16x4*)(PCT + u_ * 4096 + (16 * mt + r) * 64 + 32 * ks + 4 * g4); a1[mt][ks] = *(const bf16x4*)(PCT + u_ * 4096 + (16 * mt + r) * 64 + 32 * ks + 16 + 4 * g4); } } } while (0)
    R2_LOAD(0);
#pragma unroll 1
    for (int c = 0; c < NCH; ++c) {
        const size_t u = (size_t)c * AH + h;
        bf16x8 pb[2];
#pragma unroll
        for (int ks = 0; ks < 2; ++ks) pb[ks] = pack8(S[2 * ks], S[2 * ks + 1]);
#pragma unroll
        for (int mt = 0; mt < 4; ++mt) { u32x2 w; w.x = pk2(S[mt][0], S[mt][1]); w.y = pk2(S[mt][2], S[mt][3]); *(u32x2*)(SC + u * 4096 + i * 64 + 16 * mt + 4 * g4) = w; }
        bf16x8 af[4][2]; f32x4 cc[4];
#pragma unroll
        for (int mt = 0; mt < 4; ++mt) { cc[mt] = ci[mt];
#pragma unroll
            for (int ks = 0; ks < 2; ++ks) af[mt][ks] = (bf16x8){a0[mt][ks][0], a0[mt][ks][1], a0[mt][ks][2], a0[mt][ks][3], a1[mt][ks][0], a1[mt][ks][1], a1[mt][ks][2], a1[mt][ks][3]}; }
        if (c + 1 < NCH) R2_LOAD(c + 1);
#pragma unroll
        for (int mt = 0; mt < 4; ++mt) { f32x4 x = MFMA16(af[mt][0], pb[0], cc[mt]); S[mt] = MFMA16(af[mt][1], pb[1], x); }
    }
#undef R2_LOAD
    float* o = p.out + O_PWKV + ((size_t)l * AH + h) * 4096;
#pragma unroll
    for (int mt = 0; mt < 4; ++mt) *(f32x4*)(o + i * 64 + 16 * mt + 4 * g4) = S[mt];
}

constexpr int R2_NSLOT = 12, R2_SLOTB = 12288, R2_FLAGS = R2_NSLOT * R2_SLOTB;
static_assert(R2_FLAGS + 128 <= LDS_CTL_OFF, "R2 ring");
DEV void r2_chain_ring(const Params& p, int l, int task, LDSP lds, int wave, int lane) {
    const int h = task >> 2, q = task & 3, r = lane & 15, g4 = lane >> 4, i = 16 * q + r;
    volatile LAS unsigned* full = (volatile LAS unsigned*)(lds + R2_FLAGS); volatile LAS unsigned* prog = full + 16;
    if (wave == 0 && lane < 32) full[lane] = 0u;
    WG_SYNC();
    if (wave > 0) {
        const unsigned char* PCT = p.ws + WS_PCT; const unsigned char* UCS = p.ws + WS_UCS;
#pragma unroll 1
        for (int c = wave - 1; c < NCH; c += NWAVES - 1) {
            const size_t u = (size_t)c * AH + h; const int slot = c % R2_NSLOT;
            u32x4 v[12];
#pragma unroll
            for (int k = 0; k < 8; ++k) v[k] = *(const u32x4*)(PCT + u * 8192 + k * 1024 + lane * 16);
#pragma unroll
            for (int k = 0; k < 4; ++k) v[8 + k] = *(const u32x4*)(UCS + u * 16384 + (size_t)q * 4096 + k * 1024 + lane * 16);
            while ((int)*prog + R2_NSLOT <= c) SPIN_WAIT();
            COMPILER_FENCE();
#pragma unroll
            for (int k = 0; k < 12; ++k) *(LAS u32x4*)(lds + slot * R2_SLOTB + k * 1024 + lane * 16) = v[k];
            LDS_DRAIN();
            if (lane == 0) full[slot] = (unsigned)c + 1u;
        }
        return;
    }
    bf16_t* SC = (bf16_t*)(p.ws + WS_SC);
    f32x4 S[4];
#pragma unroll
    for (int mt = 0; mt < 4; ++mt) S[mt] = (f32x4){0.f, 0.f, 0.f, 0.f};
#pragma unroll 1
    for (int c = 0; c < NCH; ++c) {
        const size_t u = (size_t)c * AH + h; const int slot = c % R2_NSLOT;
        bf16x8 pb[2];
#pragma unroll
        for (int ks = 0; ks < 2; ++ks) pb[ks] = pack8(S[2 * ks], S[2 * ks + 1]);
#pragma unroll
        for (int mt = 0; mt < 4; ++mt) { u32x2 w; w.x = pk2(S[mt][0], S[mt][1]); w.y = pk2(S[mt][2], S[mt][3]); *(u32x2*)(SC + u * 4096 + i * 64 + 16 * mt + 4 * g4) = w; }
        while (full[slot] != (unsigned)c + 1u) SPIN_WAIT();
        COMPILER_FENCE();
        LDSP sl = lds + slot * R2_SLOTB;
        bf16x8 af[4][2]; f32x4 cc[4];
#pragma unroll
        for (int mt = 0; mt < 4; ++mt) { cc[mt] = *(const LAS f32x4*)(sl + 8192 + (r * 64 + 16 * mt + 4 * g4) * 4);
#pragma unroll
            for (int ks = 0; ks < 2; ++ks) { const bf16x4 lo = *(const LAS bf16x4*)(sl + ((16 * mt + r) * 64 + 32 * ks + 4 * g4) * 2), hi = *(const LAS bf16x4*)(sl + ((16 * mt + r) * 64 + 32 * ks + 16 + 4 * g4) * 2);
                af[mt][ks] = (bf16x8){lo[0], lo[1], lo[2], lo[3], hi[0], hi[1], hi[2], hi[3]}; } }
        LDS_DRAIN();
        if (lane == 0) *prog = (unsigned)c + 1u;
#pragma unroll
        for (int mt = 0; mt < 4; ++mt) { f32x4 x = MFMA16(af[mt][0], pb[0], cc[mt]); S[mt] = MFMA16(af[mt][1], pb[1], x); }
    }
    float* o = p.out + O_PWKV + ((size_t)l * AH + h) * 4096;
#pragma unroll
    for (int mt = 0; mt < 4; ++mt) *(f32x4*)(o + i * 64 + 16 * mt + 4 * g4) = S[mt];
}
DEV void r2_sample(const Params& p, int l, int task, int lane) {
    const int q = task & 3, bh = task >> 2, r = lane & 15, g4 = lane >> 4, i = 16 * q + r;
    const size_t u = (size_t)NUP + bh;
    const bf16_t* PCT = (const bf16_t*)(p.ws + WS_PCT) + u * 4096; const float* UCS = (const float*)(p.ws + WS_UCS) + u * 4096;
    const float* S0 = PIN(p, I_SWKV) + ((size_t)l * DECB * AH + bh) * 4096;
    bf16x8 pb[2];
#pragma unroll
    for (int ks = 0; ks < 2; ++ks) { const f32x4 lo = *(const f32x4*)(S0 + i * 64 + 32 * ks + 8 * g4), hi = *(const f32x4*)(S0 + i * 64 + 32 * ks + 8 * g4 + 4); pb[ks] = pack8(lo, hi); }
    float* o = p.out + O_SWKV + ((size_t)l * DECB * AH + bh) * 4096;
#pragma unroll
    for (int mt = 0; mt < 4; ++mt) {
        f32x4 x = *(const f32x4*)(UCS + i * 64 + 16 * mt + 4 * g4);
#pragma unroll
        for (int ks = 0; ks < 2; ++ks) { const bf16x8 a = *(const bf16x8*)(PCT + (16 * mt + r) * 64 + 32 * ks + 8 * g4); x = MFMA16(a, pb[ks], x); }
        *(f32x4*)(o + i * 64 + 16 * mt + 4 * g4) = x;
    }
}

DEV void r3_work(const Params& p, int l, int u, int mt, int lane) {
    const bool samp = u >= NUP; int c = 0, b = 0, h;
    if (!samp) { c = u / AH; h = u % AH; } else { const int s = u - NUP; b = s / AH; h = s % AH; if (mt > 0) return; }
    const int r = lane & 15, g4 = lane >> 4;
    const bf16_t* Q = (const bf16_t*)(p.ws + WS_QTT) + (size_t)u * 4096;
    bf16x8 a[2];
#pragma unroll
    for (int ks = 0; ks < 2; ++ks) a[ks] = *(const bf16x8*)(Q + (16 * mt + r) * 64 + 32 * ks + 8 * g4);
    f32x4 acc[4];
#pragma unroll
    for (int nt = 0; nt < 4; ++nt) {
        acc[nt] = *(const f32x4*)((const float*)(p.ws + WS_YLT) + (size_t)u * 4096 + ((mt * 4 + nt) * 64 + lane) * 4);
#pragma unroll
        for (int ks = 0; ks < 2; ++ks) {
            bf16x8 bb;
            if (!samp) bb = *(const bf16x8*)((const bf16_t*)(p.ws + WS_SC) + (size_t)u * 4096 + (16 * nt + r) * 64 + 32 * ks + 8 * g4);
            else { const float* S0 = PIN(p, I_SWKV) + (((size_t)l * DECB + b) * AH + h) * 4096 + (16 * nt + r) * 64 + 32 * ks + 8 * g4; bb = pack8(*(const f32x4*)S0, *(const f32x4*)(S0 + 4)); }
            acc[nt] = MFMA16(a[ks], bb, acc[nt]);
        }
    }
    float mean[4], rs[4];
#pragma unroll
    for (int reg = 0; reg < 4; ++reg) {
        float s = (acc[0][reg] + acc[1][reg]) + (acc[2][reg] + acc[3][reg]);
        s = sum16(s);
        const float mn = s * (1.0f / 64.0f); float v = 0.f;
#pragma unroll
        for (int nt = 0; nt < 4; ++nt) { const float d = acc[nt][reg] - mn; v += d * d; }
        v = sum16(v);
        mean[reg] = mn; rs[reg] = RSQRTF(v * (1.0f / 64.0f) + GN_EPS);
    }
    bf16_t* YA = (bf16_t*)(p.ws + WS_YA);
#pragma unroll
    for (int nt = 0; nt < 4; ++nt) {
        const int i = 16 * nt + r; const float gain = PIN(p, I_GNG)[(size_t)l * AW + 64 * h + i], bias = PIN(p, I_GNB)[(size_t)l * AW + 64 * h + i];
        const u32x2 g2 = *(const u32x2*)((const bf16_t*)(p.ws + WS_GT) + (size_t)u * 4096 + i * 64 + 16 * mt + 4 * g4);
        const u32x2 b2 = *(const u32x2*)((const bf16_t*)(p.ws + WS_BNT) + (size_t)u * 4096 + i * 64 + 16 * mt + 4 * g4);
        const float gg[4] = {bf2f(g2.x & 0xffffu), bf2f(g2.x >> 16), bf2f(g2.y & 0xffffu), bf2f(g2.y >> 16)};
        const float bn[4] = {bf2f(b2.x & 0xffffu), bf2f(b2.x >> 16), bf2f(b2.y & 0xffffu), bf2f(b2.y >> 16)};
#pragma unroll
        for (int reg = 0; reg < 4; ++reg) {
            const int t = 16 * mt + 4 * g4 + reg; const size_t row = samp ? (size_t)SEQ + 16 * b + t : (size_t)64 * c + t;
            const float y = ((acc[nt][reg] - mean[reg]) * rs[reg] * gain + bias + bn[reg]) * gg[reg];
            YA[row * AW + 64 * h + i] = (bf16_t)f2bf(y);
        }
    }
}

constexpr int AT_KB = 0, AT_VT = 24576, AT_QB = 49152;
constexpr float QSCALE = 0.125f * LOG2E;
DEV void attn_unit(const Params& p, int l, int au, LDSP lds, int tid) {
    const int lane = tid & 63, wave = WAVE_ID(tid), r = lane & 15, g4 = lane >> 4;
    const bool samp = au >= NAP; int c = 0, b = 0, kh, nk, kbase = 0, nq;
    if (!samp) { c = au / BKV; kh = au % BKV; nk = 64 * (c + 1 < 3 ? c + 1 : 3); kbase = 64 * (c > 2 ? c - 2 : 0); nq = 64 * GRP; }
    else { const int s = au - NAP; b = s / BKV; kh = s % BKV; nk = WIN + DECS; nq = DECS * GRP; }
    const float* PF = (const float*)(p.ws + WS_PF); const float* rope = (const float*)(p.ws + WS_ROPE);
    LDSP Kb = lds + AT_KB, Vt = lds + AT_VT, Qb = lds + AT_QB;
    const int sub = tid & 7, rowi = tid >> 3;
#pragma unroll 1
    for (int pp = 0; pp < 3; ++pp) {
        const int kidx = pp * 64 + rowi;
        if (kidx < nk) {
            f32x4 k1, k2, v1, v2;
            if (samp && kidx < WIN) {
                const size_t o = ((((size_t)l * DECB + b) * WIN + kidx) * BKV + kh) * 64;
                k1 = *(const f32x4*)(PIN(p, I_CK) + o + 4 * sub); k2 = *(const f32x4*)(PIN(p, I_CK) + o + 32 + 4 * sub);
                v1 = *(const f32x4*)(PIN(p, I_CV) + o + 4 * sub); v2 = *(const f32x4*)(PIN(p, I_CV) + o + 32 + 4 * sub);
            }
            if (!(samp && kidx < WIN)) {
                const size_t tok = samp ? (size_t)SEQ + 16 * b + (kidx - WIN) : (size_t)kbase + kidx;
                const int slot = samp ? SEQ + (kidx - WIN) : (int)tok;
                const float* src = PF + tok * FW;
                const f32x4 x1 = *(const f32x4*)(src + C_BK + 64 * kh + 4 * sub), x2 = *(const f32x4*)(src + C_BK + 64 * kh + 32 + 4 * sub);
                v1 = *(const f32x4*)(src + C_BV + 64 * kh + 4 * sub); v2 = *(const f32x4*)(src + C_BV + 64 * kh + 32 + 4 * sub);
                float ss = (x1[0] * x1[0] + x1[1] * x1[1]) + (x1[2] * x1[2] + x1[3] * x1[3]) + (x2[0] * x2[0] + x2[1] * x2[1]) + (x2[2] * x2[2] + x2[3] * x2[3]);
                ss = sum8(ss);
                const float rinv = RSQRTF(ss * (1.0f / 64.0f) + RMS_EPS);
                const f32x4 gn1 = *(const f32x4*)(PIN(p, I_KN) + (size_t)l * 64 + 4 * sub), gn2 = *(const f32x4*)(PIN(p, I_KN) + (size_t)l * 64 + 32 + 4 * sub);
                const f32x4 cs0 = *(const f32x4*)(rope + (size_t)slot * 64 + 8 * sub), cs1 = *(const f32x4*)(rope + (size_t)slot * 64 + 8 * sub + 4);
                const float cc[4] = {cs0[0], cs0[2], cs1[0], cs1[2]}, sn[4] = {cs0[1], cs0[3], cs1[1], cs1[3]};
#pragma unroll
                for (int e = 0; e < 4; ++e) { const float y1 = x1[e] * rinv * gn1[e], y2 = x2[e] * rinv * gn2[e]; k1[e] = y1 * cc[e] - y2 * sn[e]; k2[e] = y2 * cc[e] + y1 * sn[e]; }
                if (samp) { const size_t o = ((((size_t)l * DECB + b) * DECS + (kidx - WIN)) * BKV + kh) * 64;
                    *(f32x4*)(p.out + O_SK + o + 4 * sub) = k1; *(f32x4*)(p.out + O_SK + o + 32 + 4 * sub) = k2; *(f32x4*)(p.out + O_SV + o + 4 * sub) = v1; *(f32x4*)(p.out + O_SV + o + 32 + 4 * sub) = v2; }
                else if (kidx >= nk - 64 && tok >= (size_t)(SEQ - WIN)) { const size_t o = (((size_t)l * WIN + (tok - (SEQ - WIN))) * BKV + kh) * 64;
                    *(f32x4*)(p.out + O_PK + o + 4 * sub) = k1; *(f32x4*)(p.out + O_PK + o + 32 + 4 * sub) = k2; *(f32x4*)(p.out + O_PV + o + 4 * sub) = v1; *(f32x4*)(p.out + O_PV + o + 32 + 4 * sub) = v2; }
            }
            u32x2 w; w.x = pk2(k1[0], k1[1]); w.y = pk2(k1[2], k1[3]); *(LAS u32x2*)(Kb + swz(kidx, 4 * sub)) = w;
            w.x = pk2(k2[0], k2[1]); w.y = pk2(k2[2], k2[3]); *(LAS u32x2*)(Kb + swz(kidx, 32 + 4 * sub)) = w;
#pragma unroll
            for (int e = 0; e < 4; ++e) { *(LAS bf16_t*)(Vt + swz192(4 * sub + e, kidx)) = (bf16_t)f2bf(v1[e]); *(LAS bf16_t*)(Vt + swz192(32 + 4 * sub + e, kidx)) = (bf16_t)f2bf(v2[e]); }
        } else if (kidx < ((nk + 31) & ~31)) {
#pragma unroll
            for (int e = 0; e < 4; ++e) { *(LAS bf16_t*)(Vt + swz192(4 * sub + e, kidx)) = 0; *(LAS bf16_t*)(Vt + swz192(32 + 4 * sub + e, kidx)) = 0; }
        }
    }
#pragma unroll 1
    for (int pp = 0; pp < GRP; ++pp) {
        const int q = pp * 64 + rowi;
        if (q < nq) {
            const int g = samp ? q >> 4 : q >> 6, t = samp ? q & 15 : q & 63, head = kh * GRP + g;
            const size_t tok = samp ? (size_t)SEQ + 16 * b + t : (size_t)64 * c + t; const int slot = samp ? SEQ + t : (int)tok;
            const float* src = PF + tok * FW + C_Q + 64 * head;
            const f32x4 x1 = *(const f32x4*)(src + 4 * sub), x2 = *(const f32x4*)(src + 32 + 4 * sub);
            float ss = (x1[0] * x1[0] + x1[1] * x1[1]) + (x1[2] * x1[2] + x1[3] * x1[3]) + (x2[0] * x2[0] + x2[1] * x2[1]) + (x2[2] * x2[2] + x2[3] * x2[3]);
            ss = sum8(ss);
            const float rinv = RSQRTF(ss * (1.0f / 64.0f) + RMS_EPS) * QSCALE;
            const f32x4 gn1 = *(const f32x4*)(PIN(p, I_QN) + (size_t)l * 64 + 4 * sub), gn2 = *(const f32x4*)(PIN(p, I_QN) + (size_t)l * 64 + 32 + 4 * sub);
            const f32x4 cs0 = *(const f32x4*)(rope + (size_t)slot * 64 + 8 * sub), cs1 = *(const f32x4*)(rope + (size_t)slot * 64 + 8 * sub + 4);
            const float cc[4] = {cs0[0], cs0[2], cs1[0], cs1[2]}, sn[4] = {cs0[1], cs0[3], cs1[1], cs1[3]};
            float o1[4], o2[4];
#pragma unroll
            for (int e = 0; e < 4; ++e) { const float y1 = x1[e] * rinv * gn1[e], y2 = x2[e] * rinv * gn2[e]; o1[e] = y1 * cc[e] - y2 * sn[e]; o2[e] = y2 * cc[e] + y1 * sn[e]; }
            u32x2 w; w.x = pk2(o1[0], o1[1]); w.y = pk2(o1[2], o1[3]); *(LAS u32x2*)(Qb + swz(q, 4 * sub)) = w;
            w.x = pk2(o2[0], o2[1]); w.y = pk2(o2[2], o2[3]); *(LAS u32x2*)(Qb + swz(q, 32 + 4 * sub)) = w;
        }
    }
    WG_SYNC();
    const int nqt = nq >> 4, nkt = nk >> 4;
    bf16_t* YB = (bf16_t*)(p.ws + WS_YB);
#pragma unroll 1
    for (int qt = wave; qt < nqt; qt += NWAVES) {
        const int g = samp ? qt : qt >> 2, head = kh * GRP + g;
        const float sink2 = PIN(p, I_SINK)[(size_t)l * BH + head] * LOG2E;
        bf16x8 bq[2];
#pragma unroll
        for (int ks = 0; ks < 2; ++ks) bq[ks] = *(const LAS bf16x8*)(Qb + swz(16 * qt + r, 32 * ks + 8 * g4));
        f32x4 s[12];
#pragma unroll
        for (int kt = 0; kt < 12; ++kt) { s[kt] = (f32x4){0.f, 0.f, 0.f, 0.f};
            if (kt < nkt) {
#pragma unroll
                for (int ks = 0; ks < 2; ++ks) { const bf16x8 a = *(const LAS bf16x8*)(Kb + swz(16 * kt + r, 32 * ks + 8 * g4)); s[kt] = MFMA16(a, bq[ks], s[kt]); } } }
        float mx = sink2;
#pragma unroll
        for (int kt = 0; kt < 12; ++kt) if (kt < nkt) mx = fmaxf(fmaxf(mx, fmaxf(s[kt][0], s[kt][1])), fmaxf(s[kt][2], s[kt][3]));
        mx = fmaxf(mx, SHFL_XOR(mx, 16)); mx = fmaxf(mx, SHFL_XOR(mx, 32));
        float sum = 0.f;
#pragma unroll
        for (int kt = 0; kt < 12; ++kt) if (kt < nkt) {
#pragma unroll
            for (int e = 0; e < 4; ++e) { s[kt][e] = EXP2F(s[kt][e] - mx); sum += s[kt][e]; } }
        sum += SHFL_XOR(sum, 16); sum += SHFL_XOR(sum, 32);
        const float rden = 1.0f / (sum + EXP2F(sink2 - mx));
        f32x4 o[4];
#pragma unroll
        for (int dt = 0; dt < 4; ++dt) o[dt] = (f32x4){0.f, 0.f, 0.f, 0.f};
#pragma unroll
        for (int s2 = 0; s2 < 6; ++s2) if (2 * s2 < nkt) {
            const bf16x8 pb = pack8(s[2 * s2], s[2 * s2 + 1]);
#pragma unroll
            for (int dt = 0; dt < 4; ++dt) {
                const bf16x4 lo = *(const LAS bf16x4*)(Vt + swz192(16 * dt + r, 32 * s2 + 4 * g4)), hi = *(const LAS bf16x4*)(Vt + swz192(16 * dt + r, 32 * s2 + 16 + 4 * g4));
                o[dt] = MFMA16(((bf16x8){lo[0], lo[1], lo[2], lo[3], hi[0], hi[1], hi[2], hi[3]}), pb, o[dt]);
            }
        }
        const int q = 16 * qt + r, t = samp ? q & 15 : q & 63; const size_t tok = samp ? (size_t)SEQ + 16 * b + t : (size_t)64 * c + t;
#pragma unroll
        for (int dt = 0; dt < 4; ++dt) { u32x2 w; w.x = pk2(o[dt][0] * rden, o[dt][1] * rden); w.y = pk2(o[dt][2] * rden, o[dt][3] * rden); *(u32x2*)(YB + tok * BQ + 64 * head + 16 * dt + 4 * g4) = w; }
    }
    WG_SYNC();
}

#ifndef EMU
#define XB_TMO      128
#define XB_XCNT(j)  (256  + 64 * (j))
#define XB_XSUB(j)  (1280 + 64 * (j))
#define XB_XGEN(j)  (2304 + 64 * (j))
#define XB_TOP      3328
#define XB_TOPGEN   3392
#define XCD_BAR_WORDS 3456
#define XB_SPIN_CAP (1u << 18)

__device__ __forceinline__ unsigned xb_ld(unsigned* p)              { return __hip_atomic_load(p, __ATOMIC_RELAXED, __HIP_MEMORY_SCOPE_AGENT); }
__device__ __forceinline__ unsigned xb_add(unsigned* p, unsigned v) { return __hip_atomic_fetch_add(p, v, __ATOMIC_RELAXED, __HIP_MEMORY_SCOPE_AGENT); }
__device__ __forceinline__ unsigned xb_xcc_id() { return (unsigned)__builtin_amdgcn_s_getreg((3 << 11) | 20) & 0xFu; }
#define XB_SPIN(cond, bar) do { unsigned _sp = 0; while (cond) { __builtin_amdgcn_s_sleep(1); \
    if ((++_sp & 255u) == 0u) { if (xb_ld(&(bar)[XB_TMO])) break; if (_sp > XB_SPIN_CAP) { atomicAdd(&(bar)[XB_TMO], 1u); break; } } } } while (0)

struct XcdBarrier {
    unsigned* bar; unsigned x;
    volatile LAS unsigned* st;
};

__device__ __forceinline__ XcdBarrier xcd_barrier_post(unsigned* bar, volatile LAS unsigned* st) {
    XcdBarrier b; b.bar = bar; b.x = xb_xcc_id(); b.st = st;
    if (threadIdx.x == 0) (void)xb_add(&bar[XB_XCNT(b.x)], 1u);
    return b;
}
__device__ __forceinline__ void xcd_barrier_complete(unsigned* bar, unsigned x, unsigned& nloc, unsigned& nx) {
    const unsigned G = gridDim.x * gridDim.y * gridDim.z;
    unsigned sum, cnt, mine, sp = 0u;
    for (;;) {
        sum = 0u; cnt = 0u; mine = 0u;
#pragma unroll
        for (unsigned j = 0; j < 16; ++j) { const unsigned c = xb_ld(&bar[XB_XCNT(j)]); sum += c; cnt += (c > 0u) ? 1u : 0u; mine = (j == x) ? c : mine; }
        if (sum == G) break;
        __builtin_amdgcn_s_sleep(1);
        if ((++sp & 255u) == 0u) { if (xb_ld(&bar[XB_TMO])) break; if (sp > XB_SPIN_CAP) { atomicAdd(&bar[XB_TMO], 1u); break; } }
    }
    nloc = mine > 0u ? mine : 1u; nx = cnt > 0u ? cnt : 1u;
}

__device__ __forceinline__ void xcd_barrier(const XcdBarrier& b) {
    asm volatile("s_waitcnt vmcnt(0)" ::: "memory");
    __syncthreads();
    if (threadIdx.x == 0) {
        unsigned* bar = b.bar;
        __builtin_amdgcn_s_waitcnt(0);
        unsigned nloc = b.st[0], nx = b.st[1];
        if (nloc == 0u) { xcd_barrier_complete(bar, b.x, nloc, nx); b.st[0] = nloc; b.st[1] = nx; }
        const unsigned old = xb_add(&bar[XB_XSUB(b.x)], 1u);
        const unsigned gen = old / nloc;
        if (old + 1u == (gen + 1u) * nloc) {
            __builtin_amdgcn_fence(__ATOMIC_RELEASE, "agent");
            asm volatile("s_waitcnt vmcnt(0)" ::: "memory");
            const unsigned og = xb_add(&bar[XB_TOP], 1u);
            const unsigned tg = og / nx;
            if (og + 1u == (tg + 1u) * nx) xb_add(&bar[XB_TOPGEN], 1u);
            else XB_SPIN(xb_ld(&bar[XB_TOPGEN]) == tg, bar);
            __builtin_amdgcn_fence(__ATOMIC_ACQUIRE, "agent");
            xb_add(&bar[XB_XGEN(b.x)], 1u);
            asm volatile("s_waitcnt vmcnt(0)" ::: "memory");
        } else {
            XB_SPIN(xb_ld(&bar[XB_XGEN(b.x)]) == gen, bar);
            __builtin_amdgcn_fence(__ATOMIC_ACQUIRE, "agent");
            asm volatile("s_waitcnt vmcnt(0)" ::: "memory");
        }
    }
    __syncthreads();
}
#endif

#ifndef REP_GU
#define REP_GU 1
#endif
#ifndef REP_DOWN
#define REP_DOWN 1
#endif
#ifndef REP_WIN
#define REP_WIN 1
#endif
#ifndef REP_PRO
#define REP_PRO 1
#endif
#ifndef REP_NORM
#define REP_NORM 1
#endif
#ifndef REP_R1
#define REP_R1 1
#endif
#ifndef REP_R2
#define REP_R2 1
#endif
#ifndef REP_R3
#define REP_R3 1
#endif

#ifndef EMU
#define GRID_BAR() xcd_barrier(bar)
constexpr int CW_BAR = 4096;
__global__ void __launch_bounds__(NTHR, 2) fwd(Params p) {
    extern __shared__ __attribute__((aligned(16))) unsigned char lds_raw[];
    LDSP lds = (LDSP)lds_raw;
    const int wave = __builtin_amdgcn_readfirstlane(TID() >> 6), G = GRID(), bid = BID();
    for (int u = TID(); u < (LDS_BYTES - LDS_CTL_OFF) / 4; u += NTHR) ((LAS unsigned*)(lds + LDS_CTL_OFF))[u] = 0u;
    __syncthreads();
    XcdBarrier bar = xcd_barrier_post((unsigned*)(p.ws + WS_CTL) + CW_BAR, (volatile LAS unsigned*)(lds + LDS_CTL_OFF + 32));
#else
#define GRID_BAR() emu_grid_sync()
static void fwd(Params p) {
    LDSP lds = emu_lds();
    const int wave = TID() >> 6, G = GRID(), bid = BID();
#endif
    const int gw = bid * NWAVES + wave, NGW = G * NWAVES, NGT = G * NTHR;
#define LANE_TID() const int lane = FRESH_LANE(), tid = wave * 64 + lane; (void)tid
    bf16_t* H = (bf16_t*)(p.ws + WS_H); float* X = p.out;


#ifndef SKIP_PRO
    for (int rep_ = 0; rep_ < REP_PRO; ++rep_) { LANE_TID(); prologue(p, lds, gw, NGW, wave, lane, bid * NTHR + tid, NGT); if (rep_ + 1 < REP_PRO) GRID_BAR(); }
#endif

#pragma unroll 1
    for (int it = 0; it < 2 * DEPTH; ++it) {
        const int l = it >> 1; const bool sec = (it & 1) != 0;
        for (int rep_ = 0; rep_ < REP_NORM; ++rep_) { { LANE_TID(); norm_phase(p, PIN(p, sec ? I_NFF2 : I_NFF1) + (size_t)l * DM, it == 0, gw, NGW, lane); }
        GRID_BAR(); }

for (int rep_ = 0; rep_ < REP_GU; ++rep_) {
#ifndef SKIP_GU
        { pg8::Gemm g{H, lwp(p, l, sec ? OFF_WGU2 : OFF_WGU1), M, 2 * DFF, DM}; pg8::StaticOrder S; S.init(M, 2 * DFF, G, bid);
          EpiSwiglu E{(bf16_t*)(p.ws + WS_G)};
          pg8::gemm_phase<EpiSwiglu, pg8::StaticOrder, true, true>(lds, g, S, E, wave); }
#endif

        GRID_BAR(); }

for (int rep_ = 0; rep_ < REP_DOWN; ++rep_) {
#ifndef SKIP_DOWN
        { pg8::Gemm g{(const bf16_t*)(p.ws + WS_G), lwp(p, l, sec ? OFF_WD2 : OFF_WD1), SEQ, DM, DFF}; pg8::StaticOrder S; S.init(SEQ, DM, G, bid);
          EpiResid E{X, 0.5f / REP_DOWN};
          pg8::gemm_phase<EpiResid, pg8::StaticOrder, true, true>(lds, g, S, E, wave);
#pragma unroll 1
          for (int tile = bid; tile < (MS / 64) * (DM / 64); tile += G) { LANE_TID(); sgemm_tile(g.A, g.Bt, DFF, SEQ + 64 * (tile % (MS / 64)), 64 * (tile / (MS / 64)), lds, tid, E); } }
#endif
        if (rep_ + 1 < REP_DOWN) GRID_BAR(); }

        if (it == 2 * DEPTH - 1) break;
        GRID_BAR();
        if (!sec) {
            for (int rep_ = 0; rep_ < REP_NORM; ++rep_) { { LANE_TID(); norm_phase(p, PIN(p, I_NMIX) + (size_t)l * DM, false, gw, NGW, lane); }
            GRID_BAR(); }

for (int rep_ = 0; rep_ < REP_WIN; ++rep_) {
#ifndef SKIP_WIN
            { pg8::Gemm g{H, lwp(p, l, OFF_WIN), M, NIN, DM}; pg8::StaticOrder S; S.init(M, NIN, G, bid);
              EpiWin E{(float*)(p.ws + WS_PF), (bf16_t*)(p.ws + WS_SG)};
              pg8::gemm_phase<EpiWin, pg8::StaticOrder, true, true>(lds, g, S, E, wave); }
#endif

            GRID_BAR(); }

            for (int rep_ = 0; rep_ < REP_R1; ++rep_) {
#ifndef SKIP_R1
#pragma unroll 1
            for (int u = bid; u < NU; u += G) { LANE_TID(); r1_unit(p, l, u, lds, tid); }
#pragma unroll 1
            for (int au = bid; au < NA; au += G) { LANE_TID(); attn_unit(p, l, au, lds, tid); }
#endif

            GRID_BAR(); }

            for (int rep_ = 0; rep_ < REP_R2; ++rep_) {
#ifndef SKIP_R2
            { constexpr int nchain = 4 * AH; LANE_TID();
              if (G > nchain) {
                  if (bid < nchain) r2_chain_ring(p, l, bid, lds, wave, lane);
                  else { const int ob = bid - nchain, OG = G - nchain;
#pragma unroll 1
                      for (int task = ob * NWAVES + wave; task < 4 * NUS; task += OG * NWAVES) r2_sample(p, l, task, lane); }
              } else {
#pragma unroll 1
                  for (int task = bid; task < nchain; task += G) r2_chain_ring(p, l, task, lds, wave, lane);
#pragma unroll 1
                  for (int task = gw; task < 4 * NUS; task += NGW) r2_sample(p, l, task, lane);
              } }
#endif

            GRID_BAR(); }

            for (int rep_ = 0; rep_ < REP_R3; ++rep_) {
#ifndef SKIP_R3
            { const int worker = bid * 2 + (wave >> 2), NW = 2 * G; LANE_TID(); const int gtid = bid * NTHR + tid;
#pragma unroll 1
              for (int u = worker; u < NU; u += NW) r3_work(p, l, u, wave & 3, lane);
              const float* PF = (const float*)(p.ws + WS_PF);
              for (int idx = gtid; idx < (1 + DECB) * ACOLS; idx += NGT) { const int s = idx / ACOLS, col = idx % ACOLS;
                  if (s == 0) p.out[O_PSH + (size_t)l * ACOLS + col] = PF[(size_t)(SEQ - 1) * FW + col];
                  else p.out[O_SSH + ((size_t)l * DECB + (s - 1)) * ACOLS + col] = PF[((size_t)SEQ + 16 * (s - 1) + 15) * FW + col]; } }
#endif

            GRID_BAR(); }

#ifndef SKIP_UPA
            { pg8::Gemm g{(const bf16_t*)(p.ws + WS_YA), lwp(p, l, OFF_WUA), SEQ, DM, AW}; pg8::StaticOrder S; S.init(SEQ, DM, G, bid);
              EpiUpA E{(const bf16_t*)(p.ws + WS_SG), (float*)(p.ws + WS_T1)};
              pg8::gemm_phase<EpiUpA, pg8::StaticOrder, true, true>(lds, g, S, E, wave);
#pragma unroll 1
          for (int tile = bid; tile < (MS / 64) * (DM / 64); tile += G) { LANE_TID(); sgemm_tile(g.A, g.Bt, AW, SEQ + 64 * (tile % (MS / 64)), 64 * (tile / (MS / 64)), lds, tid, E); } }
#endif


#ifndef SKIP_UPB
            { pg8::Gemm g{(const bf16_t*)(p.ws + WS_YB), lwp(p, l, OFF_WUB), SEQ, DM, BQ}; pg8::StaticOrder S; S.init(SEQ, DM, G, bid);
              EpiUpB E{(const bf16_t*)(p.ws + WS_SG), (const float*)(p.ws + WS_T1), (bf16_t*)(p.ws + WS_MG)};
              pg8::gemm_phase<EpiUpB, pg8::StaticOrder, true, true>(lds, g, S, E, wave);
#pragma unroll 1
          for (int tile = bid; tile < (MS / 64) * (DM / 64); tile += G) { LANE_TID(); sgemm_tile(g.A, g.Bt, BQ, SEQ + 64 * (tile % (MS / 64)), 64 * (tile / (MS / 64)), lds, tid, E); } }
#endif

            GRID_BAR();

#ifndef SKIP_WO
            { pg8::Gemm g{(const bf16_t*)(p.ws + WS_MG), lwp(p, l, OFF_WO), SEQ, DM, DM}; pg8::StaticOrder S; S.init(SEQ, DM, G, bid);
              EpiResid E{X, 1.0f};
              pg8::gemm_phase<EpiResid, pg8::StaticOrder, true, true>(lds, g, S, E, wave);
#pragma unroll 1
          for (int tile = bid; tile < (MS / 64) * (DM / 64); tile += G) { LANE_TID(); sgemm_tile(g.A, g.Bt, DM, SEQ + 64 * (tile % (MS / 64)), 64 * (tile / (MS / 64)), lds, tid, E); } }
#endif

            GRID_BAR();
        }
    }
}

#ifndef EMU
extern "C" void kernel_launch(void* const* d_in, const int* in_sizes, int n_in, void* d_out, int out_size, void* d_ws, size_t ws_size, hipStream_t stream) {
    static int grid = 0;
    if (grid == 0) {
        if (n_in != 33 || (size_t)out_size != O_END || ws_size < WS_END) { fprintf(stderr, "kernel_launch: unexpected shapes (n_in %d, out %d, ws %zu, need %zu)\n", n_in, out_size, ws_size, (size_t)WS_END); grid = -1; return; }
        int dev = 0, cus = 0, per_cu = 0;
        if (hipGetDevice(&dev) != hipSuccess || hipDeviceGetAttribute(&cus, hipDeviceAttributeMultiprocessorCount, dev) != hipSuccess) { grid = -1; return; }
        if (hipFuncSetAttribute((const void*)fwd, hipFuncAttributeMaxDynamicSharedMemorySize, LDS_BYTES) != hipSuccess) { fprintf(stderr, "kernel_launch: hipFuncSetAttribute failed\n"); grid = -1; return; }
        if (hipOccupancyMaxActiveBlocksPerMultiprocessor(&per_cu, (const void*)fwd, NTHR, LDS_BYTES) != hipSuccess || per_cu < 1) fprintf(stderr, "kernel_launch: occupancy query reports %d\n", per_cu);
        (void)hipGetLastError();
        grid = cus;
    }
    if (grid < 0) return;
    if (hipMemsetAsync((char*)d_ws + WS_CTL, 0, CTL_BYTES, stream) != hipSuccess) return;
    Params p{};
    for (int i = 0; i < 33; ++i) p.in[i] = (const float*)d_in[i];
    p.out = (float*)d_out; p.ws = (unsigned char*)d_ws;
    hipLaunchKernelGGL(fwd, dim3(grid), dim3(NTHR), LDS_BYTES, stream, p);
}
#endif
```

```cpp
#ifndef EMU
#include <hip/hip_runtime.h>
#include <cstdio>
#include <cstdint>
#endif

#ifndef CFG_SMALL
constexpr int DM = 2048, SEQ = 8192, DEPTH = 4, DECB = 32, DECS = 16, PAST = 1024, AW = 1024, BH = 16, BKV = 4, DFF = 5504;
#else
constexpr int DM = 256, SEQ = 256, DEPTH = 2, DECB = 16, DECS = 16, PAST = 1024, AW = 128, BH = 4, BKV = 1, DFF = 384;
#endif
constexpr int HD = 64, AH = AW / HD, DLORA = 64, ILORA = 64, GLORA = 160, WIN = 128, GRP = BH / BKV;
constexpr int ACOLS = 3 * AW + DLORA + ILORA + GLORA, BQ = BH * HD, BKVW = BKV * HD, INCOLS = ACOLS + BQ + 2 * BKVW + 2 * DM;
constexpr int MS = DECB * DECS, M = SEQ + MS;
constexpr int FW_RAW = ACOLS + BQ + 2 * BKVW, FW = ((FW_RAW + 255) / 256) * 256, NIN = FW + 2 * DM;
constexpr int C_R = 0, C_WLO = AW, C_K = AW + DLORA, C_V = 2 * AW + DLORA, C_ALO = 3 * AW + DLORA, C_GLO = C_ALO + ILORA, C_Q = ACOLS, C_BK = ACOLS + BQ, C_BV = C_BK + BKVW;
constexpr int NCH = SEQ / 64, NUP = NCH * AH, NUS = DECB * AH, NU = NUP + NUS;
constexpr int NAP = NCH * BKV, NAS = DECB * BKV, NA = NAP + NAS;
constexpr float RMS_EPS = 1e-6f, GN_EPS = 64e-5f, LOG2E = 1.4426950408889634f;
static_assert(M % 256 == 0 && DM % 256 == 0 && DFF % 128 == 0 && AW % 128 == 0 && BQ % 128 == 0 && FW_RAW % 32 == 0 && DECS == 16 && GRP == 4, "shape constraints");

constexpr size_t O_YP = 0, O_YS = (size_t)SEQ * DM, O_PWKV = O_YS + (size_t)MS * DM, O_PSH = O_PWKV + (size_t)DEPTH * AH * 4096, O_PK = O_PSH + (size_t)DEPTH * ACOLS,
                 O_PV = O_PK + (size_t)DEPTH * WIN * BKVW, O_SWKV = O_PV + (size_t)DEPTH * WIN * BKVW, O_SSH = O_SWKV + (size_t)DEPTH * DECB * AH * 4096,
                 O_SK = O_SSH + (size_t)DEPTH * DECB * ACOLS, O_SV = O_SK + (size_t)DEPTH * DECB * DECS * BKVW, O_END = O_SV + (size_t)DEPTH * DECB * DECS * BKVW;

constexpr size_t al256(size_t x) { return (x + 255) & ~(size_t)255; }
constexpr size_t WS_CTL = 0, CTL_BYTES = 1u << 20;
constexpr size_t WS_ROPE = CTL_BYTES, ROPE_BYTES = al256((size_t)(SEQ + DECS) * 64 * 4);
constexpr int NSS = 3 * DEPTH + 1;
constexpr int NSLOT = DM / 32;
constexpr size_t WS_SS = WS_ROPE + ROPE_BYTES, SS_BYTES = al256((size_t)NSS * NSLOT * M * 4);
static_assert(NSLOT <= 64, "slots written one per lane");
constexpr size_t WS_W = WS_SS + SS_BYTES;
constexpr size_t SZ_WGU = (size_t)2 * DFF * DM * 2, SZ_WD = (size_t)DM * DFF * 2, SZ_WIN = (size_t)NIN * DM * 2, SZ_WUA = (size_t)DM * AW * 2, SZ_WUB = (size_t)DM * BQ * 2, SZ_WO = (size_t)DM * DM * 2;
constexpr size_t OFF_WGU1 = 0, OFF_WD1 = OFF_WGU1 + SZ_WGU, OFF_WIN = OFF_WD1 + SZ_WD, OFF_WUA = OFF_WIN + SZ_WIN, OFF_WUB = OFF_WUA + SZ_WUA, OFF_WO = OFF_WUB + SZ_WUB,
                 OFF_WGU2 = OFF_WO + SZ_WO, OFF_WD2 = OFF_WGU2 + SZ_WGU, OFF_DW2T = OFF_WD2 + SZ_WD, OFF_IA2T = OFF_DW2T + (size_t)AW * 64 * 2, OFF_GG2T = OFF_IA2T + (size_t)AW * 64 * 2,
                 LAYER_W_BYTES = al256(OFF_GG2T + (size_t)AW * 160 * 2);
constexpr size_t WS_H = WS_W + (size_t)DEPTH * LAYER_W_BYTES;
constexpr size_t WS_PF = WS_H + al256((size_t)M * DM * 2);
constexpr size_t WS_SG = WS_PF + al256((size_t)M * FW * 4);
constexpr size_t WS_YA = WS_SG + al256((size_t)M * 2 * DM * 2);
constexpr size_t WS_YB = WS_YA + al256((size_t)M * AW * 2);
constexpr size_t WS_MG = WS_YB + al256((size_t)M * BQ * 2);
constexpr size_t WS_OV = WS_MG + al256((size_t)M * DM * 2);
constexpr size_t WS_G = WS_OV;
constexpr size_t WS_T1 = WS_OV;
constexpr size_t WS_PCT = WS_T1 + al256((size_t)M * DM * 4);
constexpr size_t WS_UCS = WS_PCT + (size_t)NU * 8192;
constexpr size_t WS_QTT = WS_UCS + (size_t)NU * 16384;
constexpr size_t WS_YLT = WS_QTT + (size_t)NU * 8192;
constexpr size_t WS_GT = WS_YLT + (size_t)NU * 16384;
constexpr size_t WS_BNT = WS_GT + (size_t)NU * 8192;
constexpr size_t WS_SC = WS_BNT + (size_t)NU * 8192;
constexpr size_t WS_OV_END_A = WS_SC + (size_t)NUP * 8192, WS_OV_END_B = WS_G + al256((size_t)M * DFF * 2);
constexpr size_t WS_END = WS_OV_END_A > WS_OV_END_B ? WS_OV_END_A : WS_OV_END_B;

constexpr int LDS_BYTES = 159744;
constexpr int LDS_CTL_OFF = LDS_BYTES - 1024;
constexpr int NWAVES = 8, NTHR = 512;
constexpr int LDS_RINV_OFF = 131072;
static_assert(LDS_RINV_OFF + 8 * 1024 <= LDS_CTL_OFF, "rinv tables");

typedef unsigned short bf16_t;
typedef short bf16x8 __attribute__((ext_vector_type(8)));
typedef short bf16x4 __attribute__((ext_vector_type(4)));
typedef float f32x4 __attribute__((ext_vector_type(4)));
typedef unsigned u32x4 __attribute__((ext_vector_type(4)));
typedef unsigned u32x2 __attribute__((ext_vector_type(2)));
#ifdef EMU
#define LAS
#define TID() emu_tid()
#define BID() emu_bid()
#define GRID() emu_grid()
#define WG_SYNC() emu_wg_sync()
#define MFMA16(a, b, c) emu_mfma16(a, b, c)
#define SHFL_XOR(v, m) emu_shfl_xor(v, m)
#define DEV static inline
#define DEVM inline
#define EXP2F(x) exp2f(x)
#define RSQRTF(x) (1.0f / sqrtf(x))
#define WAVE_FENCE() emu_wave_sync()
#define WAVE_ID(t) ((t) >> 6)
#define PIN(p, i) ((p).in[i])
#define P_WS() (g_emu_params.ws)
#define P_OUT() (g_emu_params.out)
#define FRESH_LANE() (emu_tid() & 63)
#define SPIN_WAIT() emu_yield()
#define ATOMIC_ADD_U64(ptr, v) (*(ptr) += (v))
#define RCPF(x) (1.0f / (x))
#define LOG2F_(x) log2f(x)
static inline float sum8(float v) { v += emu_shfl_xor(v, 1); v += emu_shfl_xor(v, 2); v += emu_shfl_xor(v, 4); return v; }
static inline float sum16(float v) { v = sum8(v); v += emu_shfl_xor(v, 8); return v; }
static inline float sum64(float v) { v = sum16(v); v += emu_shfl_xor(v, 16); v += emu_shfl_xor(v, 32); return v; }
#define LDS_DRAIN() do { } while (0)
#define COMPILER_FENCE() do { } while (0)
#else
#define LAS __attribute__((address_space(3)))
#define TID() ((int)threadIdx.x)
#define BID() ((int)blockIdx.x)
#define GRID() ((int)gridDim.x)
#define WG_SYNC() __syncthreads()
#define MFMA16(a, b, c) __builtin_amdgcn_mfma_f32_16x16x32_bf16(a, b, c, 0, 0, 0)
#define SHFL_XOR(v, m) __shfl_xor(v, m)
#define DEV __device__ __forceinline__
#define DEVM __device__ __forceinline__
#define EXP2F(x) __builtin_amdgcn_exp2f(x)
#define RSQRTF(x) (1.0f / sqrtf(x))
#define WAVE_FENCE() asm volatile("s_waitcnt lgkmcnt(0)" ::: "memory")
#define WAVE_ID(t) __builtin_amdgcn_readfirstlane((t) >> 6)
#define PIN(p, i) pin_load(i)
#define P_WS() ((unsigned char*)pin_load(34))
#define P_OUT() ((float*)pin_load(33))
#define FRESH_LANE() fresh_lane()
#define SPIN_WAIT() __builtin_amdgcn_s_sleep(1)
#define ATOMIC_ADD_U64(ptr, v) ((void)__hip_atomic_fetch_add((__attribute__((address_space(1))) unsigned long long*)(ptr), (v), __ATOMIC_RELAXED, __HIP_MEMORY_SCOPE_AGENT))
#define RCPF(x) __builtin_amdgcn_rcpf(x)
#define LOG2F_(x) __builtin_amdgcn_logf(x)
__device__ __forceinline__ float dpp_add(float v, const int ctrl_sel) {
    const int x = __builtin_bit_cast(int, v); int y;
    if (ctrl_sel == 0) y = __builtin_amdgcn_update_dpp(0, x, 0xB1, 0xF, 0xF, false); else if (ctrl_sel == 1) y = __builtin_amdgcn_update_dpp(0, x, 0x4E, 0xF, 0xF, false);
    else if (ctrl_sel == 2) y = __builtin_amdgcn_update_dpp(0, x, 0x141, 0xF, 0xF, false); else y = __builtin_amdgcn_update_dpp(0, x, 0x140, 0xF, 0xF, false);
    return v + __builtin_bit_cast(float, y);
}
__device__ __forceinline__ float sum8(float v) { v = dpp_add(v, 0); v = dpp_add(v, 1); v = dpp_add(v, 2); return v; }
__device__ __forceinline__ float sum16(float v) { v = sum8(v); v = dpp_add(v, 3); return v; }
__device__ __forceinline__ float sum64(float v) { v = sum16(v); v += __shfl_xor(v, 16); v += __shfl_xor(v, 32); return v; }
#define LDS_DRAIN() asm volatile("s_waitcnt lgkmcnt(0)" ::: "memory")
#define COMPILER_FENCE() asm volatile("" ::: "memory")
__device__ __forceinline__ int fresh_lane() { int l; asm volatile("v_mbcnt_lo_u32_b32 %0, -1, 0\n\tv_mbcnt_hi_u32_b32 %0, -1, %0" : "=v"(l)); return l; }
#endif
typedef LAS unsigned char* LDSP;
typedef unsigned long long ssq_t;
constexpr float SSQ_SCALE = 1048576.0f, SSQ_INV = 1.0f / 1048576.0f;
constexpr double TWO_PI = 6.283185307179586476925286766559;
#ifdef EMU
static const double ROPE_INV[32] = {1.0, 0.7498942093324559, 0.5623413251903491, 0.4216965034285822, 0.31622776601683794, 0.23713737056616552, 0.1778279410038923, 0.1333521432163324, 0.1, 0.07498942093324558, 0.05623413251903491, 0.042169650342858224, 0.03162277660168379, 0.023713737056616554, 0.01778279410038923, 0.01333521432163324, 0.01, 0.007498942093324558, 0.005623413251903491, 0.004216965034285823, 0.0031622776601683794, 0.0023713737056616554, 0.0017782794100389228, 0.001333521432163324, 0.001, 0.0007498942093324559, 0.0005623413251903491, 0.00042169650342858224, 0.00031622776601683794, 0.00023713737056616554, 0.00017782794100389227, 0.0001333521432163324};
#else
__device__ const double ROPE_INV[32] = {1.0, 0.7498942093324559, 0.5623413251903491, 0.4216965034285822, 0.31622776601683794, 0.23713737056616552, 0.1778279410038923, 0.1333521432163324, 0.1, 0.07498942093324558, 0.05623413251903491, 0.042169650342858224, 0.03162277660168379, 0.023713737056616554, 0.01778279410038923, 0.01333521432163324, 0.01, 0.007498942093324558, 0.005623413251903491, 0.004216965034285823, 0.0031622776601683794, 0.0023713737056616554, 0.0017782794100389228, 0.001333521432163324, 0.001, 0.0007498942093324559, 0.0005623413251903491, 0.00042169650342858224, 0.00031622776601683794, 0.00023713737056616554, 0.00017782794100389227, 0.0001333521432163324};
#endif

struct Params { const float* in[33]; float* out; unsigned char* ws; };
#ifdef EMU
static Params g_emu_params;
#endif
#ifndef EMU
__device__ __forceinline__ const float* pin_load(int i) {
    const __attribute__((address_space(4))) char* k = (const __attribute__((address_space(4))) char*)__builtin_amdgcn_kernarg_segment_ptr();
    asm volatile("" : "+s"(k));
    return *(const float* const __attribute__((address_space(4)))*)(k + 8 * i);
}
#endif
enum { I_XP = 0, I_XS, I_CK, I_CV, I_SWKV, I_SSH, I_NFF1, I_F1G, I_F1U, I_F1D, I_NMIX, I_WIN, I_MU, I_DW0, I_DW2, I_IA0, I_IA2, I_GG2, I_KK, I_KA, I_RK, I_GNG, I_GNB, I_QN, I_KN, I_SINK,
       I_WUA, I_WUB, I_WO, I_NFF2, I_F2G, I_F2U, I_F2D };

#ifdef EMU
DEV unsigned f2bf(float f) { unsigned u = __builtin_bit_cast(unsigned, f); return (u + 0x7fffu + ((u >> 16) & 1u)) >> 16; }
DEV unsigned pk2(float lo, float hi) { return f2bf(lo) | (f2bf(hi) << 16); }
#else
typedef float f32x2_t_ __attribute__((ext_vector_type(2))); typedef __bf16 bf16x2_t_ __attribute__((ext_vector_type(2)));
DEV unsigned pk2(float lo, float hi) { f32x2_t_ v = {lo, hi}; bf16x2_t_ b = __builtin_convertvector(v, bf16x2_t_); return __builtin_bit_cast(unsigned, b); }
DEV unsigned f2bf(float f) { return pk2(f, 0.f) & 0xffffu; }
#endif
DEV float bf2f(unsigned h) { return __builtin_bit_cast(float, h << 16); }
DEV bf16_t* lwp(const Params& p, int l, size_t off) { return (bf16_t*)(p.ws + WS_W + (size_t)l * LAYER_W_BYTES + off); }
DEV float wave_sum(float v) { return sum64(v); }
DEV float sigmoidf_(float x) { return RCPF(1.0f + EXP2F(-x * LOG2E)); }
DEV float tanhf_(float x) { return 1.0f - 2.0f * RCPF(1.0f + EXP2F(x * (2.0f * LOG2E))); }
DEV float expf_(float x) { return EXP2F(x * LOG2E); }
DEV float softplusf_(float z) { return fmaxf(z, 0.f) + LOG2F_(1.0f + EXP2F(-fabsf(z) * LOG2E)) * 0.6931471805599453f; }
DEV int swz(int row, int col) { return row * 128 + ((((col >> 3) ^ row) & 7) << 4) + ((col & 7) << 1); }
DEV int swz192(int row, int col) { const int ch = col >> 3; return row * 384 + (((ch & ~7) | ((ch ^ row) & 7)) << 4) + ((col & 7) << 1); }
DEV f32x4 mm64(LDSP A, int m0, LDSP B, int n0, f32x4 acc, int lane) {
    const int r = lane & 15, g4 = lane >> 4;
#pragma unroll
    for (int ks = 0; ks < 2; ++ks) {
        const bf16x8 a = *(const LAS bf16x8*)(A + swz(m0 + r, 32 * ks + 8 * g4));
        const bf16x8 b = *(const LAS bf16x8*)(B + swz(n0 + r, 32 * ks + 8 * g4));
        acc = MFMA16(a, b, acc);
    }
    return acc;
}
DEV void st_tile(LDSP O, int m0, int n0, f32x4 v, int lane) {
    const int r = lane & 15, g4 = lane >> 4;
#pragma unroll
    for (int reg = 0; reg < 4; ++reg) *(LAS bf16_t*)(O + swz(m0 + 4 * g4 + reg, n0 + r)) = (bf16_t)f2bf(v[reg]);
}
DEV void st_tile_T(LDSP O, int m0, int n0, f32x4 v, int lane) {
    const int r = lane & 15, g4 = lane >> 4;
    u32x2 w; w.x = pk2(v[0], v[1]); w.y = pk2(v[2], v[3]);
    *(LAS u32x2*)(O + swz(n0 + r, m0 + 4 * g4)) = w;
}
DEV bf16x8 pack8(f32x4 lo, f32x4 hi) {
    u32x4 w; w.x = pk2(lo[0], lo[1]); w.y = pk2(lo[2], lo[3]); w.z = pk2(hi[0], hi[1]); w.w = pk2(hi[2], hi[3]);
    return __builtin_bit_cast(bf16x8, w);
}

namespace pg8 {
#define PG8_LAS __attribute__((address_space(3)))
typedef unsigned short bf16_t;
typedef short bf16x8 __attribute__((ext_vector_type(8)));
typedef float f32x4 __attribute__((ext_vector_type(4)));
typedef unsigned u32x4 __attribute__((ext_vector_type(4)));
constexpr int BM = 256, BK = 64, HALF = 128, HTB = HALF * BK * 2  , STAGE_BYTES = 8 * HTB, NXCD = 8, WGM = 8;

__host__ __device__ __forceinline__ int lds_byte(int r, int c) { const int st = (r >> 4) * 2 + (c >> 5), rr = r & 15, cc = c & 31, ob = rr * 64 + cc * 2; return st * 1024 + (ob ^ (((ob >> 9) & 1) << 5)); }
__host__ __device__ __forceinline__ void stage_rc(int b, int& R, int& C) { const int st = b / 1024, sb = b % 1024, swz = sb ^ (((sb >> 9) & 1) << 5); R = (st >> 1) * 16 + swz / 64; C = (st & 1) * 32 + (swz % 64) / 2; }
__host__ __device__ __forceinline__ int perm32(int rho) { const int n = rho >> 4, i = rho & 15; return 8 * (i >> 2) + 4 * n + (i & 3); }

struct Unit { int pm, pn, idx; };
struct Gemm { const bf16_t* A; const bf16_t* Bt; int M, N, K; };

struct StaticOrder {
    int nM, nN, nwg, G, c;
    __host__ __device__ void init(int M, int N, int G_, int c_) { nM = M / BM; nN = N / BM; nwg = nM * nN; G = G_; c = c_; }
    __host__ __device__ bool next(int i, Unit& u) const {
        const long L = (long)i * G + c; if (L >= nwg) return false;
        int wgid = (int)L; { const int q = nwg / NXCD, r = nwg % NXCD, xcd = wgid % NXCD, off = wgid / NXCD; wgid = (xcd < r ? xcd * (q + 1) : r * (q + 1) + (xcd - r) * q) + off; }
        const int nig = WGM * nN, gid = wgid / nig, fm = gid * WGM, gsz = (nM - fm) < WGM ? (nM - fm) : WGM;
        u.pm = fm + ((wgid % nig) % gsz); u.pn = (wgid % nig) / gsz; u.idx = i; return true;
    }
    __device__ __forceinline__ void a_ready(const Unit&) const {}
    __device__ __forceinline__ void done(const Unit&) const {}
};

#ifndef EMU
template <class Epi, class Sched, bool ALIGN_EPI = false, bool SP2 = false>
__device__ __forceinline__ void gemm_phase(PG8_LAS unsigned char* lds, const Gemm g, const Sched& S, const Epi& E, const int wid) {
    const int lane = ::fresh_lane(), tid = wid * 64 + lane, wr = wid >> 2, wc = wid & 3, fr = lane & 15, fq = lane >> 4;
    const int K = g.K, nt = K / BK;
    unsigned voffA[2], voffB[2];
#pragma unroll
    for (int i = 0; i < 2; ++i) { int R, C; stage_rc(tid * 16 + i * 8192, R, C); const int Rb = Epi::PERM ? ((R & ~31) + perm32(R & 31)) : R;
        voffA[i] = (unsigned)(R * K + C) * 2u; voffB[i] = (unsigned)(Rb * K + C) * 2u; }
    const size_t kstep = (size_t)(BK * 2);
    const size_t hstep = (size_t)HALF * K * 2;
    const size_t tstep = 2 * hstep;
    const unsigned ldsw = (unsigned)wid * 1024u;
    const int aoff = lds_byte(wr * 64 + fr, fq * 8), boff = lds_byte(wc * 32 + fr, fq * 8);
#define PG8_SA(b, h) (((b) * 2 + (h)) * HTB)
#define PG8_SB(b, h) ((4 + (b) * 2 + (h)) * HTB)
#define PG8_STAGE(bufoff, gbase, voff) do { _Pragma("unroll") for (int _i = 0; _i < 2; ++_i) \
        __builtin_amdgcn_global_load_lds((const unsigned*)((const char*)(gbase) + (voff)[_i]), (PG8_LAS unsigned*)(lds + (bufoff) + ldsw + _i * 8192), 16, 0, 0); } while (0)
#define PG8_LDA(dst, b, h) do { _Pragma("unroll") for (int m = 0; m < 4; ++m) _Pragma("unroll") for (int k = 0; k < 2; ++k) dst[m][k] = *(const PG8_LAS bf16x8*)(lds + PG8_SA(b, h) + aoff + m * 2048 + k * 1024); } while (0)
#define PG8_LDB(dst, b, h) do { _Pragma("unroll") for (int n = 0; n < 2; ++n) _Pragma("unroll") for (int k = 0; k < 2; ++k) dst[n][k] = *(const PG8_LAS bf16x8*)(lds + PG8_SB(b, h) + boff + n * 2048 + k * 1024); } while (0)
#define PG8_MMA(ai, bj, At, Bt) do { __builtin_amdgcn_s_setprio(1); _Pragma("unroll") for (int m = 0; m < 4; ++m) _Pragma("unroll") for (int n = 0; n < 2; ++n) _Pragma("unroll") for (int k = 0; k < 2; ++k) \
        acc[ai][bj][m][n] = __builtin_amdgcn_mfma_f32_16x16x32_bf16(Bt[n][k], At[m][k], acc[ai][bj][m][n], 0, 0, 0); __builtin_amdgcn_s_setprio(0); } while (0)
#define PG8_WAIT_V(n) asm volatile("s_waitcnt vmcnt(" #n ")" ::: "memory")
#define PG8_WAIT_L(n) asm volatile("s_waitcnt lgkmcnt(" #n ")" ::: "memory")
#define PG8_BAR __builtin_amdgcn_s_barrier()
#define PG8_SCHED __builtin_amdgcn_sched_barrier(0)
    Unit cur, nxt; int ui = 0;
    if (!S.next(0, cur)) return;
    f32x4 acc[2][2][4][2];
#pragma unroll
    for (int a = 0; a < 2; ++a)
#pragma unroll
        for (int b = 0; b < 2; ++b)
#pragma unroll
            for (int m = 0; m < 4; ++m)
#pragma unroll
                for (int n = 0; n < 2; ++n) acc[a][b][m][n] = (f32x4){0.f, 0.f, 0.f, 0.f};
    bf16x8 At[4][2], B0[2][2], B1[2][2];
    const char* cA = (const char*)g.A + (size_t)cur.pm * tstep; const char* cB = (const char*)g.Bt + (size_t)cur.pn * tstep;
    S.a_ready(cur);
    if constexpr (SP2) {
        PG8_STAGE(PG8_SB(0, 0), cB, voffB); PG8_STAGE(PG8_SB(0, 1), cB + hstep, voffB); PG8_STAGE(PG8_SA(0, 0), cA, voffA); PG8_STAGE(PG8_SA(0, 1), cA + hstep, voffA);
        if (wr == 1) PG8_BAR;
        PG8_WAIT_V(2); PG8_BAR;
        PG8_STAGE(PG8_SB(1, 0), cB + kstep, voffB); PG8_STAGE(PG8_SA(1, 0), cA + kstep, voffA); PG8_STAGE(PG8_SB(1, 1), cB + hstep + kstep, voffB);
        PG8_WAIT_V(6); PG8_BAR;
    } else {
        PG8_STAGE(PG8_SB(0, 0), cB, voffB); PG8_STAGE(PG8_SA(0, 0), cA, voffA); PG8_STAGE(PG8_SB(0, 1), cB + hstep, voffB); PG8_STAGE(PG8_SA(0, 1), cA + hstep, voffA);
        if (wr == 1) PG8_BAR;
        PG8_WAIT_V(4); PG8_BAR;
        PG8_STAGE(PG8_SB(1, 0), cB + kstep, voffB); PG8_STAGE(PG8_SA(1, 0), cA + kstep, voffA); PG8_STAGE(PG8_SB(1, 1), cB + hstep + kstep, voffB);
        PG8_WAIT_V(6); PG8_BAR;
    }
    for (;;) {
        const bool has_next = S.next(ui + 1, nxt);
        const char* nA = has_next ? (const char*)g.A + (size_t)nxt.pm * tstep : cA; const char* nB = has_next ? (const char*)g.Bt + (size_t)nxt.pn * tstep : cB;
        for (int t = 0; t < nt; t += 2) {
            const bool last = (t == nt - 2);
            const char* a1 = cA + (size_t)(t + 1) * kstep;
            const char* a2 = last ? nA : cA + (size_t)(t + 2) * kstep; const char* b2 = last ? nB : cB + (size_t)(t + 2) * kstep;
            const char* a3 = a2 + kstep; const char* b3 = b2 + kstep;
            if (last && has_next) S.a_ready(nxt);
            if constexpr (SP2) {
            PG8_LDB(B0, 0, 0); PG8_LDB(B1, 0, 1); PG8_SCHED; PG8_LDA(At, 0, 0); PG8_STAGE(PG8_SA(1, 1), a1 + hstep, voffA);
            PG8_WAIT_V(8); PG8_WAIT_L(0); PG8_BAR; PG8_MMA(0, 0, At, B0); PG8_MMA(0, 1, At, B1); PG8_BAR; PG8_SCHED;
            PG8_LDA(At, 0, 1); PG8_STAGE(PG8_SB(0, 0), b2, voffB); PG8_STAGE(PG8_SB(0, 1), b2 + hstep, voffB); PG8_STAGE(PG8_SA(0, 0), a2, voffA);
            PG8_WAIT_V(8); PG8_WAIT_L(0); PG8_BAR; PG8_MMA(1, 0, At, B0); PG8_MMA(1, 1, At, B1); PG8_BAR; PG8_SCHED;
            PG8_LDB(B0, 1, 0); PG8_LDB(B1, 1, 1); PG8_SCHED; PG8_LDA(At, 1, 0); PG8_STAGE(PG8_SA(0, 1), a2 + hstep, voffA);
            PG8_WAIT_V(8); PG8_WAIT_L(0); PG8_BAR; PG8_MMA(0, 0, At, B0); PG8_MMA(0, 1, At, B1); PG8_BAR; PG8_SCHED;
            PG8_LDA(At, 1, 1); PG8_STAGE(PG8_SB(1, 0), b3, voffB); PG8_STAGE(PG8_SB(1, 1), b3 + hstep, voffB); PG8_STAGE(PG8_SA(1, 0), a3, voffA);
            PG8_WAIT_V(8); PG8_WAIT_L(0); PG8_BAR; PG8_MMA(1, 0, At, B0); PG8_MMA(1, 1, At, B1); PG8_BAR; PG8_SCHED;
            } else {
            PG8_LDB(B0, 0, 0); PG8_SCHED; PG8_LDA(At, 0, 0); PG8_STAGE(PG8_SA(1, 1), a1 + hstep, voffA);
            PG8_WAIT_L(8); PG8_BAR; PG8_WAIT_L(0); PG8_MMA(0, 0, At, B0); PG8_BAR; PG8_SCHED;
            PG8_LDB(B1, 0, 1); PG8_STAGE(PG8_SB(0, 0), b2, voffB);
            PG8_BAR; PG8_WAIT_L(0); PG8_MMA(0, 1, At, B1); PG8_BAR;
            PG8_LDA(At, 0, 1); PG8_STAGE(PG8_SA(0, 0), a2, voffA);
            PG8_BAR; PG8_WAIT_L(0); PG8_MMA(1, 0, At, B0); PG8_BAR; PG8_SCHED;
            PG8_STAGE(PG8_SB(0, 1), b2 + hstep, voffB);
            PG8_WAIT_V(6); PG8_BAR; PG8_MMA(1, 1, At, B1); PG8_BAR;
            PG8_LDB(B0, 1, 0); PG8_SCHED; PG8_LDA(At, 1, 0); PG8_STAGE(PG8_SA(0, 1), a2 + hstep, voffA);
            PG8_WAIT_L(8); PG8_BAR; PG8_WAIT_L(0); PG8_MMA(0, 0, At, B0); PG8_BAR; PG8_SCHED;
            PG8_LDB(B1, 1, 1); PG8_STAGE(PG8_SB(1, 0), b3, voffB);
            PG8_BAR; PG8_WAIT_L(0); PG8_MMA(0, 1, At, B1); PG8_BAR;
            PG8_LDA(At, 1, 1); PG8_STAGE(PG8_SA(1, 0), a3, voffA);
            PG8_BAR; PG8_WAIT_L(0); PG8_MMA(1, 0, At, B0); PG8_BAR; PG8_SCHED;
            PG8_STAGE(PG8_SB(1, 1), b3 + hstep, voffB);
            PG8_WAIT_V(6); PG8_BAR; PG8_MMA(1, 1, At, B1); PG8_BAR;
            }
        }
        if constexpr (ALIGN_EPI) { if (wr == 0) PG8_BAR; }
        if constexpr (!Epi::AFTER_DRAIN) { E(acc, cur, wr, wc, fr, fq); S.done(cur); }
        if (!has_next) break;
#pragma unroll
        for (int a = 0; a < 2; ++a)
#pragma unroll
            for (int b = 0; b < 2; ++b)
#pragma unroll
                for (int m = 0; m < 4; ++m)
#pragma unroll
                    for (int n = 0; n < 2; ++n) acc[a][b][m][n] = (f32x4){0.f, 0.f, 0.f, 0.f};
        cur = nxt; cA = nA; cB = nB; ++ui;
        if constexpr (ALIGN_EPI) { if (wr == 1) PG8_BAR; }
    }
    PG8_WAIT_V(0);
    if constexpr (!ALIGN_EPI) { if (wr == 0) PG8_BAR; }
    PG8_BAR;
    if constexpr (Epi::AFTER_DRAIN) { E.fused(acc, cur, wr, wc, fr, fq, lds, wid, lane); S.done(cur); }
#undef PG8_SA
#undef PG8_SB
#undef PG8_STAGE
#undef PG8_LDA
#undef PG8_LDB
#undef PG8_MMA
#undef PG8_WAIT_V
#undef PG8_WAIT_L
#undef PG8_BAR
#undef PG8_SCHED
}
}
#else
template <class Epi, class Sched, bool ALIGN_EPI = false, bool SP2 = false>
static void gemm_phase(LDSP lds, const Gemm g, const Sched& S, const Epi& E, const int wid_) {
    const int tid = TID(), wid = tid >> 6, lane = tid & 63, wr = wid >> 2, wc = wid & 3, fr = lane & 15, fq = lane >> 4;
    Unit u;
    for (int i = 0; S.next(i, u); ++i) {
        f32x4 acc[2][2][4][2];
        for (int ai = 0; ai < 2; ++ai) for (int bj = 0; bj < 2; ++bj) for (int m = 0; m < 4; ++m) for (int n = 0; n < 2; ++n) for (int e = 0; e < 4; ++e) {
            const int row = 256 * u.pm + 128 * ai + 64 * wr + 16 * m + fr;
            const int col = 256 * u.pn + 128 * bj + 32 * wc + (Epi::PERM ? 8 * fq + 4 * n + e : 16 * n + 4 * fq + e);
            const bf16_t* a = g.A + (size_t)row * g.K; const bf16_t* b = g.Bt + (size_t)col * g.K; float s = 0.f;
            for (int k = 0; k < g.K; ++k) s += ::bf2f(a[k]) * ::bf2f(b[k]);
            acc[ai][bj][m][n][e] = s; }
        E(acc, u, wr, wc, fr, fq);
    }
}
}
#endif

struct EpiSwiglu {
    static constexpr bool PERM = true, AFTER_DRAIN = false;
    LDSP rtab;
    DEVM void operator()(const f32x4 (&acc)[2][2][4][2], const pg8::Unit& u, int wr, int wc, int fr, int fq) const {
        const int row0 = u.pm * 256 + wr * 64 + fr, col0 = u.pn * 128 + wc * 32 + 8 * fq;
        unsigned char* ws_ = P_WS(); bf16_t* G = (bf16_t*)(ws_ + WS_G); const LAS float* rt = (const LAS float*)rtab + u.idx * 256 + wr * 64 + fr;
#pragma unroll
        for (int ai = 0; ai < 2; ++ai)
#pragma unroll
            for (int m = 0; m < 4; ++m) {
                bf16_t* rowp = G + (size_t)(row0 + ai * 128 + m * 16) * DFF + col0;
                const float rinv = rt[ai * 128 + m * 16];
                float o[8];
#pragma unroll
                for (int n = 0; n < 2; ++n)
#pragma unroll
                    for (int e = 0; e < 4; ++e) { const float g = acc[ai][0][m][n][e] * rinv, up = acc[ai][1][m][n][e] * rinv; o[4 * n + e] = g * up * RCPF(1.0f + EXP2F(-g * LOG2E)); }
                u32x4 w; w.x = pk2(o[0], o[1]); w.y = pk2(o[2], o[3]); w.z = pk2(o[4], o[5]); w.w = pk2(o[6], o[7]);
                *(u32x4*)rowp = w;
            }
    }
};
struct EpiResid {
    static constexpr bool PERM = true, AFTER_DRAIN = false;
    float scale; int nso;
    DEVM float apply4(size_t row, int col, f32x4 v) const { float* X = P_OUT(); bf16_t* XB = (bf16_t*)(P_WS() + WS_H); f32x4* q = (f32x4*)(X + row * DM + col); const f32x4 x = *q + v * scale; *q = x;
        u32x2 w; w.x = pk2(x[0], x[1]); w.y = pk2(x[2], x[3]); *(u32x2*)(XB + row * DM + col) = w; return (x[0] * x[0] + x[1] * x[1]) + (x[2] * x[2] + x[3] * x[3]); }
    DEVM void put_ss(size_t row, int slot, float ss) const { ((float*)(P_WS() + WS_SS))[((size_t)nso * NSLOT + slot) * M + row] = ss; }
    DEVM void operator()(const f32x4 (&acc)[2][2][4][2], const pg8::Unit& u, int wr, int wc, int fr, int fq) const {
        const int row0 = u.pm * 256 + wr * 64 + fr, col0 = u.pn * 256 + wc * 32 + 8 * fq;
        float* X = P_OUT(); unsigned char* ws_ = P_WS(); bf16_t* XB = (bf16_t*)(ws_ + WS_H); float* SSs = (float*)(ws_ + WS_SS) + ((size_t)nso * NSLOT + u.pn * 8 + wc) * M;
#pragma unroll
        for (int ai = 0; ai < 2; ++ai)
#pragma unroll
            for (int m = 0; m < 4; ++m) {
                const size_t row = (size_t)(row0 + ai * 128 + m * 16); float* rowp = X + row * DM + col0; bf16_t* rowb = XB + row * DM + col0;
#pragma unroll
                for (int bj = 0; bj < 2; ++bj) { float ss = 0.f;
#pragma unroll
                    for (int n = 0; n < 2; ++n) { f32x4* q = (f32x4*)(rowp + bj * 128 + n * 4); const f32x4 x = *q + acc[ai][bj][m][n] * scale; *q = x;
                        u32x2 w; w.x = pk2(x[0], x[1]); w.y = pk2(x[2], x[3]); *(u32x2*)(rowb + bj * 128 + n * 4) = w; ss += (x[0] * x[0] + x[1] * x[1]) + (x[2] * x[2] + x[3] * x[3]); }
                    ss += SHFL_XOR(ss, 16); ss += SHFL_XOR(ss, 32);
                    if (fq == 0) SSs[(size_t)bj * 4 * M + row] = ss; }
            }
    }
};
struct EpiWin {
    static constexpr bool PERM = true, AFTER_DRAIN = false;
    LDSP rtab;
    DEVM void operator()(const f32x4 (&acc)[2][2][4][2], const pg8::Unit& u, int wr, int wc, int fr, int fq) const {
        const int row0 = u.pm * 256 + wr * 64 + fr;
        unsigned char* ws_ = P_WS(); float* PF = (float*)(ws_ + WS_PF); bf16_t* SG = (bf16_t*)(ws_ + WS_SG); const LAS float* rt = (const LAS float*)rtab + u.idx * 256 + wr * 64 + fr;
        if (u.pn < FW / 256) {
            const int col0 = u.pn * 256 + wc * 32 + 8 * fq;
#pragma unroll
            for (int ai = 0; ai < 2; ++ai)
#pragma unroll
                for (int m = 0; m < 4; ++m) {
                    float* rowp = PF + (size_t)(row0 + ai * 128 + m * 16) * FW + col0; const float rinv = rt[ai * 128 + m * 16];
#pragma unroll
                    for (int bj = 0; bj < 2; ++bj)
#pragma unroll
                        for (int n = 0; n < 2; ++n) *(f32x4*)(rowp + bj * 128 + n * 4) = acc[ai][bj][m][n] * rinv;
                }
        } else {
            const int col0 = (u.pn - FW / 256) * 256 + wc * 32 + 8 * fq;
#pragma unroll
            for (int ai = 0; ai < 2; ++ai)
#pragma unroll
                for (int m = 0; m < 4; ++m) {
                    bf16_t* rowp = SG + (size_t)(row0 + ai * 128 + m * 16) * (2 * DM) + col0; const float rinv = rt[ai * 128 + m * 16];
#pragma unroll
                    for (int bj = 0; bj < 2; ++bj)
#pragma unroll
                        for (int n = 0; n < 2; ++n) { const f32x4 v = acc[ai][bj][m][n] * rinv; u32x2 w;
                            w.x = pk2(sigmoidf_(v[0]), sigmoidf_(v[1])); w.y = pk2(sigmoidf_(v[2]), sigmoidf_(v[3]));
                            *(u32x2*)(rowp + bj * 128 + n * 4) = w; }
                }
        }
    }
};
struct EpiUpA {
    static constexpr bool PERM = true, AFTER_DRAIN = false;
    int dummy;
    DEVM void put_ss(size_t, int, float) const {}
    DEVM float apply4(size_t row, int col, f32x4 v) const { unsigned char* ws_ = P_WS(); const bf16_t* SG = (const bf16_t*)(ws_ + WS_SG); float* T1 = (float*)(ws_ + WS_T1); const u32x2 s = *(const u32x2*)(SG + row * (2 * DM) + col);
        f32x4 o; o[0] = v[0] * bf2f(s.x & 0xffffu); o[1] = v[1] * bf2f(s.x >> 16); o[2] = v[2] * bf2f(s.y & 0xffffu); o[3] = v[3] * bf2f(s.y >> 16); *(f32x4*)(T1 + row * DM + col) = o; return 0.f; }
    DEVM void operator()(const f32x4 (&acc)[2][2][4][2], const pg8::Unit& u, int wr, int wc, int fr, int fq) const {
        const int row0 = u.pm * 256 + wr * 64 + fr, col0 = u.pn * 256 + wc * 32 + 8 * fq;
        unsigned char* ws_ = P_WS(); const bf16_t* SG = (const bf16_t*)(ws_ + WS_SG); float* T1 = (float*)(ws_ + WS_T1);
#pragma unroll
        for (int ai = 0; ai < 2; ++ai)
#pragma unroll
            for (int m = 0; m < 4; ++m) {
                const size_t row = (size_t)(row0 + ai * 128 + m * 16);
#pragma unroll
                for (int bj = 0; bj < 2; ++bj)
#pragma unroll
                    for (int n = 0; n < 2; ++n) { const int c = col0 + bj * 128 + n * 4; const u32x2 s = *(const u32x2*)(SG + row * (2 * DM) + c); const f32x4 v = acc[ai][bj][m][n];
                        f32x4 o; o[0] = v[0] * bf2f(s.x & 0xffffu); o[1] = v[1] * bf2f(s.x >> 16); o[2] = v[2] * bf2f(s.y & 0xffffu); o[3] = v[3] * bf2f(s.y >> 16);
                        *(f32x4*)(T1 + row * DM + c) = o; }
            }
    }
};
struct EpiUpB {
    static constexpr bool PERM = true, AFTER_DRAIN = false;
    int dummy;
    DEVM void put_ss(size_t, int, float) const {}
    DEVM float apply4(size_t row, int col, f32x4 v) const { unsigned char* ws_ = P_WS(); const bf16_t* SG = (const bf16_t*)(ws_ + WS_SG); const float* T1 = (const float*)(ws_ + WS_T1); bf16_t* MG = (bf16_t*)(ws_ + WS_MG); const u32x2 s = *(const u32x2*)(SG + row * (2 * DM) + DM + col); const f32x4 t = *(const f32x4*)(T1 + row * DM + col);
        u32x2 w; w.x = pk2(t[0] + v[0] * bf2f(s.x & 0xffffu), t[1] + v[1] * bf2f(s.x >> 16)); w.y = pk2(t[2] + v[2] * bf2f(s.y & 0xffffu), t[3] + v[3] * bf2f(s.y >> 16)); *(u32x2*)(MG + row * DM + col) = w; return 0.f; }
    DEVM void operator()(const f32x4 (&acc)[2][2][4][2], const pg8::Unit& u, int wr, int wc, int fr, int fq) const {
        const int row0 = u.pm * 256 + wr * 64 + fr, col0 = u.pn * 256 + wc * 32 + 8 * fq;
        unsigned char* ws_ = P_WS(); const bf16_t* SG = (const bf16_t*)(ws_ + WS_SG); const float* T1 = (const float*)(ws_ + WS_T1); bf16_t* MG = (bf16_t*)(ws_ + WS_MG);
#pragma unroll
        for (int ai = 0; ai < 2; ++ai)
#pragma unroll
            for (int m = 0; m < 4; ++m) {
                const size_t row = (size_t)(row0 + ai * 128 + m * 16);
#pragma unroll
                for (int bj = 0; bj < 2; ++bj)
#pragma unroll
                    for (int n = 0; n < 2; ++n) { const int c = col0 + bj * 128 + n * 4; const u32x2 s = *(const u32x2*)(SG + row * (2 * DM) + DM + c); const f32x4 v = acc[ai][bj][m][n];
                        const f32x4 t = *(const f32x4*)(T1 + row * DM + c);
                        u32x2 w; w.x = pk2(t[0] + v[0] * bf2f(s.x & 0xffffu), t[1] + v[1] * bf2f(s.x >> 16)); w.y = pk2(t[2] + v[2] * bf2f(s.y & 0xffffu), t[3] + v[3] * bf2f(s.y >> 16));
                        *(u32x2*)(MG + row * DM + c) = w; }
            }
    }
};


template <class Sched> DEV void rinv_table(const Sched& S, int nsi, LDSP lds, int tid) {
    const float* SS = (const float*)(P_WS() + WS_SS) + (size_t)nsi * NSLOT * M; LAS float* rt = (LAS float*)(lds + LDS_RINV_OFF);
    pg8::Unit u;
#pragma unroll 1
    for (int i = 0; S.next(i, u); ++i) if (tid < 256) { float s = 0.f;
#pragma unroll 8
        for (int k = 0; k < NSLOT; ++k) s += SS[(size_t)k * M + u.pm * 256 + tid];
        rt[i * 256 + tid] = RSQRTF(s * (1.0f / DM) + RMS_EPS); }
    WG_SYNC();
}

template <class Epi> DEV void sgemm_tile(const bf16_t* A, const bf16_t* Bt, int K, int m0, int n0, LDSP lds, int tid, const Epi& E) {
    const int lane = tid & 63, wave = WAVE_ID(tid), r = lane & 15, g4 = lane >> 4;
    f32x4 acc[4][4];
#pragma unroll
    for (int nt = 0; nt < 4; ++nt)
#pragma unroll
        for (int mt = 0; mt < 4; ++mt) acc[nt][mt] = (f32x4){0.f, 0.f, 0.f, 0.f};
    unsigned offA[4], offB[4];
#pragma unroll
    for (int t = 0; t < 4; ++t) { offA[t] = (unsigned)(((m0 + r + 16 * t) * K + 8 * g4) * 2); offB[t] = (unsigned)(((n0 + r + 16 * t) * K + 8 * g4) * 2); }
    const int nks = K >> 5;
    bf16x8 xa0[4], xb0[4], xa1[4], xb1[4], xa2[4], xb2[4];
#define SG_LOAD(A_, B_, ksv) do { const char* Ab_ = (const char*)A + 64 * (ksv); const char* Bb_ = (const char*)Bt + 64 * (ksv); _Pragma("unroll") for (int t = 0; t < 4; ++t) { \
        A_[t] = *(const bf16x8*)(Ab_ + offA[t]); B_[t] = *(const bf16x8*)(Bb_ + offB[t]); } } while (0)
#define SG_MMA(A_, B_) do { _Pragma("unroll") for (int nt = 0; nt < 4; ++nt) _Pragma("unroll") for (int mt = 0; mt < 4; ++mt) acc[nt][mt] = MFMA16(B_[nt], A_[mt], acc[nt][mt]); } while (0)
    const int npairs = nks >> 1, pq = npairs / NWAVES, prem = npairs % NWAVES, hcnt = 2 * (pq + (wave < prem ? 1 : 0)), hs = 2 * (wave * pq + (wave < prem ? wave : prem));
    int i = 0;
    if (hcnt > 0) SG_LOAD(xa0, xb0, hs);
    if (hcnt > 1) SG_LOAD(xa1, xb1, hs + 1);
#pragma unroll 1
    for (; i + 4 < hcnt; i += 3) {
        SG_LOAD(xa2, xb2, hs + i + 2); SG_MMA(xa0, xb0);
        SG_LOAD(xa0, xb0, hs + i + 3); SG_MMA(xa1, xb1);
        SG_LOAD(xa1, xb1, hs + i + 4); SG_MMA(xa2, xb2);
    }
    { const int R = hcnt - i;
      if (R >= 3) SG_LOAD(xa2, xb2, hs + i + 2);
      if (R >= 1) SG_MMA(xa0, xb0);
      if (R >= 4) SG_LOAD(xa0, xb0, hs + i + 3);
      if (R >= 2) SG_MMA(xa1, xb1);
      if (R >= 3) SG_MMA(xa2, xb2);
      if (R >= 4) SG_MMA(xa0, xb0); }
#undef SG_LOAD
#undef SG_MMA
#pragma unroll
    for (int nt = 0; nt < 4; ++nt)
#pragma unroll
        for (int mt = 0; mt < 4; ++mt) *(LAS f32x4*)(lds + wave * 16384 + ((nt * 4 + mt) * 64 + lane) * 16) = acc[nt][mt];
    WG_SYNC();
    {
        const int mt = wave & 3; float q = 0.f;
#pragma unroll
        for (int k = 0; k < 2; ++k) {
            const int nt = 2 * (wave >> 2) + k, s = (nt * 4 + mt) * 64 + lane;
            f32x4 v = *(const LAS f32x4*)(lds + s * 16);
#pragma unroll
            for (int w = 1; w < NWAVES; ++w) v = v + *(const LAS f32x4*)(lds + w * 16384 + s * 16);
            q += E.apply4((size_t)(m0 + 16 * mt + r), n0 + 16 * nt + 4 * g4, v);
        }
        q += SHFL_XOR(q, 16); q += SHFL_XOR(q, 32);
        if (g4 == 0) E.put_ss((size_t)(m0 + 16 * mt + r), (n0 >> 5) + (wave >> 2), q);
    }
    WG_SYNC();
}

DEV void conv_item(const float* W, int K, int N, bf16_t* WT, int mode, const float* gain, LAS float* scr, int item, int lane) {
    const int nblk = N / 32, kb = item / nblk, nb = item % nblk, k0 = 64 * kb, n0 = 32 * nb;
    int drow = n0;
    if (mode == 1) drow = (n0 >> 7) * 256 + (n0 & 127); else if (mode == 2) drow = (n0 >> 7) * 256 + 128 + (n0 & 127); else if (mode == 3) drow = n0 < FW_RAW ? n0 : FW + (n0 - FW_RAW);
#pragma unroll 8
    for (int i = 0; i < 32; ++i) { const int kk = 2 * i + (lane >> 5); scr[kk * 33 + (lane & 31)] = W[(size_t)(k0 + kk) * N + n0 + (lane & 31)]; }
    WAVE_FENCE();
    const int c = lane & 7;
    f32x4 g0 = (f32x4){1.f, 1.f, 1.f, 1.f}, g1 = g0;
    if (gain) { g0 = *(const f32x4*)(gain + k0 + 8 * c); g1 = *(const f32x4*)(gain + k0 + 8 * c + 4); }
#pragma unroll
    for (int j = 0; j < 4; ++j) { const int n = (lane >> 3) + 8 * j; const LAS float* s = scr + (8 * c) * 33 + n;
        u32x4 o; o.x = pk2(s[0 * 33] * g0[0], s[1 * 33] * g0[1]); o.y = pk2(s[2 * 33] * g0[2], s[3 * 33] * g0[3]); o.z = pk2(s[4 * 33] * g1[0], s[5 * 33] * g1[1]); o.w = pk2(s[6 * 33] * g1[2], s[7 * 33] * g1[3]);
        *(u32x4*)(WT + (size_t)(drow + n) * K + k0 + 8 * c) = o; }
    WAVE_FENCE();
}
constexpr int IT_G = (DM / 64) * (DFF / 32), IT_D = (DFF / 64) * (DM / 32), IT_IN = (DM / 64) * (INCOLS / 32), IT_UA = (AW / 64) * (DM / 32), IT_UB = (BQ / 64) * (DM / 32), IT_O = (DM / 64) * (DM / 32);
constexpr int IT_LAYER = 4 * IT_G + 2 * IT_D + IT_IN + IT_UA + IT_UB + IT_O;
DEV void prologue(const Params& p, LDSP lds, int gw, int NGW, int wave, int lane, int gtid, int NGT) {
    LAS float* scr = (LAS float*)(lds + wave * 8448);
    for (int it = gw; it < DEPTH * IT_LAYER; it += NGW) {
        const int l = it / IT_LAYER; int r = it % IT_LAYER;
        int src, K, N, mode, gsrc = -1; size_t doff, soff;
        if (r < IT_G) { src = I_F1G; gsrc = I_NFF1; K = DM; N = DFF; mode = 1; doff = OFF_WGU1; soff = (size_t)l * DM * DFF; }
        else if ((r -= IT_G) < IT_G) { src = I_F1U; gsrc = I_NFF1; K = DM; N = DFF; mode = 2; doff = OFF_WGU1; soff = (size_t)l * DM * DFF; }
        else if ((r -= IT_G) < IT_D) { src = I_F1D; K = DFF; N = DM; mode = 0; doff = OFF_WD1; soff = (size_t)l * DFF * DM; }
        else if ((r -= IT_D) < IT_IN) { src = I_WIN; gsrc = I_NMIX; K = DM; N = INCOLS; mode = 3; doff = OFF_WIN; soff = (size_t)l * DM * INCOLS; }
        else if ((r -= IT_IN) < IT_UA) { src = I_WUA; K = AW; N = DM; mode = 0; doff = OFF_WUA; soff = (size_t)l * AW * DM; }
        else if ((r -= IT_UA) < IT_UB) { src = I_WUB; K = BQ; N = DM; mode = 0; doff = OFF_WUB; soff = (size_t)l * BQ * DM; }
        else if ((r -= IT_UB) < IT_O) { src = I_WO; K = DM; N = DM; mode = 0; doff = OFF_WO; soff = (size_t)l * DM * DM; }
        else if ((r -= IT_O) < IT_G) { src = I_F2G; gsrc = I_NFF2; K = DM; N = DFF; mode = 1; doff = OFF_WGU2; soff = (size_t)l * DM * DFF; }
        else if ((r -= IT_G) < IT_G) { src = I_F2U; gsrc = I_NFF2; K = DM; N = DFF; mode = 2; doff = OFF_WGU2; soff = (size_t)l * DM * DFF; }
        else { r -= IT_G; src = I_F2D; K = DFF; N = DM; mode = 0; doff = OFF_WD2; soff = (size_t)l * DFF * DM; }
        conv_item(PIN(p, src) + soff, K, N, lwp(p, l, doff), mode, gsrc >= 0 ? PIN(p, gsrc) + (size_t)l * DM : nullptr, scr, r, lane);
    }
    for (int idx = gtid; idx < DEPTH * AW * 288; idx += NGT) {
        const int l = idx / (AW * 288), r = idx % (AW * 288), n = r / 288, k = r % 288;
        if (k < 64) lwp(p, l, OFF_DW2T)[n * 64 + k] = (bf16_t)f2bf(PIN(p, I_DW2)[((size_t)l * 64 + k) * AW + n]);
        else if (k < 128) lwp(p, l, OFF_IA2T)[n * 64 + (k - 64)] = (bf16_t)f2bf(PIN(p, I_IA2)[((size_t)l * 64 + (k - 64)) * AW + n]);
        else lwp(p, l, OFF_GG2T)[n * 160 + (k - 128)] = (bf16_t)f2bf(PIN(p, I_GG2)[((size_t)l * 160 + (k - 128)) * AW + n]);
    }
    float* rope = (float*)(p.ws + WS_ROPE);
    for (int idx = gtid; idx < (SEQ + DECS) * 32; idx += NGT) {
        const int slot = idx >> 5, i = idx & 31; const double pos = slot < SEQ ? (double)slot : (double)(PAST + slot - SEQ);
        const double ang = pos * ROPE_INV[i]; const double red = ang - TWO_PI * __builtin_rint(ang * (1.0 / TWO_PI));
        rope[2 * idx] = cosf((float)red); rope[2 * idx + 1] = sinf((float)red);
    }
}
DEV void x0_phase(const Params& p, int gw, int NGW, int lane, int gtid, int NGT) {
    float* X = p.out; bf16_t* XB = (bf16_t*)(p.ws + WS_H); float* SS = (float*)(p.ws + WS_SS);
    const float* xp = PIN(p, I_XP); const float* xs = PIN(p, I_XS);
    for (int m = gw; m < M; m += NGW) {
        const float* xr = m < SEQ ? xp + (size_t)m * DM : xs + (size_t)(m - SEQ) * DM;
        f32x4 v[DM / 256]; float ss = 0.f;
#pragma unroll
        for (int j = 0; j < DM / 256; ++j) { v[j] = *(const f32x4*)(xr + 4 * lane + 256 * j); ss += (v[j][0] * v[j][0] + v[j][1] * v[j][1]) + (v[j][2] * v[j][2] + v[j][3] * v[j][3]); }
#pragma unroll
        for (int j = 0; j < DM / 256; ++j) { *(f32x4*)(X + (size_t)m * DM + 4 * lane + 256 * j) = v[j]; u32x2 w; w.x = pk2(v[j][0], v[j][1]); w.y = pk2(v[j][2], v[j][3]); *(u32x2*)(XB + (size_t)m * DM + 4 * lane + 256 * j) = w; }
        ss = wave_sum(ss);
        if (lane < NSLOT) SS[(size_t)lane * M + m] = lane == 0 ? ss : 0.f;
    }
}

constexpr int R1_RA = 3 * 64 * 65 * 4, R1_RB = 65536 + 64 * 65 * 4;
static_assert(R1_RA + R1_RB + 2304 <= LDS_CTL_OFF && 6 * 8192 <= R1_RA, "R1 LDS map");
DEV void r1_unit(const Params& p, int l, int u, LDSP lds, int tid) {
    const int lane = tid & 63, wave = WAVE_ID(tid), r = lane & 15, g4 = lane >> 4;
    const bool samp = u >= NUP;
    int c = 0, b = 0, h, ntok; size_t row0;
    if (!samp) { c = u / AH; h = u % AH; row0 = (size_t)64 * c; ntok = 64; } else { const int s = u - NUP; b = s / AH; h = s % AH; row0 = (size_t)SEQ + 16 * b; ntok = DECS; }
    const float* PF = (const float*)(p.ws + WS_PF);
    const float* mu = PIN(p, I_MU) + (size_t)l * ACOLS;
    LDSP RA = lds, RB = lds + R1_RA;
    LAS float* DWf = (LAS float*)RA; LAS float* IAf = DWf + 64 * 65; LAS float* GGf = IAf + 64 * 65;
    LDSP LW = RB, LA = RB + 8192, LG = RB + 16384;
    LDSP B0 = RB, B1 = RB + 8192, B2 = RB + 16384, B3 = RB + 24576, B4 = RB + 32768, B5 = RB + 40960, B6 = RB + 49152, B7 = RB + 57344;
    LAS float* RtF = (LAS float*)(RB + 65536);
    LDSP A0 = RA, A1 = RA + 8192, A2 = RA + 16384, A3 = RA + 24576, A4 = RA + 32768, A5 = RA + 40960;
    LAS float* part = (LAS float*)(lds + R1_RA + R1_RB); LAS float* gam = part + 512;
    const int mt1 = wave & 3, nh = wave >> 2;
    bf16x8 bw[2][2], ba[2][2], bg[2][5];
#pragma unroll
    for (int n = 0; n < 2; ++n) { const size_t wrow = (size_t)(64 * h + 16 * (2 * nh + n) + r);
#pragma unroll
        for (int ks = 0; ks < 2; ++ks) { bw[n][ks] = *(const bf16x8*)(lwp(p, l, OFF_DW2T) + wrow * 64 + 32 * ks + 8 * g4); ba[n][ks] = *(const bf16x8*)(lwp(p, l, OFF_IA2T) + wrow * 64 + 32 * ks + 8 * g4); }
#pragma unroll
        for (int ks = 0; ks < 5; ++ks) bg[n][ks] = *(const bf16x8*)(lwp(p, l, OFF_GG2T) + wrow * 160 + 32 * ks + 8 * g4); }
    float cr8[8], ck8[8], cv8[8], pr0 = 0.f, pk0 = 0.f, pv0 = 0.f;
    { const int ch_ = 64 * h + lane, t0 = 8 * wave; const float* pp = nullptr;
      if (t0 > 0) { if (t0 - 1 < ntok) pp = PF + (row0 + t0 - 1) * FW; } else if (samp) pp = PIN(p, I_SSH) + ((size_t)l * DECB + b) * ACOLS; else if (c > 0) pp = PF + (row0 - 1) * FW;
      if (pp) { pr0 = pp[C_R + ch_]; pk0 = pp[C_K + ch_]; pv0 = pp[C_V + ch_]; }
#pragma unroll
      for (int tt = 0; tt < 8; ++tt) { cr8[tt] = 0.f; ck8[tt] = 0.f; cv8[tt] = 0.f;
          if (t0 + tt < ntok) { const float* cp = PF + (row0 + t0 + tt) * FW; cr8[tt] = cp[C_R + ch_]; ck8[tt] = cp[C_K + ch_]; cv8[tt] = cp[C_V + ch_]; } } }
    {
        const int t = tid >> 3, sub = tid & 7; const bool valid = t < ntok;
        const float* cur = PF + (row0 + t) * FW; const float* prv = cur - FW; float ps = 1.f;
        if (t == 0) { if (samp) prv = PIN(p, I_SSH) + ((size_t)l * DECB + b) * ACOLS; else if (c == 0) { prv = cur; ps = 0.f; } }
        u32x4 wv = (u32x4){0u, 0u, 0u, 0u}, av = wv;
        if (valid) {
            float x[8], y[8];
#pragma unroll
            for (int hh = 0; hh < 2; ++hh) { const int cw = C_WLO + 8 * sub + 4 * hh, ca = C_ALO + 8 * sub + 4 * hh;
                const f32x4 c1 = *(const f32x4*)(cur + cw), p1 = *(const f32x4*)(prv + cw), m1 = *(const f32x4*)(mu + cw), c2 = *(const f32x4*)(cur + ca), p2 = *(const f32x4*)(prv + ca), m2 = *(const f32x4*)(mu + ca);
#pragma unroll
                for (int e = 0; e < 4; ++e) { x[4 * hh + e] = tanhf_(c1[e] + (p1[e] * ps - c1[e]) * m1[e]); y[4 * hh + e] = c2[e] + (p2[e] * ps - c2[e]) * m2[e]; } }
            wv.x = pk2(x[0], x[1]); wv.y = pk2(x[2], x[3]); wv.z = pk2(x[4], x[5]); wv.w = pk2(x[6], x[7]);
            av.x = pk2(y[0], y[1]); av.y = pk2(y[2], y[3]); av.z = pk2(y[4], y[5]); av.w = pk2(y[6], y[7]);
        }
        *(LAS u32x4*)(LW + swz(t, 8 * sub)) = wv; *(LAS u32x4*)(LA + swz(t, 8 * sub)) = av;
#pragma unroll
        for (int q = 0; q < 5; ++q) { const int col = 20 * sub + 4 * q; u32x2 w = (u32x2){0u, 0u};
            if (valid) { const int cg = C_GLO + col; const f32x4 c1 = *(const f32x4*)(cur + cg), p1 = *(const f32x4*)(prv + cg), m1 = *(const f32x4*)(mu + cg); float z[4];
#pragma unroll
                for (int e = 0; e < 4; ++e) z[e] = sigmoidf_(c1[e] + (p1[e] * ps - c1[e]) * m1[e]);
                w.x = pk2(z[0], z[1]); w.y = pk2(z[2], z[3]); }
            *(LAS u32x2*)(LG + swz192(t, col)) = w; }
    }
    WG_SYNC();
    if (16 * mt1 < ntok) {
        f32x4 aw[2], aa[2], ag[2];
#pragma unroll
        for (int n = 0; n < 2; ++n) { aw[n] = (f32x4){0.f, 0.f, 0.f, 0.f}; aa[n] = aw[n]; ag[n] = aw[n]; }
#pragma unroll
        for (int ks = 0; ks < 2; ++ks) { const bf16x8 a1 = *(const LAS bf16x8*)(LW + swz(16 * mt1 + r, 32 * ks + 8 * g4)), a2 = *(const LAS bf16x8*)(LA + swz(16 * mt1 + r, 32 * ks + 8 * g4));
#pragma unroll
            for (int n = 0; n < 2; ++n) { aw[n] = MFMA16(a1, bw[n][ks], aw[n]); aa[n] = MFMA16(a2, ba[n][ks], aa[n]); } }
#pragma unroll
        for (int ks = 0; ks < 5; ++ks) { const bf16x8 a3 = *(const LAS bf16x8*)(LG + swz192(16 * mt1 + r, 32 * ks + 8 * g4));
#pragma unroll
            for (int n = 0; n < 2; ++n) ag[n] = MFMA16(a3, bg[n][ks], ag[n]); }
#pragma unroll
        for (int n = 0; n < 2; ++n)
#pragma unroll
            for (int reg = 0; reg < 4; ++reg) { const int o = (16 * mt1 + 4 * g4 + reg) * 65 + 16 * (2 * nh + n) + r; DWf[o] = aw[n][reg]; IAf[o] = aa[n][reg]; GGf[o] = ag[n][reg]; }
    }
    WG_SYNC();
    {
        const int j = lane, tq = wave, ch = 64 * h + j;
        const float w0 = PIN(p, I_DW0)[(size_t)l * AW + ch], a0 = PIN(p, I_IA0)[(size_t)l * AW + ch], kkw = PIN(p, I_KK)[(size_t)l * AW + ch], kaw = PIN(p, I_KA)[(size_t)l * AW + ch], rkw = PIN(p, I_RK)[(size_t)l * AW + ch];
        const float mur = mu[C_R + ch], muk = mu[C_K + ch], muv = mu[C_V + ch];
        float pr = pr0, pk = pk0, pv = pv0;
        float rr[8], kq[8], kp[8], av[8], vv[8], ld[8], Lc[8], bs[8]; float Lacc = 0.f;
#pragma unroll
        for (int tt = 0; tt < 8; ++tt) {
            const int t = 8 * tq + tt; const bool valid = t < ntok;
            const float cr = cr8[tt], ck = ck8[tt], cv = cv8[tt];
            float r_ = cr + (pr - cr) * mur, k_ = ck + (pk - ck) * muk, v_ = cv + (pv - cv) * muv; pr = cr; pk = ck; pv = cv;
            const float w = -softplusf_(-(w0 + DWf[t * 65 + j])) - 0.5f;
            float logd = -expf_(w);
            float a = sigmoidf_(a0 + IAf[t * 65 + j]);
            float kn = k_ * kkw; const float ss = wave_sum(kn * kn); kn = kn * RCPF(fmaxf(sqrtf(ss), 1e-12f));
            float kpp = k_ * (1.0f + (a - 1.0f) * kaw);
            float bsum = wave_sum(r_ * kpp * rkw);
            if (!valid) { logd = 0.f; kn = 0.f; kpp = 0.f; r_ = 0.f; v_ = 0.f; a = 0.f; bsum = 0.f; }
            Lacc += logd; ld[tt] = logd; Lc[tt] = Lacc; rr[tt] = r_; kq[tt] = kn; kp[tt] = kpp; av[tt] = a; vv[tt] = v_; bs[tt] = bsum;
        }
        part[tq * 64 + j] = Lacc;
        WG_SYNC();
        float off = 0.f;
#pragma unroll
        for (int q = 0; q < 8; ++q) if (q < tq) off += part[q * 64 + j];
        float fa[8], fb[8], fk[8], gt[8], bn[8];
#pragma unroll
        for (int tt = 0; tt < 8; ++tt) {
            const int t = 8 * tq + tt; const float L = Lc[tt] + off, Lm = L - ld[tt], eL = expf_(L), eLm = expf_(Lm), enL = expf_(-L);
            const float At = -kq[tt] * eLm, Bt = kq[tt] * av[tt] * enL, Kt = kp[tt] * enL, Rt = rr[tt] * eL;
            *(LAS bf16_t*)(B0 + swz(t, j)) = (bf16_t)f2bf(At); *(LAS bf16_t*)(B2 + swz(t, j)) = (bf16_t)f2bf(Bt); *(LAS bf16_t*)(B4 + swz(t, j)) = (bf16_t)f2bf(Kt); *(LAS bf16_t*)(B6 + swz(t, j)) = (bf16_t)f2bf(Rt);
            RtF[t * 65 + j] = Rt; fa[tt] = At; fb[tt] = Bt; fk[tt] = Kt; gt[tt] = GGf[t * 65 + j]; bn[tt] = bs[tt] * vv[tt];
            if (t == 63) gam[j] = eL;
        }
#define R1_PK8(a) ((u32x4){pk2(a[0], a[1]), pk2(a[2], a[3]), pk2(a[4], a[5]), pk2(a[6], a[7])})
        *(LAS u32x4*)(B1 + swz(j, 8 * tq)) = R1_PK8(fa); *(LAS u32x4*)(B3 + swz(j, 8 * tq)) = R1_PK8(fb); *(LAS u32x4*)(B5 + swz(j, 8 * tq)) = R1_PK8(fk); *(LAS u32x4*)(B7 + swz(j, 8 * tq)) = R1_PK8(vv);
        *(u32x4*)((bf16_t*)(p.ws + WS_GT) + (size_t)u * 4096 + j * 64 + 8 * tq) = R1_PK8(gt);
        *(u32x4*)((bf16_t*)(p.ws + WS_BNT) + (size_t)u * 4096 + j * 64 + 8 * tq) = R1_PK8(bn);
#undef R1_PK8
    }
    WG_SYNC();
    f32x4 accP[2];
    const f32x4 zero4 = (f32x4){0.f, 0.f, 0.f, 0.f};
#pragma unroll
    for (int q = 0; q < 2; ++q) {
        const int ti = 2 * wave + q, m0 = 16 * (ti >> 2), n0 = 16 * (ti & 3), s = n0 + r;
        f32x4 x = mm64(B0, m0, B2, n0, zero4, lane);
        f32x4 pI;
#pragma unroll
        for (int reg = 0; reg < 4; ++reg) { const int t = m0 + 4 * g4 + reg; if (!(t > s)) x[reg] = 0.f; pI[reg] = x[reg] + (t == s ? 1.f : 0.f); }
        st_tile(A0, m0, n0, x, lane); st_tile_T(A1, m0, n0, x, lane); st_tile(A2, m0, n0, pI, lane); accP[q] = pI;
        x = mm64(B0, m0, B4, n0, zero4, lane);
#pragma unroll
        for (int reg = 0; reg < 4; ++reg) { const int t = m0 + 4 * g4 + reg; if (!(t > s)) x[reg] = 0.f; }
        st_tile(A3, m0, n0, x, lane);
        x = mm64(B6, m0, B2, n0, zero4, lane);
#pragma unroll
        for (int reg = 0; reg < 4; ++reg) { const int t = m0 + 4 * g4 + reg; if (!(t >= s)) x[reg] = 0.f; }
        st_tile(A4, m0, n0, x, lane);
        x = mm64(B6, m0, B4, n0, zero4, lane);
#pragma unroll
        for (int reg = 0; reg < 4; ++reg) { const int t = m0 + 4 * g4 + reg; if (!(t >= s)) x[reg] = 0.f; }
        st_tile(A5, m0, n0, x, lane);
    }
    WG_SYNC();
#define R1_STAGE_A(Ys, YTs, Yd, YTd) do { _Pragma("unroll") for (int q = 0; q < 2; ++q) { const int ti = 2 * wave + q, m0 = 16 * (ti >> 2), n0 = 16 * (ti & 3); \
        const f32x4 x = mm64(Ys, m0, YTs, n0, zero4, lane); st_tile(Yd, m0, n0, x, lane); st_tile_T(YTd, m0, n0, x, lane); } } while (0)
#define R1_STAGE_B(Ps, YTn, Pd) do { _Pragma("unroll") for (int q = 0; q < 2; ++q) { const int ti = 2 * wave + q, m0 = 16 * (ti >> 2), n0 = 16 * (ti & 3); \
        accP[q] = mm64(Ps, m0, YTn, n0, accP[q], lane); st_tile(Pd, m0, n0, accP[q], lane); } } while (0)
    R1_STAGE_A(A0, A1, B0, B2);
    WG_SYNC();
#pragma unroll 1
    for (int it = 1; it <= 5; ++it) {
        const int nxt = it & 1;
        LDSP Ps = nxt ? A2 : B4, Pd = nxt ? B4 : A2, YTn = nxt ? B2 : A1;
        R1_STAGE_B(Ps, YTn, Pd);
        if (it < 5) { LDSP Ys = nxt ? B0 : A0, YTs = nxt ? B2 : A1, Yd = nxt ? A0 : B0, YTd = nxt ? A1 : B2; R1_STAGE_A(Ys, YTs, Yd, YTd); }
        WG_SYNC();
    }
#undef R1_STAGE_A
#undef R1_STAGE_B
#pragma unroll
    for (int q = 0; q < 2; ++q) {
        const int ti = 2 * wave + q, m0 = 16 * (ti >> 2), n0 = 16 * (ti & 3);
        st_tile(B6, m0, n0, mm64(B1, m0, B4, n0, zero4, lane), lane);
        st_tile(A0, m0, n0, mm64(B7, m0, A3, n0, zero4, lane), lane);
    }
    WG_SYNC();
#pragma unroll
    for (int q = 0; q < 2; ++q) {
        const int ti = 2 * wave + q, m0 = 16 * (ti >> 2), n0 = 16 * (ti & 3);
        st_tile(A1, m0, n0, mm64(A0, m0, B4, n0, zero4, lane), lane);
        f32x4 x = mm64(B6, m0, B3, n0, zero4, lane);
        { const int jp = n0 + r; const float gj = gam[jp]; u32x2 w;
          float y[4];
#pragma unroll
          for (int reg = 0; reg < 4; ++reg) y[reg] = (x[reg] + ((m0 + 4 * g4 + reg) == jp ? 1.f : 0.f)) * gj;
          w.x = pk2(y[0], y[1]); w.y = pk2(y[2], y[3]);
          *(u32x2*)((bf16_t*)(p.ws + WS_PCT) + (size_t)u * 4096 + jp * 64 + m0 + 4 * g4) = w; }
        x = mm64(A4, m0, B6, n0, zero4, lane);
        { bf16_t* Q = (bf16_t*)(p.ws + WS_QTT) + (size_t)u * 4096;
#pragma unroll
          for (int reg = 0; reg < 4; ++reg) { const int t = m0 + 4 * g4 + reg; Q[t * 64 + n0 + r] = (bf16_t)f2bf(x[reg] + RtF[t * 65 + n0 + r]); } }
    }
    WG_SYNC();
#pragma unroll
    for (int q = 0; q < 2; ++q) {
        const int ti = 2 * wave + q, m0 = 16 * (ti >> 2), n0 = 16 * (ti & 3);
        f32x4 x = mm64(B3, m0, A1, n0, zero4, lane); x = mm64(B5, m0, B7, n0, x, lane);
#pragma unroll
        for (int reg = 0; reg < 4; ++reg) x[reg] *= gam[m0 + 4 * g4 + reg];
        *(f32x4*)((float*)(p.ws + WS_UCS) + (size_t)u * 4096 + (n0 + r) * 64 + m0 + 4 * g4) = x;
        x = mm64(A4, m0, A1, n0, zero4, lane); x = mm64(A5, m0, B7, n0, x, lane);
        *(f32x4*)((float*)(p.ws + WS_YLT) + (size_t)u * 4096 + (ti * 64 + lane) * 4) = x;
    }
    WG_SYNC();
}

DEV void r2_chain(const Params& p, int l, int task, int lane) {
    const int h = task >> 2, q = task & 3, r = lane & 15, g4 = lane >> 4, i = 16 * q + r;
    const bf16_t* PCT = (const bf16_t*)(p.ws + WS_PCT); const float* UCS = (const float*)(p.ws + WS_UCS); bf16_t* SC = (bf16_t*)(p.ws + WS_SC);
    f32x4 S[4];
#pragma unroll
    for (int mt = 0; mt < 4; ++mt) S[mt] = (f32x4){0.f, 0.f, 0.f, 0.f};
    bf16x4 a0[4][2], a1[4][2]; f32x4 ci[4];
#define R2_LOAD(cc) do { const size_t u_ = (size_t)(cc) * AH + h; _Pragma("unroll") for (int mt = 0; mt < 4; ++mt) { ci[mt] = *(const f32x4*)(UCS + u_ * 4096 + i * 64 + 16 * mt + 4 * g4); \
        _Pragma("unroll") for (int ks = 0; ks < 2; ++ks) { a0[mt][ks] = *(const bf16x4*)(PCT + u_ * 4096 + (16 * mt + r) * 64 + 32 * ks + 4 * g4); a1[mt][ks] = *(const bf16x4*)(PCT + u_ * 4096 + (16 * mt + r) * 64 + 32 * ks + 16 + 4 * g4); } } } while (0)
    R2_LOAD(0);
#pragma unroll 1
    for (int c = 0; c < NCH; ++c) {
        const size_t u = (size_t)c * AH + h;
        bf16x8 pb[2];
#pragma unroll
        for (int ks = 0; ks < 2; ++ks) pb[ks] = pack8(S[2 * ks], S[2 * ks + 1]);
#pragma unroll
        for (int mt = 0; mt < 4; ++mt) { u32x2 w; w.x = pk2(S[mt][0], S[mt][1]); w.y = pk2(S[mt][2], S[mt][3]); *(u32x2*)(SC + u * 4096 + i * 64 + 16 * mt + 4 * g4) = w; }
        bf16x8 af[4][2]; f32x4 cc[4];
#pragma unroll
        for (int mt = 0; mt < 4; ++mt) { cc[mt] = ci[mt];
#pragma unroll
            for (int ks = 0; ks < 2; ++ks) af[mt][ks] = (bf16x8){a0[mt][ks][0], a0[mt][ks][1], a0[mt][ks][2], a0[mt][ks][3], a1[mt][ks][0], a1[mt][ks][1], a1[mt][ks][2], a1[mt][ks][3]}; }
        if (c + 1 < NCH) R2_LOAD(c + 1);
#pragma unroll
        for (int mt = 0; mt < 4; ++mt) { f32x4 x = MFMA16(af[mt][0], pb[0], cc[mt]); S[mt] = MFMA16(af[mt][1], pb[1], x); }
    }
#undef R2_LOAD
    float* o = p.out + O_PWKV + ((size_t)l * AH + h) * 4096;
#pragma unroll
    for (int mt = 0; mt < 4; ++mt) *(f32x4*)(o + i * 64 + 16 * mt + 4 * g4) = S[mt];
}

constexpr int R2_NSLOT = 12, R2_SLOTB = 12288, R2_FLAGS = R2_NSLOT * R2_SLOTB;
static_assert(R2_FLAGS + 128 <= LDS_CTL_OFF, "R2 ring");
DEV void r2_chain_ring(const Params& p, int l, int task, LDSP lds, int wave, int lane) {
    const int h = task >> 2, q = task & 3, r = lane & 15, g4 = lane >> 4, i = 16 * q + r;
    volatile LAS unsigned* full = (volatile LAS unsigned*)(lds + R2_FLAGS); volatile LAS unsigned* prog = full + 16;
    if (wave == 0 && lane < 32) full[lane] = 0u;
    WG_SYNC();
    if (wave > 0) {
        const unsigned char* PCT = p.ws + WS_PCT; const unsigned char* UCS = p.ws + WS_UCS;
#pragma unroll 1
        for (int c = wave - 1; c < NCH; c += NWAVES - 1) {
            const size_t u = (size_t)c * AH + h; const int slot = c % R2_NSLOT;
            u32x4 v[12];
#pragma unroll
            for (int k = 0; k < 8; ++k) v[k] = *(const u32x4*)(PCT + u * 8192 + k * 1024 + lane * 16);
#pragma unroll
            for (int k = 0; k < 4; ++k) v[8 + k] = *(const u32x4*)(UCS + u * 16384 + (size_t)q * 4096 + k * 1024 + lane * 16);
            while ((int)*prog + R2_NSLOT <= c) SPIN_WAIT();
            COMPILER_FENCE();
#pragma unroll
            for (int k = 0; k < 12; ++k) *(LAS u32x4*)(lds + slot * R2_SLOTB + k * 1024 + lane * 16) = v[k];
            LDS_DRAIN();
            if (lane == 0) full[slot] = (unsigned)c + 1u;
        }
        return;
    }
    bf16_t* SC = (bf16_t*)(p.ws + WS_SC);
    f32x4 S[4];
#pragma unroll
    for (int mt = 0; mt < 4; ++mt) S[mt] = (f32x4){0.f, 0.f, 0.f, 0.f};
#pragma unroll 1
    for (int c = 0; c < NCH; ++c) {
        const size_t u = (size_t)c * AH + h; const int slot = c % R2_NSLOT;
        bf16x8 pb[2];
#pragma unroll
        for (int ks = 0; ks < 2; ++ks) pb[ks] = pack8(S[2 * ks], S[2 * ks + 1]);
#pragma unroll
        for (int mt = 0; mt < 4; ++mt) { u32x2 w; w.x = pk2(S[mt][0], S[mt][1]); w.y = pk2(S[mt][2], S[mt][3]); *(u32x2*)(SC + u * 4096 + i * 64 + 16 * mt + 4 * g4) = w; }
        while (full[slot] != (unsigned)c + 1u) SPIN_WAIT();
        COMPILER_FENCE();
        LDSP sl = lds + slot * R2_SLOTB;
        bf16x8 af[4][2]; f32x4 cc[4];
#pragma unroll
        for (int mt = 0; mt < 4; ++mt) { cc[mt] = *(const LAS f32x4*)(sl + 8192 + (r * 64 + 16 * mt + 4 * g4) * 4);
#pragma unroll
            for (int ks = 0; ks < 2; ++ks) { const bf16x4 lo = *(const LAS bf16x4*)(sl + ((16 * mt + r) * 64 + 32 * ks + 4 * g4) * 2), hi = *(const LAS bf16x4*)(sl + ((16 * mt + r) * 64 + 32 * ks + 16 + 4 * g4) * 2);
                af[mt][ks] = (bf16x8){lo[0], lo[1], lo[2], lo[3], hi[0], hi[1], hi[2], hi[3]}; } }
        LDS_DRAIN();
        if (lane == 0) *prog = (unsigned)c + 1u;
#pragma unroll
        for (int mt = 0; mt < 4; ++mt) { f32x4 x = MFMA16(af[mt][0], pb[0], cc[mt]); S[mt] = MFMA16(af[mt][1], pb[1], x); }
    }
    float* o = p.out + O_PWKV + ((size_t)l * AH + h) * 4096;
#pragma unroll
    for (int mt = 0; mt < 4; ++mt) *(f32x4*)(o + i * 64 + 16 * mt + 4 * g4) = S[mt];
}
DEV void r2_sample(const Params& p, int l, int task, int lane) {
    const int q = task & 3, bh = task >> 2, r = lane & 15, g4 = lane >> 4, i = 16 * q + r;
    const size_t u = (size_t)NUP + bh;
    const bf16_t* PCT = (const bf16_t*)(p.ws + WS_PCT) + u * 4096; const float* UCS = (const float*)(p.ws + WS_UCS) + u * 4096;
    const float* S0 = PIN(p, I_SWKV) + ((size_t)l * DECB * AH + bh) * 4096;
    bf16x8 pb[2];
#pragma unroll
    for (int ks = 0; ks < 2; ++ks) { const f32x4 lo = *(const f32x4*)(S0 + i * 64 + 32 * ks + 8 * g4), hi = *(const f32x4*)(S0 + i * 64 + 32 * ks + 8 * g4 + 4); pb[ks] = pack8(lo, hi); }
    float* o = p.out + O_SWKV + ((size_t)l * DECB * AH + bh) * 4096;
#pragma unroll
    for (int mt = 0; mt < 4; ++mt) {
        f32x4 x = *(const f32x4*)(UCS + i * 64 + 16 * mt + 4 * g4);
#pragma unroll
        for (int ks = 0; ks < 2; ++ks) { const bf16x8 a = *(const bf16x8*)(PCT + (16 * mt + r) * 64 + 32 * ks + 8 * g4); x = MFMA16(a, pb[ks], x); }
        *(f32x4*)(o + i * 64 + 16 * mt + 4 * g4) = x;
    }
}

DEV void r3_work(const Params& p, int l, int u, int mt, int lane) {
    const bool samp = u >= NUP; int c = 0, b = 0, h;
    if (!samp) { c = u / AH; h = u % AH; } else { const int s = u - NUP; b = s / AH; h = s % AH; if (mt > 0) return; }
    const int r = lane & 15, g4 = lane >> 4;
    const bf16_t* Q = (const bf16_t*)(p.ws + WS_QTT) + (size_t)u * 4096;
    bf16x8 a[2];
#pragma unroll
    for (int ks = 0; ks < 2; ++ks) a[ks] = *(const bf16x8*)(Q + (16 * mt + r) * 64 + 32 * ks + 8 * g4);
    f32x4 acc[4];
#pragma unroll
    for (int nt = 0; nt < 4; ++nt) {
        acc[nt] = *(const f32x4*)((const float*)(p.ws + WS_YLT) + (size_t)u * 4096 + ((mt * 4 + nt) * 64 + lane) * 4);
#pragma unroll
        for (int ks = 0; ks < 2; ++ks) {
            bf16x8 bb;
            if (!samp) bb = *(const bf16x8*)((const bf16_t*)(p.ws + WS_SC) + (size_t)u * 4096 + (16 * nt + r) * 64 + 32 * ks + 8 * g4);
            else { const float* S0 = PIN(p, I_SWKV) + (((size_t)l * DECB + b) * AH + h) * 4096 + (16 * nt + r) * 64 + 32 * ks + 8 * g4; bb = pack8(*(const f32x4*)S0, *(const f32x4*)(S0 + 4)); }
            acc[nt] = MFMA16(a[ks], bb, acc[nt]);
        }
    }
    float mean[4], rs[4];
#pragma unroll
    for (int reg = 0; reg < 4; ++reg) {
        float s = (acc[0][reg] + acc[1][reg]) + (acc[2][reg] + acc[3][reg]);
        s = sum16(s);
        const float mn = s * (1.0f / 64.0f); float v = 0.f;
#pragma unroll
        for (int nt = 0; nt < 4; ++nt) { const float d = acc[nt][reg] - mn; v += d * d; }
        v = sum16(v);
        mean[reg] = mn; rs[reg] = RSQRTF(v * (1.0f / 64.0f) + GN_EPS);
    }
    bf16_t* YA = (bf16_t*)(p.ws + WS_YA);
#pragma unroll
    for (int nt = 0; nt < 4; ++nt) {
        const int i = 16 * nt + r; const float gain = PIN(p, I_GNG)[(size_t)l * AW + 64 * h + i], bias = PIN(p, I_GNB)[(size_t)l * AW + 64 * h + i];
        const u32x2 g2 = *(const u32x2*)((const bf16_t*)(p.ws + WS_GT) + (size_t)u * 4096 + i * 64 + 16 * mt + 4 * g4);
        const u32x2 b2 = *(const u32x2*)((const bf16_t*)(p.ws + WS_BNT) + (size_t)u * 4096 + i * 64 + 16 * mt + 4 * g4);
        const float gg[4] = {bf2f(g2.x & 0xffffu), bf2f(g2.x >> 16), bf2f(g2.y & 0xffffu), bf2f(g2.y >> 16)};
        const float bn[4] = {bf2f(b2.x & 0xffffu), bf2f(b2.x >> 16), bf2f(b2.y & 0xffffu), bf2f(b2.y >> 16)};
#pragma unroll
        for (int reg = 0; reg < 4; ++reg) {
            const int t = 16 * mt + 4 * g4 + reg; const size_t row = samp ? (size_t)SEQ + 16 * b + t : (size_t)64 * c + t;
            const float y = ((acc[nt][reg] - mean[reg]) * rs[reg] * gain + bias + bn[reg]) * gg[reg];
            YA[row * AW + 64 * h + i] = (bf16_t)f2bf(y);
        }
    }
}

constexpr int AT_KB = 0, AT_VT = 24576, AT_QB = 49152;
constexpr float QSCALE = 0.125f * LOG2E;
DEV void attn_unit(const Params& p, int l, int au, LDSP lds, int tid) {
    const int lane = tid & 63, wave = WAVE_ID(tid), r = lane & 15, g4 = lane >> 4;
    const bool samp = au >= NAP; int c = 0, b = 0, kh, nk, kbase = 0, nq;
    if (!samp) { c = au / BKV; kh = au % BKV; nk = 64 * (c + 1 < 3 ? c + 1 : 3); kbase = 64 * (c > 2 ? c - 2 : 0); nq = 64 * GRP; }
    else { const int s = au - NAP; b = s / BKV; kh = s % BKV; nk = WIN + DECS; nq = DECS * GRP; }
    const float* PF = (const float*)(p.ws + WS_PF); const float* rope = (const float*)(p.ws + WS_ROPE);
    LDSP Kb = lds + AT_KB, Vt = lds + AT_VT, Qb = lds + AT_QB;
    const int sub = tid & 7, rowi = tid >> 3;
    f32x4 K1[3], K2[3], V1[3], V2[3], KC0[3], KC1[3];
#pragma unroll
    for (int pp = 0; pp < 3; ++pp) {
        const int kidx = pp * 64 + rowi;
        if (kidx < nk) {
            if (samp && kidx < WIN) {
                const size_t o = ((((size_t)l * DECB + b) * WIN + kidx) * BKV + kh) * 64; const float* ck = PIN(p, I_CK) + o; const float* cv = PIN(p, I_CV) + o;
                K1[pp] = *(const f32x4*)(ck + 4 * sub); K2[pp] = *(const f32x4*)(ck + 32 + 4 * sub); V1[pp] = *(const f32x4*)(cv + 4 * sub); V2[pp] = *(const f32x4*)(cv + 32 + 4 * sub);
            } else {
                const size_t tok = samp ? (size_t)SEQ + 16 * b + (kidx - WIN) : (size_t)kbase + kidx; const int slot = samp ? SEQ + (kidx - WIN) : (int)tok;
                const float* src = PF + tok * FW;
                K1[pp] = *(const f32x4*)(src + C_BK + 64 * kh + 4 * sub); K2[pp] = *(const f32x4*)(src + C_BK + 64 * kh + 32 + 4 * sub);
                V1[pp] = *(const f32x4*)(src + C_BV + 64 * kh + 4 * sub); V2[pp] = *(const f32x4*)(src + C_BV + 64 * kh + 32 + 4 * sub);
                KC0[pp] = *(const f32x4*)(rope + (size_t)slot * 64 + 8 * sub); KC1[pp] = *(const f32x4*)(rope + (size_t)slot * 64 + 8 * sub + 4);
            }
        }
    }
    f32x4 Q1[GRP], Q2[GRP], QC0[GRP], QC1[GRP];
#pragma unroll
    for (int pp = 0; pp < GRP; ++pp) {
        const int q = pp * 64 + rowi;
        if (q < nq) {
            const int g = samp ? q >> 4 : q >> 6, t = samp ? q & 15 : q & 63, head = kh * GRP + g;
            const size_t tok = samp ? (size_t)SEQ + 16 * b + t : (size_t)64 * c + t; const int slot = samp ? SEQ + t : (int)tok;
            const float* src = PF + tok * FW + C_Q + 64 * head;
            Q1[pp] = *(const f32x4*)(src + 4 * sub); Q2[pp] = *(const f32x4*)(src + 32 + 4 * sub);
            QC0[pp] = *(const f32x4*)(rope + (size_t)slot * 64 + 8 * sub); QC1[pp] = *(const f32x4*)(rope + (size_t)slot * 64 + 8 * sub + 4);
        }
    }
    const f32x4 kg1 = *(const f32x4*)(PIN(p, I_KN) + (size_t)l * 64 + 4 * sub), kg2 = *(const f32x4*)(PIN(p, I_KN) + (size_t)l * 64 + 32 + 4 * sub);
    const f32x4 qg1 = *(const f32x4*)(PIN(p, I_QN) + (size_t)l * 64 + 4 * sub), qg2 = *(const f32x4*)(PIN(p, I_QN) + (size_t)l * 64 + 32 + 4 * sub);
#pragma unroll
    for (int pp = 0; pp < 3; ++pp) {
        const int kidx = pp * 64 + rowi;
        if (kidx < nk) {
            f32x4 k1 = K1[pp], k2 = K2[pp]; const f32x4 v1 = V1[pp], v2 = V2[pp];
            if (!(samp && kidx < WIN)) {
                const size_t tok = samp ? (size_t)SEQ + 16 * b + (kidx - WIN) : (size_t)kbase + kidx;
                const f32x4 x1 = k1, x2 = k2;
                float ss = (x1[0] * x1[0] + x1[1] * x1[1]) + (x1[2] * x1[2] + x1[3] * x1[3]) + (x2[0] * x2[0] + x2[1] * x2[1]) + (x2[2] * x2[2] + x2[3] * x2[3]);
                ss = sum8(ss);
                const float rinv = RSQRTF(ss * (1.0f / 64.0f) + RMS_EPS);
                const float cc[4] = {KC0[pp][0], KC0[pp][2], KC1[pp][0], KC1[pp][2]}, sn[4] = {KC0[pp][1], KC0[pp][3], KC1[pp][1], KC1[pp][3]};
#pragma unroll
                for (int e = 0; e < 4; ++e) { const float y1 = x1[e] * rinv * kg1[e], y2 = x2[e] * rinv * kg2[e]; k1[e] = y1 * cc[e] - y2 * sn[e]; k2[e] = y2 * cc[e] + y1 * sn[e]; }
                if (samp) { const size_t o = ((((size_t)l * DECB + b) * DECS + (kidx - WIN)) * BKV + kh) * 64;
                    *(f32x4*)(p.out + O_SK + o + 4 * sub) = k1; *(f32x4*)(p.out + O_SK + o + 32 + 4 * sub) = k2; *(f32x4*)(p.out + O_SV + o + 4 * sub) = v1; *(f32x4*)(p.out + O_SV + o + 32 + 4 * sub) = v2; }
                else if (kidx >= nk - 64 && tok >= (size_t)(SEQ - WIN)) { const size_t o = (((size_t)l * WIN + (tok - (SEQ - WIN))) * BKV + kh) * 64;
                    *(f32x4*)(p.out + O_PK + o + 4 * sub) = k1; *(f32x4*)(p.out + O_PK + o + 32 + 4 * sub) = k2; *(f32x4*)(p.out + O_PV + o + 4 * sub) = v1; *(f32x4*)(p.out + O_PV + o + 32 + 4 * sub) = v2; }
            }
            u32x2 w; w.x = pk2(k1[0], k1[1]); w.y = pk2(k1[2], k1[3]); *(LAS u32x2*)(Kb + swz(kidx, 4 * sub)) = w;
            w.x = pk2(k2[0], k2[1]); w.y = pk2(k2[2], k2[3]); *(LAS u32x2*)(Kb + swz(kidx, 32 + 4 * sub)) = w;
#pragma unroll
            for (int e = 0; e < 4; ++e) { *(LAS bf16_t*)(Vt + swz192(4 * sub + e, kidx)) = (bf16_t)f2bf(v1[e]); *(LAS bf16_t*)(Vt + swz192(32 + 4 * sub + e, kidx)) = (bf16_t)f2bf(v2[e]); }
        } else if (kidx < ((nk + 31) & ~31)) {
#pragma unroll
            for (int e = 0; e < 4; ++e) { *(LAS bf16_t*)(Vt + swz192(4 * sub + e, kidx)) = 0; *(LAS bf16_t*)(Vt + swz192(32 + 4 * sub + e, kidx)) = 0; }
        }
    }
#pragma unroll
    for (int pp = 0; pp < GRP; ++pp) {
        const int q = pp * 64 + rowi;
        if (q < nq) {
            const f32x4 x1 = Q1[pp], x2 = Q2[pp];
            float ss = (x1[0] * x1[0] + x1[1] * x1[1]) + (x1[2] * x1[2] + x1[3] * x1[3]) + (x2[0] * x2[0] + x2[1] * x2[1]) + (x2[2] * x2[2] + x2[3] * x2[3]);
            ss = sum8(ss);
            const float rinv = RSQRTF(ss * (1.0f / 64.0f) + RMS_EPS) * QSCALE;
            const float cc[4] = {QC0[pp][0], QC0[pp][2], QC1[pp][0], QC1[pp][2]}, sn[4] = {QC0[pp][1], QC0[pp][3], QC1[pp][1], QC1[pp][3]};
            float o1[4], o2[4];
#pragma unroll
            for (int e = 0; e < 4; ++e) { const float y1 = x1[e] * rinv * qg1[e], y2 = x2[e] * rinv * qg2[e]; o1[e] = y1 * cc[e] - y2 * sn[e]; o2[e] = y2 * cc[e] + y1 * sn[e]; }
            u32x2 w; w.x = pk2(o1[0], o1[1]); w.y = pk2(o1[2], o1[3]); *(LAS u32x2*)(Qb + swz(q, 4 * sub)) = w;
            w.x = pk2(o2[0], o2[1]); w.y = pk2(o2[2], o2[3]); *(LAS u32x2*)(Qb + swz(q, 32 + 4 * sub)) = w;
        }
    }
    WG_SYNC();
    const int nqt = nq >> 4, nkt = nk >> 4;
    bf16_t* YB = (bf16_t*)(p.ws + WS_YB);
#pragma unroll 1
    for (int qt = wave; qt < nqt; qt += NWAVES) {
        const int g = samp ? qt : qt >> 2, head = kh * GRP + g;
        const float sink2 = PIN(p, I_SINK)[(size_t)l * BH + head] * LOG2E;
        bf16x8 bq[2];
#pragma unroll
        for (int ks = 0; ks < 2; ++ks) bq[ks] = *(const LAS bf16x8*)(Qb + swz(16 * qt + r, 32 * ks + 8 * g4));
        f32x4 s[12];
#pragma unroll
        for (int kt = 0; kt < 12; ++kt) { s[kt] = (f32x4){0.f, 0.f, 0.f, 0.f};
            if (kt < nkt) {
#pragma unroll
                for (int ks = 0; ks < 2; ++ks) { const bf16x8 a = *(const LAS bf16x8*)(Kb + swz(16 * kt + r, 32 * ks + 8 * g4)); s[kt] = MFMA16(a, bq[ks], s[kt]); } } }
        float mx = sink2;
#pragma unroll
        for (int kt = 0; kt < 12; ++kt) if (kt < nkt) mx = fmaxf(fmaxf(mx, fmaxf(s[kt][0], s[kt][1])), fmaxf(s[kt][2], s[kt][3]));
        mx = fmaxf(mx, SHFL_XOR(mx, 16)); mx = fmaxf(mx, SHFL_XOR(mx, 32));
        float sum = 0.f;
#pragma unroll
        for (int kt = 0; kt < 12; ++kt) if (kt < nkt) {
#pragma unroll
            for (int e = 0; e < 4; ++e) { s[kt][e] = EXP2F(s[kt][e] - mx); sum += s[kt][e]; } }
        sum += SHFL_XOR(sum, 16); sum += SHFL_XOR(sum, 32);
        const float rden = 1.0f / (sum + EXP2F(sink2 - mx));
        f32x4 o[4];
#pragma unroll
        for (int dt = 0; dt < 4; ++dt) o[dt] = (f32x4){0.f, 0.f, 0.f, 0.f};
#pragma unroll
        for (int s2 = 0; s2 < 6; ++s2) if (2 * s2 < nkt) {
            const bf16x8 pb = pack8(s[2 * s2], s[2 * s2 + 1]);
#pragma unroll
            for (int dt = 0; dt < 4; ++dt) {
                const bf16x4 lo = *(const LAS bf16x4*)(Vt + swz192(16 * dt + r, 32 * s2 + 4 * g4)), hi = *(const LAS bf16x4*)(Vt + swz192(16 * dt + r, 32 * s2 + 16 + 4 * g4));
                o[dt] = MFMA16(((bf16x8){lo[0], lo[1], lo[2], lo[3], hi[0], hi[1], hi[2], hi[3]}), pb, o[dt]);
            }
        }
        const int q = 16 * qt + r, t = samp ? q & 15 : q & 63; const size_t tok = samp ? (size_t)SEQ + 16 * b + t : (size_t)64 * c + t;
#pragma unroll
        for (int dt = 0; dt < 4; ++dt) { u32x2 w; w.x = pk2(o[dt][0] * rden, o[dt][1] * rden); w.y = pk2(o[dt][2] * rden, o[dt][3] * rden); *(u32x2*)(YB + tok * BQ + 64 * head + 16 * dt + 4 * g4) = w; }
    }
    WG_SYNC();
}

#ifndef EMU
#define XB_TMO      128
#define XB_XCNT(j)  (256  + 64 * (j))
#define XB_XSUB(j)  (1280 + 64 * (j))
#define XB_XGEN(j)  (2304 + 64 * (j))
#define XB_TOP      3328
#define XB_TOPGEN   3392
#define XCD_BAR_WORDS 3456
#define XB_SPIN_CAP (1u << 18)

__device__ __forceinline__ unsigned xb_ld(unsigned* p)              { return __hip_atomic_load(p, __ATOMIC_RELAXED, __HIP_MEMORY_SCOPE_AGENT); }
__device__ __forceinline__ unsigned xb_add(unsigned* p, unsigned v) { return __hip_atomic_fetch_add(p, v, __ATOMIC_RELAXED, __HIP_MEMORY_SCOPE_AGENT); }
__device__ __forceinline__ unsigned xb_xcc_id() { return (unsigned)__builtin_amdgcn_s_getreg((3 << 11) | 20) & 0xFu; }
#define XB_SPIN(cond, bar) do { unsigned _sp = 0; while (cond) { __builtin_amdgcn_s_sleep(1); \
    if ((++_sp & 255u) == 0u) { if (xb_ld(&(bar)[XB_TMO])) break; if (_sp > XB_SPIN_CAP) { atomicAdd(&(bar)[XB_TMO], 1u); break; } } } } while (0)

struct XcdBarrier {
    unsigned* bar; unsigned x;
    volatile LAS unsigned* st;
};

__device__ __forceinline__ XcdBarrier xcd_barrier_post(unsigned* bar, volatile LAS unsigned* st) {
    XcdBarrier b; b.bar = bar; b.x = xb_xcc_id(); b.st = st;
    if (threadIdx.x == 0) (void)xb_add(&bar[XB_XCNT(b.x)], 1u);
    return b;
}
__device__ __forceinline__ void xcd_barrier_complete(unsigned* bar, unsigned x, unsigned& nloc, unsigned& nx) {
    const unsigned G = gridDim.x * gridDim.y * gridDim.z;
    unsigned sum, cnt, mine, sp = 0u;
    for (;;) {
        sum = 0u; cnt = 0u; mine = 0u;
#pragma unroll
        for (unsigned j = 0; j < 16; ++j) { const unsigned c = xb_ld(&bar[XB_XCNT(j)]); sum += c; cnt += (c > 0u) ? 1u : 0u; mine = (j == x) ? c : mine; }
        if (sum == G) break;
        __builtin_amdgcn_s_sleep(1);
        if ((++sp & 255u) == 0u) { if (xb_ld(&bar[XB_TMO])) break; if (sp > XB_SPIN_CAP) { atomicAdd(&bar[XB_TMO], 1u); break; } }
    }
    nloc = mine > 0u ? mine : 1u; nx = cnt > 0u ? cnt : 1u;
}

__device__ __forceinline__ void xcd_barrier(const XcdBarrier& b) {
    asm volatile("s_waitcnt vmcnt(0)" ::: "memory");
    __syncthreads();
    if (threadIdx.x == 0) {
        unsigned* bar = b.bar;
        __builtin_amdgcn_s_waitcnt(0);
        unsigned nloc = b.st[0], nx = b.st[1];
        if (nloc == 0u) { xcd_barrier_complete(bar, b.x, nloc, nx); b.st[0] = nloc; b.st[1] = nx; }
        const unsigned old = xb_add(&bar[XB_XSUB(b.x)], 1u);
        const unsigned gen = old / nloc;
        if (old + 1u == (gen + 1u) * nloc) {
            __builtin_amdgcn_fence(__ATOMIC_RELEASE, "agent");
            asm volatile("s_waitcnt vmcnt(0)" ::: "memory");
            const unsigned og = xb_add(&bar[XB_TOP], 1u);
            const unsigned tg = og / nx;
            if (og + 1u == (tg + 1u) * nx) xb_add(&bar[XB_TOPGEN], 1u);
            else XB_SPIN(xb_ld(&bar[XB_TOPGEN]) == tg, bar);
            __builtin_amdgcn_fence(__ATOMIC_ACQUIRE, "agent");
            xb_add(&bar[XB_XGEN(b.x)], 1u);
            asm volatile("s_waitcnt vmcnt(0)" ::: "memory");
        } else {
            XB_SPIN(xb_ld(&bar[XB_XGEN(b.x)]) == gen, bar);
            __builtin_amdgcn_fence(__ATOMIC_ACQUIRE, "agent");
            asm volatile("s_waitcnt vmcnt(0)" ::: "memory");
        }
    }
    __syncthreads();
}
#endif

#ifndef REP_GU
#define REP_GU 1
#endif
#ifndef REP_DOWN
#define REP_DOWN 1
#endif
#ifndef REP_WIN
#define REP_WIN 1
#endif
#ifndef REP_UP
#define REP_UP 1
#endif
#ifndef REP_WO
#define REP_WO 1
#endif
#ifndef REP_PRO
#define REP_PRO 1
#endif
#ifndef REP_NORM
#define REP_NORM 1
#endif
#ifndef REP_R1
#define REP_R1 1
#endif
#ifndef REP_R2
#define REP_R2 1
#endif
#ifndef REP_R3
#define REP_R3 1
#endif

#ifndef EMU
#define GRID_BAR() xcd_barrier(bar)
constexpr int CW_BAR = 4096;
__global__ void __launch_bounds__(NTHR, 2) fwd(Params p) {
    extern __shared__ __attribute__((aligned(16))) unsigned char lds_raw[];
    LDSP lds = (LDSP)lds_raw;
    const int wave = __builtin_amdgcn_readfirstlane(TID() >> 6), G = GRID(), bid = BID();
    for (int u = TID(); u < (LDS_BYTES - LDS_CTL_OFF) / 4; u += NTHR) ((LAS unsigned*)(lds + LDS_CTL_OFF))[u] = 0u;
    __syncthreads();
    XcdBarrier bar = xcd_barrier_post((unsigned*)(p.ws + WS_CTL) + CW_BAR, (volatile LAS unsigned*)(lds + LDS_CTL_OFF + 32));
#else
#define GRID_BAR() emu_grid_sync()
static void fwd(Params p) {
    g_emu_params = p;
    LDSP lds = emu_lds();
    const int wave = TID() >> 6, G = GRID(), bid = BID();
#endif
    const int gw = bid * NWAVES + wave, NGW = G * NWAVES, NGT = G * NTHR;
#define LANE_TID() const int lane = FRESH_LANE(), tid = wave * 64 + lane; (void)tid
    bf16_t* XB = (bf16_t*)(p.ws + WS_H);


#ifndef SKIP_PRO
    for (int rep_ = 0; rep_ < REP_PRO; ++rep_) { LANE_TID(); prologue(p, lds, gw, NGW, wave, lane, bid * NTHR + tid, NGT); x0_phase(p, gw, NGW, lane, bid * NTHR + tid, NGT); if (rep_ + 1 < REP_PRO) GRID_BAR(); }
    GRID_BAR();
#endif

#pragma unroll 1
    for (int it = 0; it < 2 * DEPTH; ++it) {
        const int l = it >> 1; const bool sec = (it & 1) != 0;
        const int nsi = 3 * l + (sec ? 2 : 0);

for (int rep_ = 0; rep_ < REP_GU; ++rep_) {
#ifndef SKIP_GU
        { pg8::Gemm g{XB, lwp(p, l, sec ? OFF_WGU2 : OFF_WGU1), M, 2 * DFF, DM}; pg8::StaticOrder S; S.init(M, 2 * DFF, G, bid);
          { LANE_TID(); rinv_table(S, nsi, lds, tid); }
          EpiSwiglu E{lds + LDS_RINV_OFF};
          pg8::gemm_phase<EpiSwiglu, pg8::StaticOrder, true, true>(lds, g, S, E, wave); }
#endif

        GRID_BAR(); }

for (int rep_ = 0; rep_ < REP_DOWN; ++rep_) {
#ifndef SKIP_DOWN
        { pg8::Gemm g{(const bf16_t*)(p.ws + WS_G), lwp(p, l, sec ? OFF_WD2 : OFF_WD1), SEQ, DM, DFF}; pg8::StaticOrder S; S.init(SEQ, DM, G, bid);
          EpiResid E{0.5f / REP_DOWN, nsi + 1};
          pg8::gemm_phase<EpiResid, pg8::StaticOrder, true, true>(lds, g, S, E, wave);
#pragma unroll 1
          for (int tile = bid; tile < (MS / 64) * (DM / 64); tile += G) { LANE_TID(); sgemm_tile(g.A, g.Bt, DFF, SEQ + 64 * (tile % (MS / 64)), 64 * (tile / (MS / 64)), lds, tid, E); } }
#endif
        if (rep_ + 1 < REP_DOWN) GRID_BAR(); }

        if (it == 2 * DEPTH - 1) break;
        GRID_BAR();
        if (!sec) {


for (int rep_ = 0; rep_ < REP_WIN; ++rep_) {
#ifndef SKIP_WIN
            { pg8::Gemm g{XB, lwp(p, l, OFF_WIN), M, NIN, DM}; pg8::StaticOrder S; S.init(M, NIN, G, bid);
              { LANE_TID(); rinv_table(S, 3 * l + 1, lds, tid); }
              EpiWin E{lds + LDS_RINV_OFF};
              pg8::gemm_phase<EpiWin, pg8::StaticOrder, true, true>(lds, g, S, E, wave); }
#endif

            GRID_BAR(); }

            for (int rep_ = 0; rep_ < REP_R1; ++rep_) {
#ifndef SKIP_R1
#pragma unroll 1
            for (int u = bid; u < NU; u += G) { LANE_TID(); r1_unit(p, l, u, lds, tid); }
#pragma unroll 1
            for (int au = bid; au < NA; au += G) { LANE_TID(); attn_unit(p, l, au, lds, tid); }
#endif

            GRID_BAR(); }

            for (int rep_ = 0; rep_ < REP_R2; ++rep_) {
#ifndef SKIP_R2
            { constexpr int nchain = 4 * AH; LANE_TID();
              if (G > nchain) {
                  if (bid < nchain) r2_chain_ring(p, l, bid, lds, wave, lane);
                  else { const int ob = bid - nchain, OG = G - nchain;
#pragma unroll 1
                      for (int task = ob * NWAVES + wave; task < 4 * NUS; task += OG * NWAVES) r2_sample(p, l, task, lane); }
              } else {
#pragma unroll 1
                  for (int task = bid; task < nchain; task += G) r2_chain_ring(p, l, task, lds, wave, lane);
#pragma unroll 1
                  for (int task = gw; task < 4 * NUS; task += NGW) r2_sample(p, l, task, lane);
              } }
#endif

            GRID_BAR(); }

            for (int rep_ = 0; rep_ < REP_R3; ++rep_) {
#ifndef SKIP_R3
            { const int worker = bid * 2 + (wave >> 2), NW = 2 * G; LANE_TID(); const int gtid = bid * NTHR + tid;
#pragma unroll 1
              for (int u = worker; u < NU; u += NW) r3_work(p, l, u, wave & 3, lane);
              const float* PF = (const float*)(p.ws + WS_PF);
              for (int idx = gtid; idx < (1 + DECB) * ACOLS; idx += NGT) { const int s = idx / ACOLS, col = idx % ACOLS;
                  if (s == 0) p.out[O_PSH + (size_t)l * ACOLS + col] = PF[(size_t)(SEQ - 1) * FW + col];
                  else p.out[O_SSH + ((size_t)l * DECB + (s - 1)) * ACOLS + col] = PF[((size_t)SEQ + 16 * (s - 1) + 15) * FW + col]; } }
#endif

            GRID_BAR(); }

for (int rep_ = 0; rep_ < REP_UP; ++rep_) {
#ifndef SKIP_UPA
            { pg8::Gemm g{(const bf16_t*)(p.ws + WS_YA), lwp(p, l, OFF_WUA), SEQ, DM, AW}; pg8::StaticOrder S; S.init(SEQ, DM, G, bid);
              EpiUpA E{0};
              pg8::gemm_phase<EpiUpA, pg8::StaticOrder, true, true>(lds, g, S, E, wave);
#pragma unroll 1
          for (int tile = bid; tile < (MS / 64) * (DM / 64); tile += G) { LANE_TID(); sgemm_tile(g.A, g.Bt, AW, SEQ + 64 * (tile % (MS / 64)), 64 * (tile / (MS / 64)), lds, tid, E); } }
#endif


#ifndef SKIP_UPB
            { pg8::Gemm g{(const bf16_t*)(p.ws + WS_YB), lwp(p, l, OFF_WUB), SEQ, DM, BQ}; pg8::StaticOrder S; S.init(SEQ, DM, G, bid);
              EpiUpB E{0};
              pg8::gemm_phase<EpiUpB, pg8::StaticOrder, true, true>(lds, g, S, E, wave);
#pragma unroll 1
          for (int tile = bid; tile < (MS / 64) * (DM / 64); tile += G) { LANE_TID(); sgemm_tile(g.A, g.Bt, BQ, SEQ + 64 * (tile % (MS / 64)), 64 * (tile / (MS / 64)), lds, tid, E); } }
#endif

            GRID_BAR(); }
for (int rep_ = 0; rep_ < REP_WO; ++rep_) {
#ifndef SKIP_WO
            { pg8::Gemm g{(const bf16_t*)(p.ws + WS_MG), lwp(p, l, OFF_WO), SEQ, DM, DM}; pg8::StaticOrder S; S.init(SEQ, DM, G, bid);
              EpiResid E{1.0f / REP_WO, 3 * l + 2};
              pg8::gemm_phase<EpiResid, pg8::StaticOrder, true, true>(lds, g, S, E, wave);
#pragma unroll 1
          for (int tile = bid; tile < (MS / 64) * (DM / 64); tile += G) { LANE_TID(); sgemm_tile(g.A, g.Bt, DM, SEQ + 64 * (tile % (MS / 64)), 64 * (tile / (MS / 64)), lds, tid, E); } }
#endif

            GRID_BAR(); }
        }
    }
}

#ifndef EMU
extern "C" void kernel_launch(void* const* d_in, const int* in_sizes, int n_in, void* d_out, int out_size, void* d_ws, size_t ws_size, hipStream_t stream) {
    static int grid = 0;
    if (grid == 0) {
        if (n_in != 33 || (size_t)out_size != O_END || ws_size < WS_END) { fprintf(stderr, "kernel_launch: unexpected shapes (n_in %d, out %d, ws %zu, need %zu)\n", n_in, out_size, ws_size, (size_t)WS_END); grid = -1; return; }
        int dev = 0, cus = 0, per_cu = 0;
        if (hipGetDevice(&dev) != hipSuccess || hipDeviceGetAttribute(&cus, hipDeviceAttributeMultiprocessorCount, dev) != hipSuccess) { grid = -1; return; }
        if (hipFuncSetAttribute((const void*)fwd, hipFuncAttributeMaxDynamicSharedMemorySize, LDS_BYTES) != hipSuccess) { fprintf(stderr, "kernel_launch: hipFuncSetAttribute failed\n"); grid = -1; return; }
        if (hipOccupancyMaxActiveBlocksPerMultiprocessor(&per_cu, (const void*)fwd, NTHR, LDS_BYTES) != hipSuccess || per_cu < 1) fprintf(stderr, "kernel_launch: occupancy query reports %d\n", per_cu);
        (void)hipGetLastError();
        grid = cus;
    }
    if (grid < 0) return;
    if (hipMemsetAsync((char*)d_ws + WS_CTL, 0, CTL_BYTES, stream) != hipSuccess) return;
    Params p{};
    for (int i = 0; i < 33; ++i) p.in[i] = (const float*)d_in[i];
    p.out = (float*)d_out; p.ws = (unsigned char*)d_ws;
    hipLaunchKernelGGL(fwd, dim3(grid), dim3(NTHR), LDS_BYTES, stream, p);
}
#endif
```

```cpp
#ifndef EMU
#include <hip/hip_runtime.h>
#include <cstdio>
#include <cstdint>
#endif

#ifndef CFG_SMALL
constexpr int DM = 2048, SEQ = 8192, DEPTH = 4, DECB = 32, DECS = 16, PAST = 1024, AW = 1024, BH = 16, BKV = 4, DFF = 5504;
#else
constexpr int DM = 256, SEQ = 256, DEPTH = 2, DECB = 16, DECS = 16, PAST = 1024, AW = 128, BH = 4, BKV = 1, DFF = 384;
#endif
constexpr int HD = 64, AH = AW / HD, DLORA = 64, ILORA = 64, GLORA = 160, WIN = 128, GRP = BH / BKV;
constexpr int ACOLS = 3 * AW + DLORA + ILORA + GLORA, BQ = BH * HD, BKVW = BKV * HD, INCOLS = ACOLS + BQ + 2 * BKVW + 2 * DM;
constexpr int MS = DECB * DECS, M = SEQ + MS;
constexpr int FW_RAW = ACOLS + BQ + 2 * BKVW, FW = ((FW_RAW + 255) / 256) * 256, NIN = FW + 2 * DM;
constexpr int C_R = 0, C_WLO = AW, C_K = AW + DLORA, C_V = 2 * AW + DLORA, C_ALO = 3 * AW + DLORA, C_GLO = C_ALO + ILORA, C_Q = ACOLS, C_BK = ACOLS + BQ, C_BV = C_BK + BKVW;
constexpr int NCH = SEQ / 64, NUP = NCH * AH, NUS = DECB * AH, NU = NUP + NUS;
constexpr int NAP = NCH * BKV, NAS = DECB * BKV, NA = NAP + NAS;
constexpr float RMS_EPS = 1e-6f, GN_EPS = 64e-5f, LOG2E = 1.4426950408889634f;
static_assert(M % 256 == 0 && DM % 256 == 0 && DFF % 128 == 0 && AW % 128 == 0 && BQ % 128 == 0 && FW_RAW % 32 == 0 && DECS == 16 && GRP == 4, "shape constraints");

constexpr size_t O_YP = 0, O_YS = (size_t)SEQ * DM, O_PWKV = O_YS + (size_t)MS * DM, O_PSH = O_PWKV + (size_t)DEPTH * AH * 4096, O_PK = O_PSH + (size_t)DEPTH * ACOLS,
                 O_PV = O_PK + (size_t)DEPTH * WIN * BKVW, O_SWKV = O_PV + (size_t)DEPTH * WIN * BKVW, O_SSH = O_SWKV + (size_t)DEPTH * DECB * AH * 4096,
                 O_SK = O_SSH + (size_t)DEPTH * DECB * ACOLS, O_SV = O_SK + (size_t)DEPTH * DECB * DECS * BKVW, O_END = O_SV + (size_t)DEPTH * DECB * DECS * BKVW;

constexpr size_t al256(size_t x) { return (x + 255) & ~(size_t)255; }
constexpr size_t WS_CTL = 0, CTL_BYTES = 1u << 20;
constexpr size_t WS_ROPE = CTL_BYTES, ROPE_BYTES = al256((size_t)(SEQ + DECS) * 64 * 4);
constexpr int NSS = 3 * DEPTH + 1;
constexpr int NSLOT = DM / 32;
constexpr size_t WS_SS = WS_ROPE + ROPE_BYTES, SS_BYTES = al256((size_t)NSS * NSLOT * M * 4);
static_assert(NSLOT <= 64, "slots written one per lane");
constexpr size_t WS_W = WS_SS + SS_BYTES;
constexpr size_t SZ_WGU = (size_t)2 * DFF * DM * 2, SZ_WD = (size_t)DM * DFF * 2, SZ_WIN = (size_t)NIN * DM * 2, SZ_WUA = (size_t)DM * AW * 2, SZ_WUB = (size_t)DM * BQ * 2, SZ_WO = (size_t)DM * DM * 2;
constexpr size_t OFF_WGU1 = 0, OFF_WD1 = OFF_WGU1 + SZ_WGU, OFF_WIN = OFF_WD1 + SZ_WD, OFF_WUA = OFF_WIN + SZ_WIN, OFF_WUB = OFF_WUA + SZ_WUA, OFF_WO = OFF_WUB + SZ_WUB,
                 OFF_WGU2 = OFF_WO + SZ_WO, OFF_WD2 = OFF_WGU2 + SZ_WGU, OFF_DW2T = OFF_WD2 + SZ_WD, OFF_IA2T = OFF_DW2T + (size_t)AW * 64 * 2, OFF_GG2T = OFF_IA2T + (size_t)AW * 64 * 2,
                 LAYER_W_BYTES = al256(OFF_GG2T + (size_t)AW * 160 * 2);
constexpr size_t WS_H = WS_W + (size_t)DEPTH * LAYER_W_BYTES;
constexpr size_t WS_PF = WS_H + al256((size_t)M * DM * 2);
constexpr size_t WS_SG = WS_PF + al256((size_t)M * FW * 4);
constexpr size_t WS_YA = WS_SG + al256((size_t)M * 2 * DM * 2);
constexpr size_t WS_YB = WS_YA + al256((size_t)M * AW * 2);
constexpr size_t WS_MG = WS_YB + al256((size_t)M * BQ * 2);
constexpr size_t WS_OV = WS_MG + al256((size_t)M * DM * 2);
constexpr size_t WS_G = WS_OV;
constexpr size_t WS_T1 = WS_OV;
constexpr size_t WS_PCT = WS_T1 + al256((size_t)M * DM * 4);
constexpr size_t WS_UCS = WS_PCT + (size_t)NU * 8192;
constexpr size_t WS_QTT = WS_UCS + (size_t)NU * 16384;
constexpr size_t WS_YLT = WS_QTT + (size_t)NU * 8192;
constexpr size_t WS_GT = WS_YLT + (size_t)NU * 16384;
constexpr size_t WS_BNT = WS_GT + (size_t)NU * 8192;
constexpr size_t WS_SC = WS_BNT + (size_t)NU * 8192;
constexpr size_t WS_OV_END_A = WS_SC + (size_t)NUP * 8192, WS_OV_END_B = WS_G + al256((size_t)M * DFF * 2);
constexpr size_t WS_END = WS_OV_END_A > WS_OV_END_B ? WS_OV_END_A : WS_OV_END_B;

constexpr int LDS_BYTES = 159744;
constexpr int LDS_CTL_OFF = LDS_BYTES - 1024;
constexpr int NWAVES = 8, NTHR = 512;
constexpr int CW_CONV = 8192;
constexpr int LDS_RINV_OFF = 131072;
static_assert(LDS_RINV_OFF + 8 * 1024 <= LDS_CTL_OFF, "rinv tables");

typedef unsigned short bf16_t;
typedef short bf16x8 __attribute__((ext_vector_type(8)));
typedef short bf16x4 __attribute__((ext_vector_type(4)));
typedef float f32x4 __attribute__((ext_vector_type(4)));
typedef unsigned u32x4 __attribute__((ext_vector_type(4)));
typedef unsigned u32x2 __attribute__((ext_vector_type(2)));
#ifdef EMU
#define LAS
#define TID() emu_tid()
#define BID() emu_bid()
#define GRID() emu_grid()
#define WG_SYNC() emu_wg_sync()
#define MFMA16(a, b, c) emu_mfma16(a, b, c)
#define SHFL_XOR(v, m) emu_shfl_xor(v, m)
#define DEV static inline
#define DEVM inline
#define EXP2F(x) exp2f(x)
#define RSQRTF(x) (1.0f / sqrtf(x))
#define WAVE_FENCE() emu_wave_sync()
#define WAVE_ID(t) ((t) >> 6)
#define PIN(p, i) ((p).in[i])
#define P_WS() (g_emu_params.ws)
#define P_OUT() (g_emu_params.out)
#define FRESH_LANE() (emu_tid() & 63)
#define SPIN_WAIT() emu_yield()
#define OPAQUE_S(x) (x)
static inline int claim_item(unsigned* ctr, int lane) { (void)lane;
    static unsigned emu_last[1 << 16]; const int key = (emu_bid() * 8 + (emu_tid() >> 6)) & 0xffff; if ((emu_tid() & 63) == 0) emu_last[key] = (*ctr)++; emu_wave_sync(); const unsigned v = emu_last[key]; emu_wave_sync(); return (int)v; }
#define ATOMIC_ADD_U64(ptr, v) (*(ptr) += (v))
#define RCPF(x) (1.0f / (x))
#define LOG2F_(x) log2f(x)
static inline float sum8(float v) { v += emu_shfl_xor(v, 1); v += emu_shfl_xor(v, 2); v += emu_shfl_xor(v, 4); return v; }
static inline float sum16(float v) { v = sum8(v); v += emu_shfl_xor(v, 8); return v; }
static inline float sum64(float v) { v = sum16(v); v += emu_shfl_xor(v, 16); v += emu_shfl_xor(v, 32); return v; }
#define LDS_DRAIN() do { } while (0)
#define COMPILER_FENCE() do { } while (0)
#else
#define LAS __attribute__((address_space(3)))
#define TID() ((int)threadIdx.x)
#define BID() ((int)blockIdx.x)
#define GRID() ((int)gridDim.x)
#define WG_SYNC() __syncthreads()
#define MFMA16(a, b, c) __builtin_amdgcn_mfma_f32_16x16x32_bf16(a, b, c, 0, 0, 0)
#define SHFL_XOR(v, m) __shfl_xor(v, m)
#define DEV __device__ __forceinline__
#define DEVM __device__ __forceinline__
#define EXP2F(x) __builtin_amdgcn_exp2f(x)
#define RSQRTF(x) (1.0f / sqrtf(x))
#define WAVE_FENCE() asm volatile("s_waitcnt lgkmcnt(0)" ::: "memory")
#define WAVE_ID(t) __builtin_amdgcn_readfirstlane((t) >> 6)
#define PIN(p, i) pin_load(i)
#define P_WS() ((unsigned char*)pin_load(34))
#define P_OUT() ((float*)pin_load(33))
#define FRESH_LANE() fresh_lane()
#define SPIN_WAIT() __builtin_amdgcn_s_sleep(1)
__device__ __forceinline__ int opaque_s(int x) { asm volatile("" : "+s"(x)); return x; }
#define OPAQUE_S(x) opaque_s(x)
__device__ __forceinline__ int claim_item(unsigned* ctr, int lane) { unsigned v = 0; if (lane == 0) v = __hip_atomic_fetch_add((__attribute__((address_space(1))) unsigned*)ctr, 1u, __ATOMIC_RELAXED, __HIP_MEMORY_SCOPE_AGENT); return __builtin_amdgcn_readfirstlane(v); }
#define ATOMIC_ADD_U64(ptr, v) ((void)__hip_atomic_fetch_add((__attribute__((address_space(1))) unsigned long long*)(ptr), (v), __ATOMIC_RELAXED, __HIP_MEMORY_SCOPE_AGENT))
#define RCPF(x) __builtin_amdgcn_rcpf(x)
#define LOG2F_(x) __builtin_amdgcn_logf(x)
__device__ __forceinline__ float dpp_add(float v, const int ctrl_sel) {
    const int x = __builtin_bit_cast(int, v); int y;
    if (ctrl_sel == 0) y = __builtin_amdgcn_update_dpp(0, x, 0xB1, 0xF, 0xF, false); else if (ctrl_sel == 1) y = __builtin_amdgcn_update_dpp(0, x, 0x4E, 0xF, 0xF, false);
    else if (ctrl_sel == 2) y = __builtin_amdgcn_update_dpp(0, x, 0x141, 0xF, 0xF, false); else y = __builtin_amdgcn_update_dpp(0, x, 0x140, 0xF, 0xF, false);
    return v + __builtin_bit_cast(float, y);
}
__device__ __forceinline__ float sum8(float v) { v = dpp_add(v, 0); v = dpp_add(v, 1); v = dpp_add(v, 2); return v; }
__device__ __forceinline__ float sum16(float v) { v = sum8(v); v = dpp_add(v, 3); return v; }
__device__ __forceinline__ float sum64(float v) { v = sum16(v); v += __shfl_xor(v, 16); v += __shfl_xor(v, 32); return v; }
#define LDS_DRAIN() asm volatile("s_waitcnt lgkmcnt(0)" ::: "memory")
#define COMPILER_FENCE() asm volatile("" ::: "memory")
__device__ __forceinline__ int fresh_lane() { int l; asm volatile("v_mbcnt_lo_u32_b32 %0, -1, 0\n\tv_mbcnt_hi_u32_b32 %0, -1, %0" : "=v"(l)); return l; }
#endif
typedef LAS unsigned char* LDSP;
typedef unsigned long long ssq_t;
constexpr float SSQ_SCALE = 1048576.0f, SSQ_INV = 1.0f / 1048576.0f;
constexpr double TWO_PI = 6.283185307179586476925286766559;
#ifdef EMU
static const double ROPE_INV[32] = {1.0, 0.7498942093324559, 0.5623413251903491, 0.4216965034285822, 0.31622776601683794, 0.23713737056616552, 0.1778279410038923, 0.1333521432163324, 0.1, 0.07498942093324558, 0.05623413251903491, 0.042169650342858224, 0.03162277660168379, 0.023713737056616554, 0.01778279410038923, 0.01333521432163324, 0.01, 0.007498942093324558, 0.005623413251903491, 0.004216965034285823, 0.0031622776601683794, 0.0023713737056616554, 0.0017782794100389228, 0.001333521432163324, 0.001, 0.0007498942093324559, 0.0005623413251903491, 0.00042169650342858224, 0.00031622776601683794, 0.00023713737056616554, 0.00017782794100389227, 0.0001333521432163324};
#else
__device__ const double ROPE_INV[32] = {1.0, 0.7498942093324559, 0.5623413251903491, 0.4216965034285822, 0.31622776601683794, 0.23713737056616552, 0.1778279410038923, 0.1333521432163324, 0.1, 0.07498942093324558, 0.05623413251903491, 0.042169650342858224, 0.03162277660168379, 0.023713737056616554, 0.01778279410038923, 0.01333521432163324, 0.01, 0.007498942093324558, 0.005623413251903491, 0.004216965034285823, 0.0031622776601683794, 0.0023713737056616554, 0.0017782794100389228, 0.001333521432163324, 0.001, 0.0007498942093324559, 0.0005623413251903491, 0.00042169650342858224, 0.00031622776601683794, 0.00023713737056616554, 0.00017782794100389227, 0.0001333521432163324};
#endif

struct Params { const float* in[33]; float* out; unsigned char* ws; };
#ifdef EMU
static Params g_emu_params;
#endif
#ifndef EMU
__device__ __forceinline__ const float* pin_load(int i) {
    const __attribute__((address_space(4))) char* k = (const __attribute__((address_space(4))) char*)__builtin_amdgcn_kernarg_segment_ptr();
    asm volatile("" : "+s"(k));
    return *(const float* const __attribute__((address_space(4)))*)(k + 8 * i);
}
#endif
enum { I_XP = 0, I_XS, I_CK, I_CV, I_SWKV, I_SSH, I_NFF1, I_F1G, I_F1U, I_F1D, I_NMIX, I_WIN, I_MU, I_DW0, I_DW2, I_IA0, I_IA2, I_GG2, I_KK, I_KA, I_RK, I_GNG, I_GNB, I_QN, I_KN, I_SINK,
       I_WUA, I_WUB, I_WO, I_NFF2, I_F2G, I_F2U, I_F2D };

#ifdef EMU
DEV unsigned f2bf(float f) { unsigned u = __builtin_bit_cast(unsigned, f); return (u + 0x7fffu + ((u >> 16) & 1u)) >> 16; }
DEV unsigned pk2(float lo, float hi) { return f2bf(lo) | (f2bf(hi) << 16); }
#else
typedef float f32x2_t_ __attribute__((ext_vector_type(2))); typedef __bf16 bf16x2_t_ __attribute__((ext_vector_type(2)));
DEV unsigned pk2(float lo, float hi) { f32x2_t_ v = {lo, hi}; bf16x2_t_ b = __builtin_convertvector(v, bf16x2_t_); return __builtin_bit_cast(unsigned, b); }
DEV unsigned f2bf(float f) { return pk2(f, 0.f) & 0xffffu; }
#endif
DEV float bf2f(unsigned h) { return __builtin_bit_cast(float, h << 16); }
DEV bf16_t* lwp(const Params& p, int l, size_t off) { return (bf16_t*)(p.ws + WS_W + (size_t)l * LAYER_W_BYTES + off); }
DEV float wave_sum(float v) { return sum64(v); }
DEV float sigmoidf_(float x) { return RCPF(1.0f + EXP2F(-x * LOG2E)); }
DEV float tanhf_(float x) { return 1.0f - 2.0f * RCPF(1.0f + EXP2F(x * (2.0f * LOG2E))); }
DEV float expf_(float x) { return EXP2F(x * LOG2E); }
DEV float softplusf_(float z) { return fmaxf(z, 0.f) + LOG2F_(1.0f + EXP2F(-fabsf(z) * LOG2E)) * 0.6931471805599453f; }
DEV int swz(int row, int col) { return row * 128 + ((((col >> 3) ^ row) & 7) << 4) + ((col & 7) << 1); }
DEV int swz192(int row, int col) { const int ch = col >> 3; return row * 384 + (((ch & ~7) | ((ch ^ row) & 7)) << 4) + ((col & 7) << 1); }
DEV f32x4 mm64(LDSP A, int m0, LDSP B, int n0, f32x4 acc, int lane) {
    const int r = lane & 15, g4 = lane >> 4;
#pragma unroll
    for (int ks = 0; ks < 2; ++ks) {
        const bf16x8 a = *(const LAS bf16x8*)(A + swz(m0 + r, 32 * ks + 8 * g4));
        const bf16x8 b = *(const LAS bf16x8*)(B + swz(n0 + r, 32 * ks + 8 * g4));
        acc = MFMA16(a, b, acc);
    }
    return acc;
}
DEV void st_tile(LDSP O, int m0, int n0, f32x4 v, int lane) {
    const int r = lane & 15, g4 = lane >> 4;
#pragma unroll
    for (int reg = 0; reg < 4; ++reg) *(LAS bf16_t*)(O + swz(m0 + 4 * g4 + reg, n0 + r)) = (bf16_t)f2bf(v[reg]);
}
DEV void st_tile_T(LDSP O, int m0, int n0, f32x4 v, int lane) {
    const int r = lane & 15, g4 = lane >> 4;
    u32x2 w; w.x = pk2(v[0], v[1]); w.y = pk2(v[2], v[3]);
    *(LAS u32x2*)(O + swz(n0 + r, m0 + 4 * g4)) = w;
}
DEV bf16x8 pack8(f32x4 lo, f32x4 hi) {
    u32x4 w; w.x = pk2(lo[0], lo[1]); w.y = pk2(lo[2], lo[3]); w.z = pk2(hi[0], hi[1]); w.w = pk2(hi[2], hi[3]);
    return __builtin_bit_cast(bf16x8, w);
}

namespace pg8 {
#define PG8_LAS __attribute__((address_space(3)))
typedef unsigned short bf16_t;
typedef short bf16x8 __attribute__((ext_vector_type(8)));
typedef float f32x4 __attribute__((ext_vector_type(4)));
typedef unsigned u32x4 __attribute__((ext_vector_type(4)));
constexpr int BM = 256, BK = 64, HALF = 128, HTB = HALF * BK * 2  , STAGE_BYTES = 8 * HTB, NXCD = 8, WGM = 8;

__host__ __device__ __forceinline__ int lds_byte(int r, int c) { const int st = (r >> 4) * 2 + (c >> 5), rr = r & 15, cc = c & 31, ob = rr * 64 + cc * 2; return st * 1024 + (ob ^ (((ob >> 9) & 1) << 5)); }
__host__ __device__ __forceinline__ void stage_rc(int b, int& R, int& C) { const int st = b / 1024, sb = b % 1024, swz = sb ^ (((sb >> 9) & 1) << 5); R = (st >> 1) * 16 + swz / 64; C = (st & 1) * 32 + (swz % 64) / 2; }
__host__ __device__ __forceinline__ int perm32(int rho) { const int n = rho >> 4, i = rho & 15; return 8 * (i >> 2) + 4 * n + (i & 3); }

struct Unit { int pm, pn, idx; };
struct Gemm { const bf16_t* A; const bf16_t* Bt; int M, N, K; };

struct StaticOrder {
    int nM, nN, nwg, G, c;
    __host__ __device__ void init(int M, int N, int G_, int c_) { nM = M / BM; nN = N / BM; nwg = nM * nN; G = G_; c = c_; }
    __host__ __device__ bool next(int i, Unit& u) const {
        const long L = (long)i * G + c; if (L >= nwg) return false;
        int wgid = (int)L; { const int q = nwg / NXCD, r = nwg % NXCD, xcd = wgid % NXCD, off = wgid / NXCD; wgid = (xcd < r ? xcd * (q + 1) : r * (q + 1) + (xcd - r) * q) + off; }
        const int nig = WGM * nN, gid = wgid / nig, fm = gid * WGM, gsz = (nM - fm) < WGM ? (nM - fm) : WGM;
        u.pm = fm + ((wgid % nig) % gsz); u.pn = (wgid % nig) / gsz; u.idx = i; return true;
    }
    __device__ __forceinline__ void a_ready(const Unit&) const {}
    __device__ __forceinline__ void done(const Unit&) const {}
};

#ifndef EMU
template <class Epi, class Sched, bool ALIGN_EPI = false, bool SP2 = false>
__device__ __forceinline__ void gemm_phase(PG8_LAS unsigned char* lds, const Gemm g, const Sched& S, const Epi& E, const int wid) {
    const int lane = ::fresh_lane(), tid = wid * 64 + lane, wr = wid >> 2, wc = wid & 3, fr = lane & 15, fq = lane >> 4;
    const int K = g.K, nt = K / BK;
    unsigned voffA[2], voffB[2];
#pragma unroll
    for (int i = 0; i < 2; ++i) { int R, C; stage_rc(tid * 16 + i * 8192, R, C); const int Rb = Epi::PERM ? ((R & ~31) + perm32(R & 31)) : R;
        voffA[i] = (unsigned)(R * K + C) * 2u; voffB[i] = (unsigned)(Rb * K + C) * 2u; }
    const size_t kstep = (size_t)(BK * 2);
    const size_t hstep = (size_t)HALF * K * 2;
    const size_t tstep = 2 * hstep;
    const unsigned ldsw = (unsigned)wid * 1024u;
    const int aoff = lds_byte(wr * 64 + fr, fq * 8), boff = lds_byte(wc * 32 + fr, fq * 8);
#define PG8_SA(b, h) (((b) * 2 + (h)) * HTB)
#define PG8_SB(b, h) ((4 + (b) * 2 + (h)) * HTB)
#define PG8_STAGE(bufoff, gbase, voff) do { _Pragma("unroll") for (int _i = 0; _i < 2; ++_i) \
        __builtin_amdgcn_global_load_lds((const unsigned*)((const char*)(gbase) + (voff)[_i]), (PG8_LAS unsigned*)(lds + (bufoff) + ldsw + _i * 8192), 16, 0, 0); } while (0)
#define PG8_LDA(dst, b, h) do { _Pragma("unroll") for (int m = 0; m < 4; ++m) _Pragma("unroll") for (int k = 0; k < 2; ++k) dst[m][k] = *(const PG8_LAS bf16x8*)(lds + PG8_SA(b, h) + aoff + m * 2048 + k * 1024); } while (0)
#define PG8_LDB(dst, b, h) do { _Pragma("unroll") for (int n = 0; n < 2; ++n) _Pragma("unroll") for (int k = 0; k < 2; ++k) dst[n][k] = *(const PG8_LAS bf16x8*)(lds + PG8_SB(b, h) + boff + n * 2048 + k * 1024); } while (0)
#define PG8_MMA(ai, bj, At, Bt) do { __builtin_amdgcn_s_setprio(1); _Pragma("unroll") for (int m = 0; m < 4; ++m) _Pragma("unroll") for (int n = 0; n < 2; ++n) _Pragma("unroll") for (int k = 0; k < 2; ++k) \
        acc[ai][bj][m][n] = __builtin_amdgcn_mfma_f32_16x16x32_bf16(Bt[n][k], At[m][k], acc[ai][bj][m][n], 0, 0, 0); __builtin_amdgcn_s_setprio(0); } while (0)
#define PG8_WAIT_V(n) asm volatile("s_waitcnt vmcnt(" #n ")" ::: "memory")
#define PG8_WAIT_L(n) asm volatile("s_waitcnt lgkmcnt(" #n ")" ::: "memory")
#define PG8_BAR __builtin_amdgcn_s_barrier()
#define PG8_SCHED __builtin_amdgcn_sched_barrier(0)
    Unit cur, nxt; int ui = 0;
    if (!S.next(0, cur)) return;
    f32x4 acc[2][2][4][2];
#pragma unroll
    for (int a = 0; a < 2; ++a)
#pragma unroll
        for (int b = 0; b < 2; ++b)
#pragma unroll
            for (int m = 0; m < 4; ++m)
#pragma unroll
                for (int n = 0; n < 2; ++n) acc[a][b][m][n] = (f32x4){0.f, 0.f, 0.f, 0.f};
    bf16x8 At[4][2], B0[2][2], B1[2][2];
    const char* cA = (const char*)g.A + (size_t)cur.pm * tstep; const char* cB = (const char*)g.Bt + (size_t)cur.pn * tstep;
    S.a_ready(cur);
    if constexpr (SP2) {
        PG8_STAGE(PG8_SB(0, 0), cB, voffB); PG8_STAGE(PG8_SB(0, 1), cB + hstep, voffB); PG8_STAGE(PG8_SA(0, 0), cA, voffA); PG8_STAGE(PG8_SA(0, 1), cA + hstep, voffA);
        if (wr == 1) PG8_BAR;
        PG8_WAIT_V(2); PG8_BAR;
        PG8_STAGE(PG8_SB(1, 0), cB + kstep, voffB); PG8_STAGE(PG8_SA(1, 0), cA + kstep, voffA); PG8_STAGE(PG8_SB(1, 1), cB + hstep + kstep, voffB);
        PG8_WAIT_V(6); PG8_BAR;
    } else {
        PG8_STAGE(PG8_SB(0, 0), cB, voffB); PG8_STAGE(PG8_SA(0, 0), cA, voffA); PG8_STAGE(PG8_SB(0, 1), cB + hstep, voffB); PG8_STAGE(PG8_SA(0, 1), cA + hstep, voffA);
        if (wr == 1) PG8_BAR;
        PG8_WAIT_V(4); PG8_BAR;
        PG8_STAGE(PG8_SB(1, 0), cB + kstep, voffB); PG8_STAGE(PG8_SA(1, 0), cA + kstep, voffA); PG8_STAGE(PG8_SB(1, 1), cB + hstep + kstep, voffB);
        PG8_WAIT_V(6); PG8_BAR;
    }
    for (;;) {
        const bool has_next = S.next(ui + 1, nxt);
        const char* nA = has_next ? (const char*)g.A + (size_t)nxt.pm * tstep : cA; const char* nB = has_next ? (const char*)g.Bt + (size_t)nxt.pn * tstep : cB;
        for (int t = 0; t < nt; t += 2) {
            const bool last = (t == nt - 2);
            const char* a1 = cA + (size_t)(t + 1) * kstep;
            const char* a2 = last ? nA : cA + (size_t)(t + 2) * kstep; const char* b2 = last ? nB : cB + (size_t)(t + 2) * kstep;
            const char* a3 = a2 + kstep; const char* b3 = b2 + kstep;
            if (last && has_next) S.a_ready(nxt);
            if constexpr (SP2) {
            PG8_LDB(B0, 0, 0); PG8_LDB(B1, 0, 1); PG8_SCHED; PG8_LDA(At, 0, 0); PG8_STAGE(PG8_SA(1, 1), a1 + hstep, voffA);
            PG8_WAIT_V(8); PG8_WAIT_L(0); PG8_BAR; PG8_MMA(0, 0, At, B0); PG8_MMA(0, 1, At, B1); PG8_BAR; PG8_SCHED;
            PG8_LDA(At, 0, 1); PG8_STAGE(PG8_SB(0, 0), b2, voffB); PG8_STAGE(PG8_SB(0, 1), b2 + hstep, voffB); PG8_STAGE(PG8_SA(0, 0), a2, voffA);
            PG8_WAIT_V(8); PG8_WAIT_L(0); PG8_BAR; PG8_MMA(1, 0, At, B0); PG8_MMA(1, 1, At, B1); PG8_BAR; PG8_SCHED;
            PG8_LDB(B0, 1, 0); PG8_LDB(B1, 1, 1); PG8_SCHED; PG8_LDA(At, 1, 0); PG8_STAGE(PG8_SA(0, 1), a2 + hstep, voffA);
            PG8_WAIT_V(8); PG8_WAIT_L(0); PG8_BAR; PG8_MMA(0, 0, At, B0); PG8_MMA(0, 1, At, B1); PG8_BAR; PG8_SCHED;
            PG8_LDA(At, 1, 1); PG8_STAGE(PG8_SB(1, 0), b3, voffB); PG8_STAGE(PG8_SB(1, 1), b3 + hstep, voffB); PG8_STAGE(PG8_SA(1, 0), a3, voffA);
            PG8_WAIT_V(8); PG8_WAIT_L(0); PG8_BAR; PG8_MMA(1, 0, At, B0); PG8_MMA(1, 1, At, B1); PG8_BAR; PG8_SCHED;
            } else {
            PG8_LDB(B0, 0, 0); PG8_SCHED; PG8_LDA(At, 0, 0); PG8_STAGE(PG8_SA(1, 1), a1 + hstep, voffA);
            PG8_WAIT_L(8); PG8_BAR; PG8_WAIT_L(0); PG8_MMA(0, 0, At, B0); PG8_BAR; PG8_SCHED;
            PG8_LDB(B1, 0, 1); PG8_STAGE(PG8_SB(0, 0), b2, voffB);
            PG8_BAR; PG8_WAIT_L(0); PG8_MMA(0, 1, At, B1); PG8_BAR;
            PG8_LDA(At, 0, 1); PG8_STAGE(PG8_SA(0, 0), a2, voffA);
            PG8_BAR; PG8_WAIT_L(0); PG8_MMA(1, 0, At, B0); PG8_BAR; PG8_SCHED;
            PG8_STAGE(PG8_SB(0, 1), b2 + hstep, voffB);
            PG8_WAIT_V(6); PG8_BAR; PG8_MMA(1, 1, At, B1); PG8_BAR;
            PG8_LDB(B0, 1, 0); PG8_SCHED; PG8_LDA(At, 1, 0); PG8_STAGE(PG8_SA(0, 1), a2 + hstep, voffA);
            PG8_WAIT_L(8); PG8_BAR; PG8_WAIT_L(0); PG8_MMA(0, 0, At, B0); PG8_BAR; PG8_SCHED;
            PG8_LDB(B1, 1, 1); PG8_STAGE(PG8_SB(1, 0), b3, voffB);
            PG8_BAR; PG8_WAIT_L(0); PG8_MMA(0, 1, At, B1); PG8_BAR;
            PG8_LDA(At, 1, 1); PG8_STAGE(PG8_SA(1, 0), a3, voffA);
            PG8_BAR; PG8_WAIT_L(0); PG8_MMA(1, 0, At, B0); PG8_BAR; PG8_SCHED;
            PG8_STAGE(PG8_SB(1, 1), b3 + hstep, voffB);
            PG8_WAIT_V(6); PG8_BAR; PG8_MMA(1, 1, At, B1); PG8_BAR;
            }
        }
        if constexpr (ALIGN_EPI) { if (wr == 0) PG8_BAR; }
        if constexpr (!Epi::AFTER_DRAIN) { E(acc, cur, wr, wc, fr, fq); S.done(cur); }
        if (!has_next) break;
#pragma unroll
        for (int a = 0; a < 2; ++a)
#pragma unroll
            for (int b = 0; b < 2; ++b)
#pragma unroll
                for (int m = 0; m < 4; ++m)
#pragma unroll
                    for (int n = 0; n < 2; ++n) acc[a][b][m][n] = (f32x4){0.f, 0.f, 0.f, 0.f};
        cur = nxt; cA = nA; cB = nB; ++ui;
        if constexpr (ALIGN_EPI) { if (wr == 1) PG8_BAR; }
    }
    PG8_WAIT_V(0);
    if constexpr (!ALIGN_EPI) { if (wr == 0) PG8_BAR; }
    PG8_BAR;
    if constexpr (Epi::AFTER_DRAIN) { E.fused(acc, cur, wr, wc, fr, fq, lds, wid, lane); S.done(cur); }
#undef PG8_SA
#undef PG8_SB
#undef PG8_STAGE
#undef PG8_LDA
#undef PG8_LDB
#undef PG8_MMA
#undef PG8_WAIT_V
#undef PG8_WAIT_L
#undef PG8_BAR
#undef PG8_SCHED
}
}
#else
template <class Epi, class Sched, bool ALIGN_EPI = false, bool SP2 = false>
static void gemm_phase(LDSP lds, const Gemm g, const Sched& S, const Epi& E, const int wid_) {
    const int tid = TID(), wid = tid >> 6, lane = tid & 63, wr = wid >> 2, wc = wid & 3, fr = lane & 15, fq = lane >> 4;
    Unit u;
    for (int i = 0; S.next(i, u); ++i) {
        f32x4 acc[2][2][4][2];
        for (int ai = 0; ai < 2; ++ai) for (int bj = 0; bj < 2; ++bj) for (int m = 0; m < 4; ++m) for (int n = 0; n < 2; ++n) for (int e = 0; e < 4; ++e) {
            const int row = 256 * u.pm + 128 * ai + 64 * wr + 16 * m + fr;
            const int col = 256 * u.pn + 128 * bj + 32 * wc + (Epi::PERM ? 8 * fq + 4 * n + e : 16 * n + 4 * fq + e);
            const bf16_t* a = g.A + (size_t)row * g.K; const bf16_t* b = g.Bt + (size_t)col * g.K; float s = 0.f;
            for (int k = 0; k < g.K; ++k) s += ::bf2f(a[k]) * ::bf2f(b[k]);
            acc[ai][bj][m][n][e] = s; }
        E(acc, u, wr, wc, fr, fq);
    }
}
}
#endif

struct EpiSwiglu {
    static constexpr bool PERM = true, AFTER_DRAIN = false;
    LDSP rtab;
    DEVM void operator()(const f32x4 (&acc)[2][2][4][2], const pg8::Unit& u, int wr, int wc, int fr, int fq) const {
        const int row0 = u.pm * 256 + wr * 64 + fr, col0 = u.pn * 128 + wc * 32 + 8 * fq;
        unsigned char* ws_ = P_WS(); bf16_t* G = (bf16_t*)(ws_ + WS_G); const LAS float* rt = (const LAS float*)rtab + u.idx * 256 + wr * 64 + fr;
#pragma unroll
        for (int ai = 0; ai < 2; ++ai)
#pragma unroll
            for (int m = 0; m < 4; ++m) {
                bf16_t* rowp = G + (size_t)(row0 + ai * 128 + m * 16) * DFF + col0;
                const float rinv = rt[ai * 128 + m * 16];
                float o[8];
#pragma unroll
                for (int n = 0; n < 2; ++n)
#pragma unroll
                    for (int e = 0; e < 4; ++e) { const float g = acc[ai][0][m][n][e] * rinv, up = acc[ai][1][m][n][e] * rinv; o[4 * n + e] = g * up * RCPF(1.0f + EXP2F(-g * LOG2E)); }
                u32x4 w; w.x = pk2(o[0], o[1]); w.y = pk2(o[2], o[3]); w.z = pk2(o[4], o[5]); w.w = pk2(o[6], o[7]);
                *(u32x4*)rowp = w;
            }
    }
};
struct EpiResid {
    static constexpr bool PERM = true, AFTER_DRAIN = false;
    float scale; int nso;
    DEVM float apply4(size_t row, int col, f32x4 v) const { float* X = P_OUT(); bf16_t* XB = (bf16_t*)(P_WS() + WS_H); f32x4* q = (f32x4*)(X + row * DM + col); const f32x4 x = *q + v * scale; *q = x;
        u32x2 w; w.x = pk2(x[0], x[1]); w.y = pk2(x[2], x[3]); *(u32x2*)(XB + row * DM + col) = w; return (x[0] * x[0] + x[1] * x[1]) + (x[2] * x[2] + x[3] * x[3]); }
    DEVM void put_ss(size_t row, int slot, float ss) const { ((float*)(P_WS() + WS_SS))[((size_t)nso * NSLOT + slot) * M + row] = ss; }
    DEVM void operator()(const f32x4 (&acc)[2][2][4][2], const pg8::Unit& u, int wr, int wc, int fr, int fq) const {
        const int row0 = u.pm * 256 + wr * 64 + fr, col0 = u.pn * 256 + wc * 32 + 8 * fq;
        float* X = P_OUT(); unsigned char* ws_ = P_WS(); bf16_t* XB = (bf16_t*)(ws_ + WS_H); float* SSs = (float*)(ws_ + WS_SS) + ((size_t)nso * NSLOT + u.pn * 8 + wc) * M;
#pragma unroll
        for (int ai = 0; ai < 2; ++ai)
#pragma unroll
            for (int m = 0; m < 4; ++m) {
                const size_t row = (size_t)(row0 + ai * 128 + m * 16); float* rowp = X + row * DM + col0; bf16_t* rowb = XB + row * DM + col0;
#pragma unroll
                for (int bj = 0; bj < 2; ++bj) { float ss = 0.f;
#pragma unroll
                    for (int n = 0; n < 2; ++n) { f32x4* q = (f32x4*)(rowp + bj * 128 + n * 4); const f32x4 x = *q + acc[ai][bj][m][n] * scale; *q = x;
                        u32x2 w; w.x = pk2(x[0], x[1]); w.y = pk2(x[2], x[3]); *(u32x2*)(rowb + bj * 128 + n * 4) = w; ss += (x[0] * x[0] + x[1] * x[1]) + (x[2] * x[2] + x[3] * x[3]); }
                    ss += SHFL_XOR(ss, 16); ss += SHFL_XOR(ss, 32);
                    if (fq == 0) SSs[(size_t)bj * 4 * M + row] = ss; }
            }
    }
};
struct EpiWin {
    static constexpr bool PERM = true, AFTER_DRAIN = false;
    LDSP rtab;
    DEVM void operator()(const f32x4 (&acc)[2][2][4][2], const pg8::Unit& u, int wr, int wc, int fr, int fq) const {
        const int row0 = u.pm * 256 + wr * 64 + fr;
        unsigned char* ws_ = P_WS(); float* PF = (float*)(ws_ + WS_PF); bf16_t* SG = (bf16_t*)(ws_ + WS_SG); const LAS float* rt = (const LAS float*)rtab + u.idx * 256 + wr * 64 + fr;
        if (u.pn < FW / 256) {
            const int col0 = u.pn * 256 + wc * 32 + 8 * fq;
#pragma unroll
            for (int ai = 0; ai < 2; ++ai)
#pragma unroll
                for (int m = 0; m < 4; ++m) {
                    float* rowp = PF + (size_t)(row0 + ai * 128 + m * 16) * FW + col0; const float rinv = rt[ai * 128 + m * 16];
#pragma unroll
                    for (int bj = 0; bj < 2; ++bj)
#pragma unroll
                        for (int n = 0; n < 2; ++n) *(f32x4*)(rowp + bj * 128 + n * 4) = acc[ai][bj][m][n] * rinv;
                }
        } else {
            const int col0 = (u.pn - FW / 256) * 256 + wc * 32 + 8 * fq;
#pragma unroll
            for (int ai = 0; ai < 2; ++ai)
#pragma unroll
                for (int m = 0; m < 4; ++m) {
                    bf16_t* rowp = SG + (size_t)(row0 + ai * 128 + m * 16) * (2 * DM) + col0; const float rinv = rt[ai * 128 + m * 16];
#pragma unroll
                    for (int bj = 0; bj < 2; ++bj)
#pragma unroll
                        for (int n = 0; n < 2; ++n) { const f32x4 v = acc[ai][bj][m][n] * rinv; u32x2 w;
                            w.x = pk2(sigmoidf_(v[0]), sigmoidf_(v[1])); w.y = pk2(sigmoidf_(v[2]), sigmoidf_(v[3]));
                            *(u32x2*)(rowp + bj * 128 + n * 4) = w; }
                }
        }
    }
};
struct EpiUpA {
    static constexpr bool PERM = true, AFTER_DRAIN = false;
    int dummy;
    DEVM void put_ss(size_t, int, float) const {}
    DEVM float apply4(size_t row, int col, f32x4 v) const { unsigned char* ws_ = P_WS(); const bf16_t* SG = (const bf16_t*)(ws_ + WS_SG); float* T1 = (float*)(ws_ + WS_T1); const u32x2 s = *(const u32x2*)(SG + row * (2 * DM) + col);
        f32x4 o; o[0] = v[0] * bf2f(s.x & 0xffffu); o[1] = v[1] * bf2f(s.x >> 16); o[2] = v[2] * bf2f(s.y & 0xffffu); o[3] = v[3] * bf2f(s.y >> 16); *(f32x4*)(T1 + row * DM + col) = o; return 0.f; }
    DEVM void operator()(const f32x4 (&acc)[2][2][4][2], const pg8::Unit& u, int wr, int wc, int fr, int fq) const {
        const int row0 = u.pm * 256 + wr * 64 + fr, col0 = u.pn * 256 + wc * 32 + 8 * fq;
        unsigned char* ws_ = P_WS(); const bf16_t* SG = (const bf16_t*)(ws_ + WS_SG); float* T1 = (float*)(ws_ + WS_T1);
#pragma unroll
        for (int ai = 0; ai < 2; ++ai)
#pragma unroll
            for (int m = 0; m < 4; ++m) {
                const size_t row = (size_t)(row0 + ai * 128 + m * 16);
#pragma unroll
                for (int bj = 0; bj < 2; ++bj)
#pragma unroll
                    for (int n = 0; n < 2; ++n) { const int c = col0 + bj * 128 + n * 4; const u32x2 s = *(const u32x2*)(SG + row * (2 * DM) + c); const f32x4 v = acc[ai][bj][m][n];
                        f32x4 o; o[0] = v[0] * bf2f(s.x & 0xffffu); o[1] = v[1] * bf2f(s.x >> 16); o[2] = v[2] * bf2f(s.y & 0xffffu); o[3] = v[3] * bf2f(s.y >> 16);
                        *(f32x4*)(T1 + row * DM + c) = o; }
            }
    }
};
struct EpiUpB {
    static constexpr bool PERM = true, AFTER_DRAIN = false;
    int dummy;
    DEVM void put_ss(size_t, int, float) const {}
    DEVM float apply4(size_t row, int col, f32x4 v) const { unsigned char* ws_ = P_WS(); const bf16_t* SG = (const bf16_t*)(ws_ + WS_SG); const float* T1 = (const float*)(ws_ + WS_T1); bf16_t* MG = (bf16_t*)(ws_ + WS_MG); const u32x2 s = *(const u32x2*)(SG + row * (2 * DM) + DM + col); const f32x4 t = *(const f32x4*)(T1 + row * DM + col);
        u32x2 w; w.x = pk2(t[0] + v[0] * bf2f(s.x & 0xffffu), t[1] + v[1] * bf2f(s.x >> 16)); w.y = pk2(t[2] + v[2] * bf2f(s.y & 0xffffu), t[3] + v[3] * bf2f(s.y >> 16)); *(u32x2*)(MG + row * DM + col) = w; return 0.f; }
    DEVM void operator()(const f32x4 (&acc)[2][2][4][2], const pg8::Unit& u, int wr, int wc, int fr, int fq) const {
        const int row0 = u.pm * 256 + wr * 64 + fr, col0 = u.pn * 256 + wc * 32 + 8 * fq;
        unsigned char* ws_ = P_WS(); const bf16_t* SG = (const bf16_t*)(ws_ + WS_SG); const float* T1 = (const float*)(ws_ + WS_T1); bf16_t* MG = (bf16_t*)(ws_ + WS_MG);
#pragma unroll
        for (int ai = 0; ai < 2; ++ai)
#pragma unroll
            for (int m = 0; m < 4; ++m) {
                const size_t row = (size_t)(row0 + ai * 128 + m * 16);
#pragma unroll
                for (int bj = 0; bj < 2; ++bj)
#pragma unroll
                    for (int n = 0; n < 2; ++n) { const int c = col0 + bj * 128 + n * 4; const u32x2 s = *(const u32x2*)(SG + row * (2 * DM) + DM + c); const f32x4 v = acc[ai][bj][m][n];
                        const f32x4 t = *(const f32x4*)(T1 + row * DM + c);
                        u32x2 w; w.x = pk2(t[0] + v[0] * bf2f(s.x & 0xffffu), t[1] + v[1] * bf2f(s.x >> 16)); w.y = pk2(t[2] + v[2] * bf2f(s.y & 0xffffu), t[3] + v[3] * bf2f(s.y >> 16));
                        *(u32x2*)(MG + row * DM + c) = w; }
            }
    }
};


template <class Sched> DEV void rinv_table(const Sched& S, int nsi, LDSP lds, int tid) {
    const float* SS = (const float*)(P_WS() + WS_SS) + (size_t)nsi * NSLOT * M; LAS float* rt = (LAS float*)(lds + LDS_RINV_OFF);
    pg8::Unit u;
#pragma unroll 1
    for (int i = 0; S.next(i, u); ++i) if (tid < 256) { float s = 0.f;
#pragma unroll 8
        for (int k = 0; k < NSLOT; ++k) s += SS[(size_t)k * M + u.pm * 256 + tid];
        rt[i * 256 + tid] = RSQRTF(s * (1.0f / DM) + RMS_EPS); }
    WG_SYNC();
}

template <class Epi> DEV void sgemm_tile(const bf16_t* A, const bf16_t* Bt, int K, int m0, int n0, LDSP lds, int tid, const Epi& E) {
    const int lane = tid & 63, wave = WAVE_ID(tid), r = lane & 15, g4 = lane >> 4;
    f32x4 acc[4][4];
#pragma unroll
    for (int nt = 0; nt < 4; ++nt)
#pragma unroll
        for (int mt = 0; mt < 4; ++mt) acc[nt][mt] = (f32x4){0.f, 0.f, 0.f, 0.f};
    unsigned offA[4], offB[4];
#pragma unroll
    for (int t = 0; t < 4; ++t) { offA[t] = (unsigned)(((m0 + r + 16 * t) * K + 8 * g4) * 2); offB[t] = (unsigned)(((n0 + r + 16 * t) * K + 8 * g4) * 2); }
    const int nks = K >> 5;
    bf16x8 xa0[4], xb0[4], xa1[4], xb1[4], xa2[4], xb2[4];
#define SG_LOAD(A_, B_, ksv) do { const char* Ab_ = (const char*)A + 64 * (ksv); const char* Bb_ = (const char*)Bt + 64 * (ksv); _Pragma("unroll") for (int t = 0; t < 4; ++t) { \
        A_[t] = *(const bf16x8*)(Ab_ + offA[t]); B_[t] = *(const bf16x8*)(Bb_ + offB[t]); } } while (0)
#define SG_MMA(A_, B_) do { _Pragma("unroll") for (int nt = 0; nt < 4; ++nt) _Pragma("unroll") for (int mt = 0; mt < 4; ++mt) acc[nt][mt] = MFMA16(B_[nt], A_[mt], acc[nt][mt]); } while (0)
    const int npairs = nks >> 1, pq = npairs / NWAVES, prem = npairs % NWAVES, hcnt = 2 * (pq + (wave < prem ? 1 : 0)), hs = 2 * (wave * pq + (wave < prem ? wave : prem));
    int i = 0;
    if (hcnt > 0) SG_LOAD(xa0, xb0, hs);
    if (hcnt > 1) SG_LOAD(xa1, xb1, hs + 1);
#pragma unroll 1
    for (; i + 4 < hcnt; i += 3) {
        SG_LOAD(xa2, xb2, hs + i + 2); SG_MMA(xa0, xb0);
        SG_LOAD(xa0, xb0, hs + i + 3); SG_MMA(xa1, xb1);
        SG_LOAD(xa1, xb1, hs + i + 4); SG_MMA(xa2, xb2);
    }
    { const int R = hcnt - i;
      if (R >= 3) SG_LOAD(xa2, xb2, hs + i + 2);
      if (R >= 1) SG_MMA(xa0, xb0);
      if (R >= 4) SG_LOAD(xa0, xb0, hs + i + 3);
      if (R >= 2) SG_MMA(xa1, xb1);
      if (R >= 3) SG_MMA(xa2, xb2);
      if (R >= 4) SG_MMA(xa0, xb0); }
#undef SG_LOAD
#undef SG_MMA
#pragma unroll
    for (int nt = 0; nt < 4; ++nt)
#pragma unroll
        for (int mt = 0; mt < 4; ++mt) *(LAS f32x4*)(lds + wave * 16384 + ((nt * 4 + mt) * 64 + lane) * 16) = acc[nt][mt];
    WG_SYNC();
    {
        const int mt = wave & 3; float q = 0.f;
#pragma unroll
        for (int k = 0; k < 2; ++k) {
            const int nt = 2 * (wave >> 2) + k, s = (nt * 4 + mt) * 64 + lane;
            f32x4 v = *(const LAS f32x4*)(lds + s * 16);
#pragma unroll
            for (int w = 1; w < NWAVES; ++w) v = v + *(const LAS f32x4*)(lds + w * 16384 + s * 16);
            q += E.apply4((size_t)(m0 + 16 * mt + r), n0 + 16 * nt + 4 * g4, v);
        }
        q += SHFL_XOR(q, 16); q += SHFL_XOR(q, 32);
        if (g4 == 0) E.put_ss((size_t)(m0 + 16 * mt + r), (n0 >> 5) + (wave >> 2), q);
    }
    WG_SYNC();
}

DEV void conv_item(const float* W, int K, int N, bf16_t* WT, int mode, const float* gain, LAS float* scr, int item, int lane) {
    const int nblk = N / 32, kb = item / nblk, nb = item % nblk, k0 = 64 * kb, n0 = 32 * nb;
    int drow = n0;
    if (mode == 1) drow = (n0 >> 7) * 256 + (n0 & 127); else if (mode == 2) drow = (n0 >> 7) * 256 + 128 + (n0 & 127); else if (mode == 3) drow = n0 < FW_RAW ? n0 : FW + (n0 - FW_RAW);
    {
        f32x4 v[8];
#pragma unroll
        for (int i = 0; i < 8; ++i) v[i] = *(const f32x4*)(W + (size_t)(k0 + 8 * i + (lane >> 3)) * N + n0 + 4 * (lane & 7));
#pragma unroll
        for (int i = 0; i < 8; ++i) { LAS float* d = scr + (8 * i + (lane >> 3)) * 33 + 4 * (lane & 7); d[0] = v[i][0]; d[1] = v[i][1]; d[2] = v[i][2]; d[3] = v[i][3]; }
    }
    WAVE_FENCE();
    const int c = lane & 7;
    f32x4 g0 = (f32x4){1.f, 1.f, 1.f, 1.f}, g1 = g0;
    if (gain) { g0 = *(const f32x4*)(gain + k0 + 8 * c); g1 = *(const f32x4*)(gain + k0 + 8 * c + 4); }
#pragma unroll
    for (int j = 0; j < 4; ++j) { const int n = (lane >> 3) + 8 * j; const LAS float* s = scr + (8 * c) * 33 + n;
        u32x4 o; o.x = pk2(s[0 * 33] * g0[0], s[1 * 33] * g0[1]); o.y = pk2(s[2 * 33] * g0[2], s[3 * 33] * g0[3]); o.z = pk2(s[4 * 33] * g1[0], s[5 * 33] * g1[1]); o.w = pk2(s[6 * 33] * g1[2], s[7 * 33] * g1[3]);
        *(u32x4*)(WT + (size_t)(drow + n) * K + k0 + 8 * c) = o; }
    WAVE_FENCE();
}
constexpr int IT_G = (DM / 64) * (DFF / 32), IT_D = (DFF / 64) * (DM / 32), IT_IN = (DM / 64) * (INCOLS / 32), IT_UA = (AW / 64) * (DM / 32), IT_UB = (BQ / 64) * (DM / 32), IT_O = (DM / 64) * (DM / 32);
constexpr int IT_LAYER = 4 * IT_G + 2 * IT_D + IT_IN + IT_UA + IT_UB + IT_O;
DEV void conv_layer_item(const Params& p, int l, int r, LAS float* scr, int lane) {
        int src, K, N, mode, gsrc = -1; size_t doff, soff;
        if (r < IT_G) { src = I_F1G; gsrc = I_NFF1; K = DM; N = DFF; mode = 1; doff = OFF_WGU1; soff = (size_t)l * DM * DFF; }
        else if ((r -= IT_G) < IT_G) { src = I_F1U; gsrc = I_NFF1; K = DM; N = DFF; mode = 2; doff = OFF_WGU1; soff = (size_t)l * DM * DFF; }
        else if ((r -= IT_G) < IT_D) { src = I_F1D; K = DFF; N = DM; mode = 0; doff = OFF_WD1; soff = (size_t)l * DFF * DM; }
        else if ((r -= IT_D) < IT_IN) { src = I_WIN; gsrc = I_NMIX; K = DM; N = INCOLS; mode = 3; doff = OFF_WIN; soff = (size_t)l * DM * INCOLS; }
        else if ((r -= IT_IN) < IT_UA) { src = I_WUA; K = AW; N = DM; mode = 0; doff = OFF_WUA; soff = (size_t)l * AW * DM; }
        else if ((r -= IT_UA) < IT_UB) { src = I_WUB; K = BQ; N = DM; mode = 0; doff = OFF_WUB; soff = (size_t)l * BQ * DM; }
        else if ((r -= IT_UB) < IT_O) { src = I_WO; K = DM; N = DM; mode = 0; doff = OFF_WO; soff = (size_t)l * DM * DM; }
        else if ((r -= IT_O) < IT_G) { src = I_F2G; gsrc = I_NFF2; K = DM; N = DFF; mode = 1; doff = OFF_WGU2; soff = (size_t)l * DM * DFF; }
        else if ((r -= IT_G) < IT_G) { src = I_F2U; gsrc = I_NFF2; K = DM; N = DFF; mode = 2; doff = OFF_WGU2; soff = (size_t)l * DM * DFF; }
        else { r -= IT_G; src = I_F2D; K = DFF; N = DM; mode = 0; doff = OFF_WD2; soff = (size_t)l * DFF * DM; }
        conv_item(PIN(p, src) + soff, K, N, lwp(p, l, doff), mode, gsrc >= 0 ? PIN(p, gsrc) + (size_t)l * DM : nullptr, scr, r, lane);
}
DEV void conv_some(const Params& p, int l, int nmax, LDSP lds, int wave, int lane) {
    if (l >= DEPTH) return;
    unsigned* ctr = (unsigned*)(p.ws + WS_CTL) + CW_CONV + 64 * l; LAS float* scr = (LAS float*)(lds + wave * 8448);
#pragma unroll 1
    for (int n = 0; n < nmax; ++n) { const int r = claim_item(ctr, lane); if (r >= IT_LAYER) break; conv_layer_item(p, l, r, scr, lane); }
}
DEV void prologue(const Params& p, LDSP lds, int gw, int NGW, int wave, int lane, int gtid, int NGT) {
    LAS float* scr = (LAS float*)(lds + wave * 8448);
#pragma unroll 1
    for (int it = gw; it < DEPTH * IT_LAYER; it += NGW) conv_layer_item(p, it / IT_LAYER, it % IT_LAYER, scr, lane);
    for (int idx = gtid; idx < DEPTH * AW * 288; idx += NGT) {
        const int l = idx / (AW * 288), r = idx % (AW * 288), n = r / 288, k = r % 288;
        if (k < 64) lwp(p, l, OFF_DW2T)[n * 64 + k] = (bf16_t)f2bf(PIN(p, I_DW2)[((size_t)l * 64 + k) * AW + n]);
        else if (k < 128) lwp(p, l, OFF_IA2T)[n * 64 + (k - 64)] = (bf16_t)f2bf(PIN(p, I_IA2)[((size_t)l * 64 + (k - 64)) * AW + n]);
        else lwp(p, l, OFF_GG2T)[n * 160 + (k - 128)] = (bf16_t)f2bf(PIN(p, I_GG2)[((size_t)l * 160 + (k - 128)) * AW + n]);
    }
    float* rope = (float*)(p.ws + WS_ROPE);
    for (int idx = gtid; idx < (SEQ + DECS) * 32; idx += NGT) {
        const int slot = idx >> 5, i = idx & 31; const double pos = slot < SEQ ? (double)slot : (double)(PAST + slot - SEQ);
        const double ang = pos * ROPE_INV[i]; const double red = ang - TWO_PI * __builtin_rint(ang * (1.0 / TWO_PI));
        rope[2 * idx] = cosf((float)red); rope[2 * idx + 1] = sinf((float)red);
    }
}
DEV void x0_phase(const Params& p, int gw, int NGW, int lane, int gtid, int NGT) {
    float* X = p.out; bf16_t* XB = (bf16_t*)(p.ws + WS_H); float* SS = (float*)(p.ws + WS_SS);
    const float* xp = PIN(p, I_XP); const float* xs = PIN(p, I_XS);
    for (int m = gw; m < M; m += NGW) {
        const float* xr = m < SEQ ? xp + (size_t)m * DM : xs + (size_t)(m - SEQ) * DM;
        f32x4 v[DM / 256]; float ss = 0.f;
#pragma unroll
        for (int j = 0; j < DM / 256; ++j) { v[j] = *(const f32x4*)(xr + 4 * lane + 256 * j); ss += (v[j][0] * v[j][0] + v[j][1] * v[j][1]) + (v[j][2] * v[j][2] + v[j][3] * v[j][3]); }
#pragma unroll
        for (int j = 0; j < DM / 256; ++j) { *(f32x4*)(X + (size_t)m * DM + 4 * lane + 256 * j) = v[j]; u32x2 w; w.x = pk2(v[j][0], v[j][1]); w.y = pk2(v[j][2], v[j][3]); *(u32x2*)(XB + (size_t)m * DM + 4 * lane + 256 * j) = w; }
        ss = wave_sum(ss);
        if (lane < NSLOT) SS[(size_t)lane * M + m] = lane == 0 ? ss : 0.f;
    }
}

constexpr int R1_RA = 3 * 64 * 65 * 4, R1_RB = 65536 + 64 * 65 * 4;
static_assert(R1_RA + R1_RB + 2304 <= LDS_CTL_OFF && 6 * 8192 <= R1_RA, "R1 LDS map");
DEV void r1_unit(const Params& p, int l, int u, LDSP lds, int tid) {
    const int lane = tid & 63, wave = WAVE_ID(tid), r = lane & 15, g4 = lane >> 4;
    const bool samp = u >= NUP;
    int c = 0, b = 0, h, ntok; size_t row0;
    if (!samp) { c = u / AH; h = u % AH; row0 = (size_t)64 * c; ntok = 64; } else { const int s = u - NUP; b = s / AH; h = s % AH; row0 = (size_t)SEQ + 16 * b; ntok = DECS; }
    const float* PF = (const float*)(p.ws + WS_PF);
    const float* mu = PIN(p, I_MU) + (size_t)l * ACOLS;
    LDSP RA = lds, RB = lds + R1_RA;
    LAS float* DWf = (LAS float*)RA; LAS float* IAf = DWf + 64 * 65; LAS float* GGf = IAf + 64 * 65;
    LDSP LW = RB, LA = RB + 8192, LG = RB + 16384;
    LDSP B0 = RB, B1 = RB + 8192, B2 = RB + 16384, B3 = RB + 24576, B4 = RB + 32768, B5 = RB + 40960, B6 = RB + 49152, B7 = RB + 57344;
    LAS float* RtF = (LAS float*)(RB + 65536);
    LDSP A0 = RA, A1 = RA + 8192, A2 = RA + 16384, A3 = RA + 24576, A4 = RA + 32768, A5 = RA + 40960;
    LAS float* part = (LAS float*)(lds + R1_RA + R1_RB); LAS float* gam = part + 512;
    const int mt1 = wave & 3, nh = wave >> 2;
    bf16x8 bw[2][2], ba[2][2], bg[2][5];
#pragma unroll
    for (int n = 0; n < 2; ++n) { const size_t wrow = (size_t)(64 * h + 16 * (2 * nh + n) + r);
#pragma unroll
        for (int ks = 0; ks < 2; ++ks) { bw[n][ks] = *(const bf16x8*)(lwp(p, l, OFF_DW2T) + wrow * 64 + 32 * ks + 8 * g4); ba[n][ks] = *(const bf16x8*)(lwp(p, l, OFF_IA2T) + wrow * 64 + 32 * ks + 8 * g4); }
#pragma unroll
        for (int ks = 0; ks < 5; ++ks) bg[n][ks] = *(const bf16x8*)(lwp(p, l, OFF_GG2T) + wrow * 160 + 32 * ks + 8 * g4); }
    float cr8[8], ck8[8], cv8[8], pr0 = 0.f, pk0 = 0.f, pv0 = 0.f;
    { const int ch_ = 64 * h + lane, t0 = 8 * wave; const float* pp = nullptr;
      if (t0 > 0) { if (t0 - 1 < ntok) pp = PF + (row0 + t0 - 1) * FW; } else if (samp) pp = PIN(p, I_SSH) + ((size_t)l * DECB + b) * ACOLS; else if (c > 0) pp = PF + (row0 - 1) * FW;
      if (pp) { pr0 = pp[C_R + ch_]; pk0 = pp[C_K + ch_]; pv0 = pp[C_V + ch_]; }
#pragma unroll
      for (int tt = 0; tt < 8; ++tt) { cr8[tt] = 0.f; ck8[tt] = 0.f; cv8[tt] = 0.f;
          if (t0 + tt < ntok) { const float* cp = PF + (row0 + t0 + tt) * FW; cr8[tt] = cp[C_R + ch_]; ck8[tt] = cp[C_K + ch_]; cv8[tt] = cp[C_V + ch_]; } } }
    {
        const int t = tid >> 3, sub = tid & 7; const bool valid = t < ntok;
        const float* cur = PF + (row0 + t) * FW; const float* prv = cur - FW; float ps = 1.f;
        if (t == 0) { if (samp) prv = PIN(p, I_SSH) + ((size_t)l * DECB + b) * ACOLS; else if (c == 0) { prv = cur; ps = 0.f; } }
        u32x4 wv = (u32x4){0u, 0u, 0u, 0u}, av = wv;
        if (valid) {
            float x[8], y[8];
#pragma unroll
            for (int hh = 0; hh < 2; ++hh) { const int cw = C_WLO + 8 * sub + 4 * hh, ca = C_ALO + 8 * sub + 4 * hh;
                const f32x4 c1 = *(const f32x4*)(cur + cw), p1 = *(const f32x4*)(prv + cw), m1 = *(const f32x4*)(mu + cw), c2 = *(const f32x4*)(cur + ca), p2 = *(const f32x4*)(prv + ca), m2 = *(const f32x4*)(mu + ca);
#pragma unroll
                for (int e = 0; e < 4; ++e) { x[4 * hh + e] = tanhf_(c1[e] + (p1[e] * ps - c1[e]) * m1[e]); y[4 * hh + e] = c2[e] + (p2[e] * ps - c2[e]) * m2[e]; } }
            wv.x = pk2(x[0], x[1]); wv.y = pk2(x[2], x[3]); wv.z = pk2(x[4], x[5]); wv.w = pk2(x[6], x[7]);
            av.x = pk2(y[0], y[1]); av.y = pk2(y[2], y[3]); av.z = pk2(y[4], y[5]); av.w = pk2(y[6], y[7]);
        }
        *(LAS u32x4*)(LW + swz(t, 8 * sub)) = wv; *(LAS u32x4*)(LA + swz(t, 8 * sub)) = av;
#pragma unroll
        for (int q = 0; q < 5; ++q) { const int col = 20 * sub + 4 * q; u32x2 w = (u32x2){0u, 0u};
            if (valid) { const int cg = C_GLO + col; const f32x4 c1 = *(const f32x4*)(cur + cg), p1 = *(const f32x4*)(prv + cg), m1 = *(const f32x4*)(mu + cg); float z[4];
#pragma unroll
                for (int e = 0; e < 4; ++e) z[e] = sigmoidf_(c1[e] + (p1[e] * ps - c1[e]) * m1[e]);
                w.x = pk2(z[0], z[1]); w.y = pk2(z[2], z[3]); }
            *(LAS u32x2*)(LG + swz192(t, col)) = w; }
    }
    WG_SYNC();
    if (16 * mt1 < ntok) {
        f32x4 aw[2], aa[2], ag[2];
#pragma unroll
        for (int n = 0; n < 2; ++n) { aw[n] = (f32x4){0.f, 0.f, 0.f, 0.f}; aa[n] = aw[n]; ag[n] = aw[n]; }
#pragma unroll
        for (int ks = 0; ks < 2; ++ks) { const bf16x8 a1 = *(const LAS bf16x8*)(LW + swz(16 * mt1 + r, 32 * ks + 8 * g4)), a2 = *(const LAS bf16x8*)(LA + swz(16 * mt1 + r, 32 * ks + 8 * g4));
#pragma unroll
            for (int n = 0; n < 2; ++n) { aw[n] = MFMA16(a1, bw[n][ks], aw[n]); aa[n] = MFMA16(a2, ba[n][ks], aa[n]); } }
#pragma unroll
        for (int ks = 0; ks < 5; ++ks) { const bf16x8 a3 = *(const LAS bf16x8*)(LG + swz192(16 * mt1 + r, 32 * ks + 8 * g4));
#pragma unroll
            for (int n = 0; n < 2; ++n) ag[n] = MFMA16(a3, bg[n][ks], ag[n]); }
#pragma unroll
        for (int n = 0; n < 2; ++n)
#pragma unroll
            for (int reg = 0; reg < 4; ++reg) { const int o = (16 * mt1 + 4 * g4 + reg) * 65 + 16 * (2 * nh + n) + r; DWf[o] = aw[n][reg]; IAf[o] = aa[n][reg]; GGf[o] = ag[n][reg]; }
    }
    WG_SYNC();
    {
        const int j = lane, tq = wave, ch = 64 * h + j;
        const float w0 = PIN(p, I_DW0)[(size_t)l * AW + ch], a0 = PIN(p, I_IA0)[(size_t)l * AW + ch], kkw = PIN(p, I_KK)[(size_t)l * AW + ch], kaw = PIN(p, I_KA)[(size_t)l * AW + ch], rkw = PIN(p, I_RK)[(size_t)l * AW + ch];
        const float mur = mu[C_R + ch], muk = mu[C_K + ch], muv = mu[C_V + ch];
        float pr = pr0, pk = pk0, pv = pv0;
        float rr[8], kq[8], kp[8], av[8], vv[8], ld[8], Lc[8], bs[8]; float Lacc = 0.f;
#pragma unroll
        for (int tt = 0; tt < 8; ++tt) {
            const int t = 8 * tq + tt; const bool valid = t < ntok;
            const float cr = cr8[tt], ck = ck8[tt], cv = cv8[tt];
            float r_ = cr + (pr - cr) * mur, k_ = ck + (pk - ck) * muk, v_ = cv + (pv - cv) * muv; pr = cr; pk = ck; pv = cv;
            const float w = -softplusf_(-(w0 + DWf[t * 65 + j])) - 0.5f;
            float logd = -expf_(w);
            float a = sigmoidf_(a0 + IAf[t * 65 + j]);
            float kn = k_ * kkw; const float ss = wave_sum(kn * kn); kn = kn * RCPF(fmaxf(sqrtf(ss), 1e-12f));
            float kpp = k_ * (1.0f + (a - 1.0f) * kaw);
            float bsum = wave_sum(r_ * kpp * rkw);
            if (!valid) { logd = 0.f; kn = 0.f; kpp = 0.f; r_ = 0.f; v_ = 0.f; a = 0.f; bsum = 0.f; }
            Lacc += logd; ld[tt] = logd; Lc[tt] = Lacc; rr[tt] = r_; kq[tt] = kn; kp[tt] = kpp; av[tt] = a; vv[tt] = v_; bs[tt] = bsum;
        }
        part[tq * 64 + j] = Lacc;
        WG_SYNC();
        float off = 0.f;
#pragma unroll
        for (int q = 0; q < 8; ++q) if (q < tq) off += part[q * 64 + j];
        float fa[8], fb[8], fk[8], gt[8], bn[8];
#pragma unroll
        for (int tt = 0; tt < 8; ++tt) {
            const int t = 8 * tq + tt; const float L = Lc[tt] + off, Lm = L - ld[tt], eL = expf_(L), eLm = expf_(Lm), enL = expf_(-L);
            const float At = -kq[tt] * eLm, Bt = kq[tt] * av[tt] * enL, Kt = kp[tt] * enL, Rt = rr[tt] * eL;
            *(LAS bf16_t*)(B0 + swz(t, j)) = (bf16_t)f2bf(At); *(LAS bf16_t*)(B2 + swz(t, j)) = (bf16_t)f2bf(Bt); *(LAS bf16_t*)(B4 + swz(t, j)) = (bf16_t)f2bf(Kt); *(LAS bf16_t*)(B6 + swz(t, j)) = (bf16_t)f2bf(Rt);
            RtF[t * 65 + j] = Rt; fa[tt] = At; fb[tt] = Bt; fk[tt] = Kt; gt[tt] = GGf[t * 65 + j]; bn[tt] = bs[tt] * vv[tt];
            if (t == 63) gam[j] = eL;
        }
#define R1_PK8(a) ((u32x4){pk2(a[0], a[1]), pk2(a[2], a[3]), pk2(a[4], a[5]), pk2(a[6], a[7])})
        *(LAS u32x4*)(B1 + swz(j, 8 * tq)) = R1_PK8(fa); *(LAS u32x4*)(B3 + swz(j, 8 * tq)) = R1_PK8(fb); *(LAS u32x4*)(B5 + swz(j, 8 * tq)) = R1_PK8(fk); *(LAS u32x4*)(B7 + swz(j, 8 * tq)) = R1_PK8(vv);
        *(u32x4*)((bf16_t*)(p.ws + WS_GT) + (size_t)u * 4096 + j * 64 + 8 * tq) = R1_PK8(gt);
        *(u32x4*)((bf16_t*)(p.ws + WS_BNT) + (size_t)u * 4096 + j * 64 + 8 * tq) = R1_PK8(bn);
#undef R1_PK8
    }
    WG_SYNC();
    f32x4 accP[2];
    const f32x4 zero4 = (f32x4){0.f, 0.f, 0.f, 0.f};
#pragma unroll
    for (int q = 0; q < 2; ++q) {
        const int ti = 2 * wave + q, m0 = 16 * (ti >> 2), n0 = 16 * (ti & 3), s = n0 + r;
        f32x4 x = mm64(B0, m0, B2, n0, zero4, lane);
        f32x4 pI;
#pragma unroll
        for (int reg = 0; reg < 4; ++reg) { const int t = m0 + 4 * g4 + reg; if (!(t > s)) x[reg] = 0.f; pI[reg] = x[reg] + (t == s ? 1.f : 0.f); }
        st_tile(A0, m0, n0, x, lane); st_tile_T(A1, m0, n0, x, lane); st_tile(A2, m0, n0, pI, lane); accP[q] = pI;
        x = mm64(B0, m0, B4, n0, zero4, lane);
#pragma unroll
        for (int reg = 0; reg < 4; ++reg) { const int t = m0 + 4 * g4 + reg; if (!(t > s)) x[reg] = 0.f; }
        st_tile(A3, m0, n0, x, lane);
        x = mm64(B6, m0, B2, n0, zero4, lane);
#pragma unroll
        for (int reg = 0; reg < 4; ++reg) { const int t = m0 + 4 * g4 + reg; if (!(t >= s)) x[reg] = 0.f; }
        st_tile(A4, m0, n0, x, lane);
        x = mm64(B6, m0, B4, n0, zero4, lane);
#pragma unroll
        for (int reg = 0; reg < 4; ++reg) { const int t = m0 + 4 * g4 + reg; if (!(t >= s)) x[reg] = 0.f; }
        st_tile(A5, m0, n0, x, lane);
    }
    WG_SYNC();
#define R1_STAGE_A(Ys, YTs, Yd, YTd) do { _Pragma("unroll") for (int q = 0; q < 2; ++q) { const int ti = 2 * wave + q, m0 = 16 * (ti >> 2), n0 = 16 * (ti & 3); \
        const f32x4 x = mm64(Ys, m0, YTs, n0, zero4, lane); st_tile(Yd, m0, n0, x, lane); st_tile_T(YTd, m0, n0, x, lane); } } while (0)
#define R1_STAGE_B(Ps, YTn, Pd) do { _Pragma("unroll") for (int q = 0; q < 2; ++q) { const int ti = 2 * wave + q, m0 = 16 * (ti >> 2), n0 = 16 * (ti & 3); \
        accP[q] = mm64(Ps, m0, YTn, n0, accP[q], lane); st_tile(Pd, m0, n0, accP[q], lane); } } while (0)
    R1_STAGE_A(A0, A1, B0, B2);
    WG_SYNC();
#pragma unroll 1
    for (int it = 1; it <= 5; ++it) {
        const int nxt = it & 1;
        LDSP Ps = nxt ? A2 : B4, Pd = nxt ? B4 : A2, YTn = nxt ? B2 : A1;
        R1_STAGE_B(Ps, YTn, Pd);
        if (it < 5) { LDSP Ys = nxt ? B0 : A0, YTs = nxt ? B2 : A1, Yd = nxt ? A0 : B0, YTd = nxt ? A1 : B2; R1_STAGE_A(Ys, YTs, Yd, YTd); }
        WG_SYNC();
    }
#undef R1_STAGE_A
#undef R1_STAGE_B
#pragma unroll
    for (int q = 0; q < 2; ++q) {
        const int ti = 2 * wave + q, m0 = 16 * (ti >> 2), n0 = 16 * (ti & 3);
        st_tile(B6, m0, n0, mm64(B1, m0, B4, n0, zero4, lane), lane);
        st_tile(A0, m0, n0, mm64(B7, m0, A3, n0, zero4, lane), lane);
    }
    WG_SYNC();
#pragma unroll
    for (int q = 0; q < 2; ++q) {
        const int ti = 2 * wave + q, m0 = 16 * (ti >> 2), n0 = 16 * (ti & 3);
        st_tile(A1, m0, n0, mm64(A0, m0, B4, n0, zero4, lane), lane);
        f32x4 x = mm64(B6, m0, B3, n0, zero4, lane);
        { const int jp = n0 + r; const float gj = gam[jp]; u32x2 w;
          float y[4];
#pragma unroll
          for (int reg = 0; reg < 4; ++reg) y[reg] = (x[reg] + ((m0 + 4 * g4 + reg) == jp ? 1.f : 0.f)) * gj;
          w.x = pk2(y[0], y[1]); w.y = pk2(y[2], y[3]);
          *(u32x2*)((bf16_t*)(p.ws + WS_PCT) + (size_t)u * 4096 + jp * 64 + m0 + 4 * g4) = w; }
        x = mm64(A4, m0, B6, n0, zero4, lane);
        { bf16_t* Q = (bf16_t*)(p.ws + WS_QTT) + (size_t)u * 4096;
#pragma unroll
          for (int reg = 0; reg < 4; ++reg) { const int t = m0 + 4 * g4 + reg; Q[t * 64 + n0 + r] = (bf16_t)f2bf(x[reg] + RtF[t * 65 + n0 + r]); } }
    }
    WG_SYNC();
#pragma unroll
    for (int q = 0; q < 2; ++q) {
        const int ti = 2 * wave + q, m0 = 16 * (ti >> 2), n0 = 16 * (ti & 3);
        f32x4 x = mm64(B3, m0, A1, n0, zero4, lane); x = mm64(B5, m0, B7, n0, x, lane);
#pragma unroll
        for (int reg = 0; reg < 4; ++reg) x[reg] *= gam[m0 + 4 * g4 + reg];
        *(f32x4*)((float*)(p.ws + WS_UCS) + (size_t)u * 4096 + (n0 + r) * 64 + m0 + 4 * g4) = x;
        x = mm64(A4, m0, A1, n0, zero4, lane); x = mm64(A5, m0, B7, n0, x, lane);
        *(f32x4*)((float*)(p.ws + WS_YLT) + (size_t)u * 4096 + (ti * 64 + lane) * 4) = x;
    }
    WG_SYNC();
}

DEV void r2_chain(const Params& p, int l, int task, int lane) {
    const int h = task >> 2, q = task & 3, r = lane & 15, g4 = lane >> 4, i = 16 * q + r;
    const bf16_t* PCT = (const bf16_t*)(p.ws + WS_PCT); const float* UCS = (const float*)(p.ws + WS_UCS); bf16_t* SC = (bf16_t*)(p.ws + WS_SC);
    f32x4 S[4];
#pragma unroll
    for (int mt = 0; mt < 4; ++mt) S[mt] = (f32x4){0.f, 0.f, 0.f, 0.f};
    bf16x4 a0[4][2], a1[4][2]; f32x4 ci[4];
#define R2_LOAD(cc) do { const size_t u_ = (size_t)(cc) * AH + h; _Pragma("unroll") for (int mt = 0; mt < 4; ++mt) { ci[mt] = *(const f32x4*)(UCS + u_ * 4096 + i * 64 + 16 * mt + 4 * g4); \
        _Pragma("unroll") for (int ks = 0; ks < 2; ++ks) { a0[mt][ks] = *(const bf16x4*)(PCT + u_ * 4096 + (16 * mt + r) * 64 + 32 * ks + 4 * g4); a1[mt][ks] = *(const bf16x4*)(PCT + u_ * 4096 + (16 * mt + r) * 64 + 32 * ks + 16 + 4 * g4); } } } while (0)
    R2_LOAD(0);
#pragma unroll 1
    for (int c = 0; c < NCH; ++c) {
        const size_t u = (size_t)c * AH + h;
        bf16x8 pb[2];
#pragma unroll
        for (int ks = 0; ks < 2; ++ks) pb[ks] = pack8(S[2 * ks], S[2 * ks + 1]);
#pragma unroll
        for (int mt = 0; mt < 4; ++mt) { u32x2 w; w.x = pk2(S[mt][0], S[mt][1]); w.y = pk2(S[mt][2], S[mt][3]); *(u32x2*)(SC + u * 4096 + i * 64 + 16 * mt + 4 * g4) = w; }
        bf16x8 af[4][2]; f32x4 cc[4];
#pragma unroll
        for (int mt = 0; mt < 4; ++mt) { cc[mt] = ci[mt];
#pragma unroll
            for (int ks = 0; ks < 2; ++ks) af[mt][ks] = (bf16x8){a0[mt][ks][0], a0[mt][ks][1], a0[mt][ks][2], a0[mt][ks][3], a1[mt][ks][0], a1[mt][ks][1], a1[mt][ks][2], a1[mt][ks][3]}; }
        if (c + 1 < NCH) R2_LOAD(c + 1);
#pragma unroll
        for (int mt = 0; mt < 4; ++mt) { f32x4 x = MFMA16(af[mt][0], pb[0], cc[mt]); S[mt] = MFMA16(af[mt][1], pb[1], x); }
    }
#undef R2_LOAD
    float* o = p.out + O_PWKV + ((size_t)l * AH + h) * 4096;
#pragma unroll
    for (int mt = 0; mt < 4; ++mt) *(f32x4*)(o + i * 64 + 16 * mt + 4 * g4) = S[mt];
}

constexpr int R2_NSLOT = 12, R2_SLOTB = 12288, R2_FLAGS = R2_NSLOT * R2_SLOTB;
static_assert(R2_FLAGS + 128 <= LDS_CTL_OFF, "R2 ring");
DEV void r2_chain_ring(const Params& p, int l, int task, LDSP lds, int wave, int lane) {
    const int h = task >> 2, q = task & 3, r = lane & 15, g4 = lane >> 4, i = 16 * q + r;
    volatile LAS unsigned* full = (volatile LAS unsigned*)(lds + R2_FLAGS); volatile LAS unsigned* prog = full + 16;
    if (wave == 0 && lane < 32) full[lane] = 0u;
    WG_SYNC();
    if (wave > 0) {
        const unsigned char* PCT = p.ws + WS_PCT; const unsigned char* UCS = p.ws + WS_UCS;
#pragma unroll 1
        for (int c = wave - 1; c < NCH; c += NWAVES - 1) {
            const size_t u = (size_t)c * AH + h; const int slot = c % R2_NSLOT;
            u32x4 v[12];
#pragma unroll
            for (int k = 0; k < 8; ++k) v[k] = *(const u32x4*)(PCT + u * 8192 + k * 1024 + lane * 16);
#pragma unroll
            for (int k = 0; k < 4; ++k) v[8 + k] = *(const u32x4*)(UCS + u * 16384 + (size_t)q * 4096 + k * 1024 + lane * 16);
            while ((int)*prog + R2_NSLOT <= c) SPIN_WAIT();
            COMPILER_FENCE();
#pragma unroll
            for (int k = 0; k < 12; ++k) *(LAS u32x4*)(lds + slot * R2_SLOTB + k * 1024 + lane * 16) = v[k];
            LDS_DRAIN();
            if (lane == 0) full[slot] = (unsigned)c + 1u;
        }
        return;
    }
    bf16_t* SC = (bf16_t*)(p.ws + WS_SC);
    f32x4 S[4];
#pragma unroll
    for (int mt = 0; mt < 4; ++mt) S[mt] = (f32x4){0.f, 0.f, 0.f, 0.f};
#pragma unroll 1
    for (int c = 0; c < NCH; ++c) {
        const size_t u = (size_t)c * AH + h; const int slot = c % R2_NSLOT;
        bf16x8 pb[2];
#pragma unroll
        for (int ks = 0; ks < 2; ++ks) pb[ks] = pack8(S[2 * ks], S[2 * ks + 1]);
#pragma unroll
        for (int mt = 0; mt < 4; ++mt) { u32x2 w; w.x = pk2(S[mt][0], S[mt][1]); w.y = pk2(S[mt][2], S[mt][3]); *(u32x2*)(SC + u * 4096 + i * 64 + 16 * mt + 4 * g4) = w; }
        while (full[slot] != (unsigned)c + 1u) SPIN_WAIT();
        COMPILER_FENCE();
        LDSP sl = lds + slot * R2_SLOTB;
        bf16x8 af[4][2]; f32x4 cc[4];
#pragma unroll
        for (int mt = 0; mt < 4; ++mt) { cc[mt] = *(const LAS f32x4*)(sl + 8192 + (r * 64 + 16 * mt + 4 * g4) * 4);
#pragma unroll
            for (int ks = 0; ks < 2; ++ks) { const bf16x4 lo = *(const LAS bf16x4*)(sl + ((16 * mt + r) * 64 + 32 * ks + 4 * g4) * 2), hi = *(const LAS bf16x4*)(sl + ((16 * mt + r) * 64 + 32 * ks + 16 + 4 * g4) * 2);
                af[mt][ks] = (bf16x8){lo[0], lo[1], lo[2], lo[3], hi[0], hi[1], hi[2], hi[3]}; } }
        LDS_DRAIN();
        if (lane == 0) *prog = (unsigned)c + 1u;
#pragma unroll
        for (int mt = 0; mt < 4; ++mt) { f32x4 x = MFMA16(af[mt][0], pb[0], cc[mt]); S[mt] = MFMA16(af[mt][1], pb[1], x); }
    }
    float* o = p.out + O_PWKV + ((size_t)l * AH + h) * 4096;
#pragma unroll
    for (int mt = 0; mt < 4; ++mt) *(f32x4*)(o + i * 64 + 16 * mt + 4 * g4) = S[mt];
}
DEV void r2_sample(const Params& p, int l, int task, int lane) {
    const int q = task & 3, bh = task >> 2, r = lane & 15, g4 = lane >> 4, i = 16 * q + r;
    const size_t u = (size_t)NUP + bh;
    const bf16_t* PCT = (const bf16_t*)(p.ws + WS_PCT) + u * 4096; const float* UCS = (const float*)(p.ws + WS_UCS) + u * 4096;
    const float* S0 = PIN(p, I_SWKV) + ((size_t)l * DECB * AH + bh) * 4096;
    bf16x8 pb[2];
#pragma unroll
    for (int ks = 0; ks < 2; ++ks) { const f32x4 lo = *(const f32x4*)(S0 + i * 64 + 32 * ks + 8 * g4), hi = *(const f32x4*)(S0 + i * 64 + 32 * ks + 8 * g4 + 4); pb[ks] = pack8(lo, hi); }
    float* o = p.out + O_SWKV + ((size_t)l * DECB * AH + bh) * 4096;
#pragma unroll
    for (int mt = 0; mt < 4; ++mt) {
        f32x4 x = *(const f32x4*)(UCS + i * 64 + 16 * mt + 4 * g4);
#pragma unroll
        for (int ks = 0; ks < 2; ++ks) { const bf16x8 a = *(const bf16x8*)(PCT + (16 * mt + r) * 64 + 32 * ks + 8 * g4); x = MFMA16(a, pb[ks], x); }
        *(f32x4*)(o + i * 64 + 16 * mt + 4 * g4) = x;
    }
}

DEV void r3_work(const Params& p, int l, int u, int mt, int lane) {
    const bool samp = u >= NUP; int c = 0, b = 0, h;
    if (!samp) { c = u / AH; h = u % AH; } else { const int s = u - NUP; b = s / AH; h = s % AH; if (mt > 0) return; }
    const int r = lane & 15, g4 = lane >> 4;
    const bf16_t* Q = (const bf16_t*)(p.ws + WS_QTT) + (size_t)u * 4096;
    bf16x8 a[2];
#pragma unroll
    for (int ks = 0; ks < 2; ++ks) a[ks] = *(const bf16x8*)(Q + (16 * mt + r) * 64 + 32 * ks + 8 * g4);
    f32x4 acc[4];
#pragma unroll
    for (int nt = 0; nt < 4; ++nt) {
        acc[nt] = *(const f32x4*)((const float*)(p.ws + WS_YLT) + (size_t)u * 4096 + ((mt * 4 + nt) * 64 + lane) * 4);
#pragma unroll
        for (int ks = 0; ks < 2; ++ks) {
            bf16x8 bb;
            if (!samp) bb = *(const bf16x8*)((const bf16_t*)(p.ws + WS_SC) + (size_t)u * 4096 + (16 * nt + r) * 64 + 32 * ks + 8 * g4);
            else { const float* S0 = PIN(p, I_SWKV) + (((size_t)l * DECB + b) * AH + h) * 4096 + (16 * nt + r) * 64 + 32 * ks + 8 * g4; bb = pack8(*(const f32x4*)S0, *(const f32x4*)(S0 + 4)); }
            acc[nt] = MFMA16(a[ks], bb, acc[nt]);
        }
    }
    float mean[4], rs[4];
#pragma unroll
    for (int reg = 0; reg < 4; ++reg) {
        float s = (acc[0][reg] + acc[1][reg]) + (acc[2][reg] + acc[3][reg]);
        s = sum16(s);
        const float mn = s * (1.0f / 64.0f); float v = 0.f;
#pragma unroll
        for (int nt = 0; nt < 4; ++nt) { const float d = acc[nt][reg] - mn; v += d * d; }
        v = sum16(v);
        mean[reg] = mn; rs[reg] = RSQRTF(v * (1.0f / 64.0f) + GN_EPS);
    }
    bf16_t* YA = (bf16_t*)(p.ws + WS_YA);
#pragma unroll
    for (int nt = 0; nt < 4; ++nt) {
        const int i = 16 * nt + r; const float gain = PIN(p, I_GNG)[(size_t)l * AW + 64 * h + i], bias = PIN(p, I_GNB)[(size_t)l * AW + 64 * h + i];
        const u32x2 g2 = *(const u32x2*)((const bf16_t*)(p.ws + WS_GT) + (size_t)u * 4096 + i * 64 + 16 * mt + 4 * g4);
        const u32x2 b2 = *(const u32x2*)((const bf16_t*)(p.ws + WS_BNT) + (size_t)u * 4096 + i * 64 + 16 * mt + 4 * g4);
        const float gg[4] = {bf2f(g2.x & 0xffffu), bf2f(g2.x >> 16), bf2f(g2.y & 0xffffu), bf2f(g2.y >> 16)};
        const float bn[4] = {bf2f(b2.x & 0xffffu), bf2f(b2.x >> 16), bf2f(b2.y & 0xffffu), bf2f(b2.y >> 16)};
#pragma unroll
        for (int reg = 0; reg < 4; ++reg) {
            const int t = 16 * mt + 4 * g4 + reg; const size_t row = samp ? (size_t)SEQ + 16 * b + t : (size_t)64 * c + t;
            const float y = ((acc[nt][reg] - mean[reg]) * rs[reg] * gain + bias + bn[reg]) * gg[reg];
            YA[row * AW + 64 * h + i] = (bf16_t)f2bf(y);
        }
    }
}

constexpr int AT_KB = 0, AT_VT = 24576, AT_QB = 49152;
constexpr float QSCALE = 0.125f * LOG2E;
DEV void attn_unit(const Params& p, int l, int au, LDSP lds, int tid) {
    const int lane = tid & 63, wave = WAVE_ID(tid), r = lane & 15, g4 = lane >> 4;
    const bool samp = au >= NAP; int c = 0, b = 0, kh, nk, kbase = 0, nq;
    if (!samp) { c = au / BKV; kh = au % BKV; nk = 64 * (c + 1 < 3 ? c + 1 : 3); kbase = 64 * (c > 2 ? c - 2 : 0); nq = 64 * GRP; }
    else { const int s = au - NAP; b = s / BKV; kh = s % BKV; nk = WIN + DECS; nq = DECS * GRP; }
    const float* PF = (const float*)(p.ws + WS_PF); const float* rope = (const float*)(p.ws + WS_ROPE);
    LDSP Kb = lds + AT_KB, Vt = lds + AT_VT, Qb = lds + AT_QB;
    const int sub = tid & 7, rowi = tid >> 3;
    f32x4 K1[3], K2[3], V1[3], V2[3], KC0[3], KC1[3];
#pragma unroll
    for (int pp = 0; pp < 3; ++pp) {
        const int kidx = pp * 64 + rowi;
        if (kidx < nk) {
            if (samp && kidx < WIN) {
                const size_t o = ((((size_t)l * DECB + b) * WIN + kidx) * BKV + kh) * 64; const float* ck = PIN(p, I_CK) + o; const float* cv = PIN(p, I_CV) + o;
                K1[pp] = *(const f32x4*)(ck + 4 * sub); K2[pp] = *(const f32x4*)(ck + 32 + 4 * sub); V1[pp] = *(const f32x4*)(cv + 4 * sub); V2[pp] = *(const f32x4*)(cv + 32 + 4 * sub);
            } else {
                const size_t tok = samp ? (size_t)SEQ + 16 * b + (kidx - WIN) : (size_t)kbase + kidx; const int slot = samp ? SEQ + (kidx - WIN) : (int)tok;
                const float* src = PF + tok * FW;
                K1[pp] = *(const f32x4*)(src + C_BK + 64 * kh + 4 * sub); K2[pp] = *(const f32x4*)(src + C_BK + 64 * kh + 32 + 4 * sub);
                V1[pp] = *(const f32x4*)(src + C_BV + 64 * kh + 4 * sub); V2[pp] = *(const f32x4*)(src + C_BV + 64 * kh + 32 + 4 * sub);
                KC0[pp] = *(const f32x4*)(rope + (size_t)slot * 64 + 8 * sub); KC1[pp] = *(const f32x4*)(rope + (size_t)slot * 64 + 8 * sub + 4);
            }
        }
    }
    f32x4 Q1[GRP], Q2[GRP], QC0[GRP], QC1[GRP];
#pragma unroll
    for (int pp = 0; pp < GRP; ++pp) {
        const int q = pp * 64 + rowi;
        if (q < nq) {
            const int g = samp ? q >> 4 : q >> 6, t = samp ? q & 15 : q & 63, head = kh * GRP + g;
            const size_t tok = samp ? (size_t)SEQ + 16 * b + t : (size_t)64 * c + t; const int slot = samp ? SEQ + t : (int)tok;
            const float* src = PF + tok * FW + C_Q + 64 * head;
            Q1[pp] = *(const f32x4*)(src + 4 * sub); Q2[pp] = *(const f32x4*)(src + 32 + 4 * sub);
            QC0[pp] = *(const f32x4*)(rope + (size_t)slot * 64 + 8 * sub); QC1[pp] = *(const f32x4*)(rope + (size_t)slot * 64 + 8 * sub + 4);
        }
    }
    const f32x4 kg1 = *(const f32x4*)(PIN(p, I_KN) + (size_t)l * 64 + 4 * sub), kg2 = *(const f32x4*)(PIN(p, I_KN) + (size_t)l * 64 + 32 + 4 * sub);
    const f32x4 qg1 = *(const f32x4*)(PIN(p, I_QN) + (size_t)l * 64 + 4 * sub), qg2 = *(const f32x4*)(PIN(p, I_QN) + (size_t)l * 64 + 32 + 4 * sub);
#pragma unroll
    for (int pp = 0; pp < 3; ++pp) {
        const int kidx = pp * 64 + rowi;
        if (kidx < nk) {
            f32x4 k1 = K1[pp], k2 = K2[pp]; const f32x4 v1 = V1[pp], v2 = V2[pp];
            if (!(samp && kidx < WIN)) {
                const size_t tok = samp ? (size_t)SEQ + 16 * b + (kidx - WIN) : (size_t)kbase + kidx;
                const f32x4 x1 = k1, x2 = k2;
                float ss = (x1[0] * x1[0] + x1[1] * x1[1]) + (x1[2] * x1[2] + x1[3] * x1[3]) + (x2[0] * x2[0] + x2[1] * x2[1]) + (x2[2] * x2[2] + x2[3] * x2[3]);
                ss = sum8(ss);
                const float rinv = RSQRTF(ss * (1.0f / 64.0f) + RMS_EPS);
                const float cc[4] = {KC0[pp][0], KC0[pp][2], KC1[pp][0], KC1[pp][2]}, sn[4] = {KC0[pp][1], KC0[pp][3], KC1[pp][1], KC1[pp][3]};
#pragma unroll
                for (int e = 0; e < 4; ++e) { const float y1 = x1[e] * rinv * kg1[e], y2 = x2[e] * rinv * kg2[e]; k1[e] = y1 * cc[e] - y2 * sn[e]; k2[e] = y2 * cc[e] + y1 * sn[e]; }
                if (samp) { const size_t o = ((((size_t)l * DECB + b) * DECS + (kidx - WIN)) * BKV + kh) * 64;
                    *(f32x4*)(p.out + O_SK + o + 4 * sub) = k1; *(f32x4*)(p.out + O_SK + o + 32 + 4 * sub) = k2; *(f32x4*)(p.out + O_SV + o + 4 * sub) = v1; *(f32x4*)(p.out + O_SV + o + 32 + 4 * sub) = v2; }
                else if (kidx >= nk - 64 && tok >= (size_t)(SEQ - WIN)) { const size_t o = (((size_t)l * WIN + (tok - (SEQ - WIN))) * BKV + kh) * 64;
                    *(f32x4*)(p.out + O_PK + o + 4 * sub) = k1; *(f32x4*)(p.out + O_PK + o + 32 + 4 * sub) = k2; *(f32x4*)(p.out + O_PV + o + 4 * sub) = v1; *(f32x4*)(p.out + O_PV + o + 32 + 4 * sub) = v2; }
            }
            u32x2 w; w.x = pk2(k1[0], k1[1]); w.y = pk2(k1[2], k1[3]); *(LAS u32x2*)(Kb + swz(kidx, 4 * sub)) = w;
            w.x = pk2(k2[0], k2[1]); w.y = pk2(k2[2], k2[3]); *(LAS u32x2*)(Kb + swz(kidx, 32 + 4 * sub)) = w;
#pragma unroll
            for (int e = 0; e < 4; ++e) { *(LAS bf16_t*)(Vt + swz192(4 * sub + e, kidx)) = (bf16_t)f2bf(v1[e]); *(LAS bf16_t*)(Vt + swz192(32 + 4 * sub + e, kidx)) = (bf16_t)f2bf(v2[e]); }
        } else if (kidx < ((nk + 31) & ~31)) {
#pragma unroll
            for (int e = 0; e < 4; ++e) { *(LAS bf16_t*)(Vt + swz192(4 * sub + e, kidx)) = 0; *(LAS bf16_t*)(Vt + swz192(32 + 4 * sub + e, kidx)) = 0; }
        }
    }
#pragma unroll
    for (int pp = 0; pp < GRP; ++pp) {
        const int q = pp * 64 + rowi;
        if (q < nq) {
            const f32x4 x1 = Q1[pp], x2 = Q2[pp];
            float ss = (x1[0] * x1[0] + x1[1] * x1[1]) + (x1[2] * x1[2] + x1[3] * x1[3]) + (x2[0] * x2[0] + x2[1] * x2[1]) + (x2[2] * x2[2] + x2[3] * x2[3]);
            ss = sum8(ss);
            const float rinv = RSQRTF(ss * (1.0f / 64.0f) + RMS_EPS) * QSCALE;
            const float cc[4] = {QC0[pp][0], QC0[pp][2], QC1[pp][0], QC1[pp][2]}, sn[4] = {QC0[pp][1], QC0[pp][3], QC1[pp][1], QC1[pp][3]};
            float o1[4], o2[4];
#pragma unroll
            for (int e = 0; e < 4; ++e) { const float y1 = x1[e] * rinv * qg1[e], y2 = x2[e] * rinv * qg2[e]; o1[e] = y1 * cc[e] - y2 * sn[e]; o2[e] = y2 * cc[e] + y1 * sn[e]; }
            u32x2 w; w.x = pk2(o1[0], o1[1]); w.y = pk2(o1[2], o1[3]); *(LAS u32x2*)(Qb + swz(q, 4 * sub)) = w;
            w.x = pk2(o2[0], o2[1]); w.y = pk2(o2[2], o2[3]); *(LAS u32x2*)(Qb + swz(q, 32 + 4 * sub)) = w;
        }
    }
    WG_SYNC();
    const int nqt = nq >> 4, nkt = nk >> 4;
    bf16_t* YB = (bf16_t*)(p.ws + WS_YB);
#pragma unroll 1
    for (int qt = wave; qt < nqt; qt += NWAVES) {
        const int g = samp ? qt : qt >> 2, head = kh * GRP + g;
        const float sink2 = PIN(p, I_SINK)[(size_t)l * BH + head] * LOG2E;
        bf16x8 bq[2];
#pragma unroll
        for (int ks = 0; ks < 2; ++ks) bq[ks] = *(const LAS bf16x8*)(Qb + swz(16 * qt + r, 32 * ks + 8 * g4));
        f32x4 s[12];
#pragma unroll
        for (int kt = 0; kt < 12; ++kt) { s[kt] = (f32x4){0.f, 0.f, 0.f, 0.f};
            if (kt < nkt) {
#pragma unroll
                for (int ks = 0; ks < 2; ++ks) { const bf16x8 a = *(const LAS bf16x8*)(Kb + swz(16 * kt + r, 32 * ks + 8 * g4)); s[kt] = MFMA16(a, bq[ks], s[kt]); } } }
        float mx = sink2;
#pragma unroll
        for (int kt = 0; kt < 12; ++kt) if (kt < nkt) mx = fmaxf(fmaxf(mx, fmaxf(s[kt][0], s[kt][1])), fmaxf(s[kt][2], s[kt][3]));
        mx = fmaxf(mx, SHFL_XOR(mx, 16)); mx = fmaxf(mx, SHFL_XOR(mx, 32));
        float sum = 0.f;
#pragma unroll
        for (int kt = 0; kt < 12; ++kt) if (kt < nkt) {
#pragma unroll
            for (int e = 0; e < 4; ++e) { s[kt][e] = EXP2F(s[kt][e] - mx); sum += s[kt][e]; } }
        sum += SHFL_XOR(sum, 16); sum += SHFL_XOR(sum, 32);
        const float rden = 1.0f / (sum + EXP2F(sink2 - mx));
        f32x4 o[4];
#pragma unroll
        for (int dt = 0; dt < 4; ++dt) o[dt] = (f32x4){0.f, 0.f, 0.f, 0.f};
#pragma unroll
        for (int s2 = 0; s2 < 6; ++s2) if (2 * s2 < nkt) {
            const bf16x8 pb = pack8(s[2 * s2], s[2 * s2 + 1]);
#pragma unroll
            for (int dt = 0; dt < 4; ++dt) {
                const bf16x4 lo = *(const LAS bf16x4*)(Vt + swz192(16 * dt + r, 32 * s2 + 4 * g4)), hi = *(const LAS bf16x4*)(Vt + swz192(16 * dt + r, 32 * s2 + 16 + 4 * g4));
                o[dt] = MFMA16(((bf16x8){lo[0], lo[1], lo[2], lo[3], hi[0], hi[1], hi[2], hi[3]}), pb, o[dt]);
            }
        }
        const int q = 16 * qt + r, t = samp ? q & 15 : q & 63; const size_t tok = samp ? (size_t)SEQ + 16 * b + t : (size_t)64 * c + t;
#pragma unroll
        for (int dt = 0; dt < 4; ++dt) { u32x2 w; w.x = pk2(o[dt][0] * rden, o[dt][1] * rden); w.y = pk2(o[dt][2] * rden, o[dt][3] * rden); *(u32x2*)(YB + tok * BQ + 64 * head + 16 * dt + 4 * g4) = w; }
    }
    WG_SYNC();
}

#ifndef EMU
#define XB_TMO      128
#define XB_XCNT(j)  (256  + 64 * (j))
#define XB_XSUB(j)  (1280 + 64 * (j))
#define XB_XGEN(j)  (2304 + 64 * (j))
#define XB_TOP      3328
#define XB_TOPGEN   3392
#define XCD_BAR_WORDS 3456
#define XB_SPIN_CAP (1u << 18)

__device__ __forceinline__ unsigned xb_ld(unsigned* p)              { return __hip_atomic_load(p, __ATOMIC_RELAXED, __HIP_MEMORY_SCOPE_AGENT); }
__device__ __forceinline__ unsigned xb_add(unsigned* p, unsigned v) { return __hip_atomic_fetch_add(p, v, __ATOMIC_RELAXED, __HIP_MEMORY_SCOPE_AGENT); }
__device__ __forceinline__ unsigned xb_xcc_id() { return (unsigned)__builtin_amdgcn_s_getreg((3 << 11) | 20) & 0xFu; }
#define XB_SPIN(cond, bar) do { unsigned _sp = 0; while (cond) { __builtin_amdgcn_s_sleep(1); \
    if ((++_sp & 255u) == 0u) { if (xb_ld(&(bar)[XB_TMO])) break; if (_sp > XB_SPIN_CAP) { atomicAdd(&(bar)[XB_TMO], 1u); break; } } } } while (0)

struct XcdBarrier {
    unsigned* bar; unsigned x;
    volatile LAS unsigned* st;
};

__device__ __forceinline__ XcdBarrier xcd_barrier_post(unsigned* bar, volatile LAS unsigned* st) {
    XcdBarrier b; b.bar = bar; b.x = xb_xcc_id(); b.st = st;
    if (threadIdx.x == 0) (void)xb_add(&bar[XB_XCNT(b.x)], 1u);
    return b;
}
__device__ __forceinline__ void xcd_barrier_complete(unsigned* bar, unsigned x, unsigned& nloc, unsigned& nx) {
    const unsigned G = gridDim.x * gridDim.y * gridDim.z;
    unsigned sum, cnt, mine, sp = 0u;
    for (;;) {
        sum = 0u; cnt = 0u; mine = 0u;
#pragma unroll
        for (unsigned j = 0; j < 16; ++j) { const unsigned c = xb_ld(&bar[XB_XCNT(j)]); sum += c; cnt += (c > 0u) ? 1u : 0u; mine = (j == x) ? c : mine; }
        if (sum == G) break;
        __builtin_amdgcn_s_sleep(1);
        if ((++sp & 255u) == 0u) { if (xb_ld(&bar[XB_TMO])) break; if (sp > XB_SPIN_CAP) { atomicAdd(&bar[XB_TMO], 1u); break; } }
    }
    nloc = mine > 0u ? mine : 1u; nx = cnt > 0u ? cnt : 1u;
}

__device__ __forceinline__ void xcd_barrier(const XcdBarrier& b) {
    asm volatile("s_waitcnt vmcnt(0)" ::: "memory");
    __syncthreads();
    if (threadIdx.x == 0) {
        unsigned* bar = b.bar;
        __builtin_amdgcn_s_waitcnt(0);
        unsigned nloc = b.st[0], nx = b.st[1];
        if (nloc == 0u) { xcd_barrier_complete(bar, b.x, nloc, nx); b.st[0] = nloc; b.st[1] = nx; }
        const unsigned old = xb_add(&bar[XB_XSUB(b.x)], 1u);
        const unsigned gen = old / nloc;
        if (old + 1u == (gen + 1u) * nloc) {
            __builtin_amdgcn_fence(__ATOMIC_RELEASE, "agent");
            asm volatile("s_waitcnt vmcnt(0)" ::: "memory");
            const unsigned og = xb_add(&bar[XB_TOP], 1u);
            const unsigned tg = og / nx;
            if (og + 1u == (tg + 1u) * nx) xb_add(&bar[XB_TOPGEN], 1u);
            else XB_SPIN(xb_ld(&bar[XB_TOPGEN]) == tg, bar);
            __builtin_amdgcn_fence(__ATOMIC_ACQUIRE, "agent");
            xb_add(&bar[XB_XGEN(b.x)], 1u);
            asm volatile("s_waitcnt vmcnt(0)" ::: "memory");
        } else {
            XB_SPIN(xb_ld(&bar[XB_XGEN(b.x)]) == gen, bar);
            __builtin_amdgcn_fence(__ATOMIC_ACQUIRE, "agent");
            asm volatile("s_waitcnt vmcnt(0)" ::: "memory");
        }
    }
    __syncthreads();
}
#endif

#ifndef REP_GU
#define REP_GU 1
#endif
#ifndef REP_DOWN
#define REP_DOWN 1
#endif
#ifndef REP_WIN
#define REP_WIN 1
#endif
#ifndef REP_UP
#define REP_UP 1
#endif
#ifndef REP_WO
#define REP_WO 1
#endif
#ifndef CONV_N_GU
#define CONV_N_GU 0
#endif
#ifndef CONV_N_WIN
#define CONV_N_WIN 0
#endif
#ifndef CONV_N_R2
#define CONV_N_R2 10
#endif
#ifndef REP_PRO
#define REP_PRO 1
#endif
#ifndef REP_NORM
#define REP_NORM 1
#endif
#ifndef REP_R1
#define REP_R1 1
#endif
#ifndef REP_R2
#define REP_R2 1
#endif
#ifndef REP_R3
#define REP_R3 1
#endif

#ifndef EMU
#define GRID_BAR() do { XcdBarrier b_; b_.bar = (unsigned*)(P_WS() + WS_CTL) + CW_BAR; b_.x = xb_xcc_id(); b_.st = (volatile LAS unsigned*)(lds + LDS_CTL_OFF + 32); xcd_barrier(b_); } while (0)
constexpr int CW_BAR = 4096;
__global__ void __launch_bounds__(NTHR, 2) fwd(Params p) {
    extern __shared__ __attribute__((aligned(16))) unsigned char lds_raw[];
    LDSP lds = (LDSP)lds_raw;
    const int wave = __builtin_amdgcn_readfirstlane(TID() >> 6), G = GRID(), bid = BID();
    for (int u = TID(); u < (LDS_BYTES - LDS_CTL_OFF) / 4; u += NTHR) ((LAS unsigned*)(lds + LDS_CTL_OFF))[u] = 0u;
    __syncthreads();
    (void)xcd_barrier_post((unsigned*)(p.ws + WS_CTL) + CW_BAR, (volatile LAS unsigned*)(lds + LDS_CTL_OFF + 32));
#else
#define GRID_BAR() emu_grid_sync()
static void fwd(Params p) {
    g_emu_params = p;
    LDSP lds = emu_lds();
    const int wave = TID() >> 6, G = GRID(), bid = BID();
#endif
    const int gw = bid * NWAVES + wave, NGW = G * NWAVES, NGT = G * NTHR;
#define LANE_TID() const int lane = FRESH_LANE(), tid = wave * 64 + lane; (void)tid
    bf16_t* XB = (bf16_t*)(p.ws + WS_H);


#ifndef SKIP_PRO
    for (int rep_ = 0; rep_ < REP_PRO; ++rep_) { LANE_TID(); prologue(p, lds, gw, NGW, wave, lane, bid * NTHR + tid, NGT); x0_phase(p, gw, NGW, lane, bid * NTHR + tid, NGT); if (rep_ + 1 < REP_PRO) GRID_BAR(); }
    GRID_BAR();
#endif

#pragma unroll 1
    for (int it = 0; it < 2 * DEPTH; ++it) {
        const int l = it >> 1; const bool sec = (it & 1) != 0;
        const int Gq_ = OPAQUE_S(G), bq_ = OPAQUE_S(bid);
        const int nsi = 3 * l + (sec ? 2 : 0);

for (int rep_ = 0; rep_ < REP_GU; ++rep_) {
#ifndef SKIP_GU
        { pg8::Gemm g{XB, lwp(p, l, sec ? OFF_WGU2 : OFF_WGU1), M, 2 * DFF, DM}; pg8::StaticOrder S; S.init(M, 2 * DFF, Gq_, bq_);
          { LANE_TID(); rinv_table(S, nsi, lds, tid); }
          EpiSwiglu E{lds + LDS_RINV_OFF};
          pg8::gemm_phase<EpiSwiglu, pg8::StaticOrder, true, true>(lds, g, S, E, wave); }
#endif

        GRID_BAR(); }

for (int rep_ = 0; rep_ < REP_DOWN; ++rep_) {
#ifndef SKIP_DOWN
        { pg8::Gemm g{(const bf16_t*)(p.ws + WS_G), lwp(p, l, sec ? OFF_WD2 : OFF_WD1), SEQ, DM, DFF}; pg8::StaticOrder S; S.init(SEQ, DM, Gq_, bq_);
          EpiResid E{0.5f / REP_DOWN, nsi + 1};
#pragma unroll 1
          for (int step = 0; step < 2; ++step) {
              if (((step ^ bid) & 1) == 0) pg8::gemm_phase<EpiResid, pg8::StaticOrder, true, true>(lds, g, S, E, wave);
              else {
#pragma unroll 1
                  for (int tile = bid; tile < (MS / 64) * (DM / 64); tile += G) { LANE_TID(); sgemm_tile(g.A, g.Bt, DFF, SEQ + 64 * (tile % (MS / 64)), 64 * (tile / (MS / 64)), lds, tid, E); } } } }
#endif
        if (rep_ + 1 < REP_DOWN) GRID_BAR(); }

        if (it == 2 * DEPTH - 1) break;
        GRID_BAR();
        if (!sec) {


for (int rep_ = 0; rep_ < REP_WIN; ++rep_) {
#ifndef SKIP_WIN
            { pg8::Gemm g{XB, lwp(p, l, OFF_WIN), M, NIN, DM}; pg8::StaticOrder S; S.init(M, NIN, Gq_, bq_);
              { LANE_TID(); rinv_table(S, 3 * l + 1, lds, tid); }
              EpiWin E{lds + LDS_RINV_OFF};
              pg8::gemm_phase<EpiWin, pg8::StaticOrder, true, true>(lds, g, S, E, wave); }
#endif

            GRID_BAR(); }

            for (int rep_ = 0; rep_ < REP_R1; ++rep_) {
#ifndef SKIP_R1
#pragma unroll 1
            for (int u = bid; u < NU; u += G) { LANE_TID(); r1_unit(p, l, u, lds, tid); }
#endif

            GRID_BAR(); }

            for (int rep_ = 0; rep_ < REP_R2; ++rep_) {
#ifndef SKIP_R2
            { constexpr int nchain = 4 * AH; LANE_TID();
              int a0, as_;
              if (G > nchain) {
                  if (bid < nchain) { r2_chain_ring(p, l, bid, lds, wave, lane); a0 = 1 << 20; as_ = 1; }
                  else { a0 = bid - nchain; as_ = G - nchain; }
              } else {
#pragma unroll 1
                  for (int task = bid; task < nchain; task += G) r2_chain_ring(p, l, task, lds, wave, lane);
                  WG_SYNC();
                  a0 = bid; as_ = G;
              }
#pragma unroll 1
              for (int au = a0; au < NA; au += as_) attn_unit(p, l, au, lds, tid);
#pragma unroll 1
              for (int task = a0 * NWAVES + wave; task < 4 * NUS; task += as_ * NWAVES) r2_sample(p, l, task, lane);
            }
#endif

            GRID_BAR(); }

            for (int rep_ = 0; rep_ < REP_R3; ++rep_) {
#ifndef SKIP_R3
            { const int worker = bid * 2 + (wave >> 2), NW = 2 * G; LANE_TID(); const int gtid = bid * NTHR + tid;
#pragma unroll 1
              for (int u = worker; u < NU; u += NW) r3_work(p, l, u, wave & 3, lane);
              const float* PF = (const float*)(p.ws + WS_PF);
              for (int idx = gtid; idx < (1 + DECB) * ACOLS; idx += NGT) { const int s = idx / ACOLS, col = idx % ACOLS;
                  if (s == 0) p.out[O_PSH + (size_t)l * ACOLS + col] = PF[(size_t)(SEQ - 1) * FW + col];
                  else p.out[O_SSH + ((size_t)l * DECB + (s - 1)) * ACOLS + col] = PF[((size_t)SEQ + 16 * (s - 1) + 15) * FW + col]; } }
#endif

            GRID_BAR(); }

for (int rep_ = 0; rep_ < REP_UP; ++rep_) {
#ifndef SKIP_UPA
            { pg8::Gemm g{(const bf16_t*)(p.ws + WS_YA), lwp(p, l, OFF_WUA), SEQ, DM, AW}; pg8::StaticOrder S; S.init(SEQ, DM, Gq_, bq_);
              EpiUpA E{0};
              pg8::gemm_phase<EpiUpA, pg8::StaticOrder, true, true>(lds, g, S, E, wave);
#pragma unroll 1
          for (int tile = bid; tile < (MS / 64) * (DM / 64); tile += G) { LANE_TID(); sgemm_tile(g.A, g.Bt, AW, SEQ + 64 * (tile % (MS / 64)), 64 * (tile / (MS / 64)), lds, tid, E); } }
#endif


#ifndef SKIP_UPB
            { pg8::Gemm g{(const bf16_t*)(p.ws + WS_YB), lwp(p, l, OFF_WUB), SEQ, DM, BQ}; pg8::StaticOrder S; S.init(SEQ, DM, Gq_, bq_);
              EpiUpB E{0};
              pg8::gemm_phase<EpiUpB, pg8::StaticOrder, true, true>(lds, g, S, E, wave);
#pragma unroll 1
          for (int tile = bid; tile < (MS / 64) * (DM / 64); tile += G) { LANE_TID(); sgemm_tile(g.A, g.Bt, BQ, SEQ + 64 * (tile % (MS / 64)), 64 * (tile / (MS / 64)), lds, tid, E); } }
#endif

            GRID_BAR(); }
for (int rep_ = 0; rep_ < REP_WO; ++rep_) {
#ifndef SKIP_WO
            { pg8::Gemm g{(const bf16_t*)(p.ws + WS_MG), lwp(p, l, OFF_WO), SEQ, DM, DM}; pg8::StaticOrder S; S.init(SEQ, DM, Gq_, bq_);
              EpiResid E{1.0f / REP_WO, 3 * l + 2};
              pg8::gemm_phase<EpiResid, pg8::StaticOrder, true, true>(lds, g, S, E, wave);
#pragma unroll 1
          for (int tile = bid; tile < (MS / 64) * (DM / 64); tile += G) { LANE_TID(); sgemm_tile(g.A, g.Bt, DM, SEQ + 64 * (tile % (MS / 64)), 64 * (tile / (MS / 64)), lds, tid, E); } }
#endif

            GRID_BAR(); }
        }
    }
}

#ifndef EMU
extern "C" void kernel_launch(void* const* d_in, const int* in_sizes, int n_in, void* d_out, int out_size, void* d_ws, size_t ws_size, hipStream_t stream) {
    static int grid = 0;
    if (grid == 0) {
        if (n_in != 33 || (size_t)out_size != O_END || ws_size < WS_END) { fprintf(stderr, "kernel_launch: unexpected shapes (n_in %d, out %d, ws %zu, need %zu)\n", n_in, out_size, ws_size, (size_t)WS_END); grid = -1; return; }
        int dev = 0, cus = 0, per_cu = 0;
        if (hipGetDevice(&dev) != hipSuccess || hipDeviceGetAttribute(&cus, hipDeviceAttributeMultiprocessorCount, dev) != hipSuccess) { grid = -1; return; }
        if (hipFuncSetAttribute((const void*)fwd, hipFuncAttributeMaxDynamicSharedMemorySize, LDS_BYTES) != hipSuccess) { fprintf(stderr, "kernel_launch: hipFuncSetAttribute failed\n"); grid = -1; return; }
        if (hipOccupancyMaxActiveBlocksPerMultiprocessor(&per_cu, (const void*)fwd, NTHR, LDS_BYTES) != hipSuccess || per_cu < 1) fprintf(stderr, "kernel_launch: occupancy query reports %d\n", per_cu);
        (void)hipGetLastError();
        grid = cus;
    }
    if (grid < 0) return;
    if (hipMemsetAsync((char*)d_ws + WS_CTL, 0, CTL_BYTES, stream) != hipSuccess) return;
    Params p{};
    for (int i = 0; i < 33; ++i) p.in[i] = (const float*)d_in[i];
    p.out = (float*)d_out; p.ws = (unsigned char*)d_ws;
    hipLaunchKernelGGL(fwd, dim3(grid), dim3(NTHR), LDS_BYTES, stream, p);
}
#endif
```

```cpp
#ifndef EMU
#include <hip/hip_runtime.h>
#include <cstdio>
#include <cstdint>
#endif

#ifndef CFG_SMALL
constexpr int DM = 2048, SEQ = 8192, DEPTH = 4, DECB = 32, DECS = 16, PAST = 1024, AW = 1024, BH = 16, BKV = 4, DFF = 5504;
#else
constexpr int DM = 256, SEQ = 256, DEPTH = 2, DECB = 16, DECS = 16, PAST = 1024, AW = 128, BH = 4, BKV = 1, DFF = 384;
#endif
constexpr int HD = 64, AH = AW / HD, DLORA = 64, ILORA = 64, GLORA = 160, WIN = 128, GRP = BH / BKV;
constexpr int ACOLS = 3 * AW + DLORA + ILORA + GLORA, BQ = BH * HD, BKVW = BKV * HD, INCOLS = ACOLS + BQ + 2 * BKVW + 2 * DM;
constexpr int MS = DECB * DECS, M = SEQ + MS;
constexpr int FW_RAW = ACOLS + BQ + 2 * BKVW, FW = ((FW_RAW + 255) / 256) * 256, NIN = FW + 2 * DM;
constexpr int C_R = 0, C_WLO = AW, C_K = AW + DLORA, C_V = 2 * AW + DLORA, C_ALO = 3 * AW + DLORA, C_GLO = C_ALO + ILORA, C_Q = ACOLS, C_BK = ACOLS + BQ, C_BV = C_BK + BKVW;
constexpr int NCH = SEQ / 64, NUP = NCH * AH, NUS = DECB * AH, NU = NUP + NUS;
constexpr int NAP = NCH * BKV, NAS = DECB * BKV, NA = NAP + NAS;
constexpr float RMS_EPS = 1e-6f, GN_EPS = 64e-5f, LOG2E = 1.4426950408889634f;
static_assert(M % 256 == 0 && DM % 256 == 0 && DFF % 128 == 0 && AW % 128 == 0 && BQ % 128 == 0 && FW_RAW % 32 == 0 && DECS == 16 && GRP == 4, "shape constraints");

constexpr size_t O_YP = 0, O_YS = (size_t)SEQ * DM, O_PWKV = O_YS + (size_t)MS * DM, O_PSH = O_PWKV + (size_t)DEPTH * AH * 4096, O_PK = O_PSH + (size_t)DEPTH * ACOLS,
                 O_PV = O_PK + (size_t)DEPTH * WIN * BKVW, O_SWKV = O_PV + (size_t)DEPTH * WIN * BKVW, O_SSH = O_SWKV + (size_t)DEPTH * DECB * AH * 4096,
                 O_SK = O_SSH + (size_t)DEPTH * DECB * ACOLS, O_SV = O_SK + (size_t)DEPTH * DECB * DECS * BKVW, O_END = O_SV + (size_t)DEPTH * DECB * DECS * BKVW;

constexpr size_t al256(size_t x) { return (x + 255) & ~(size_t)255; }
constexpr size_t WS_CTL = 0, CTL_BYTES = 1u << 20;
constexpr size_t WS_ROPE = CTL_BYTES, ROPE_BYTES = al256((size_t)(SEQ + DECS) * 64 * 4);
constexpr int NSS = 3 * DEPTH + 1;
constexpr int NSLOT = DM / 32;
constexpr size_t WS_SS = WS_ROPE + ROPE_BYTES, SS_BYTES = al256((size_t)NSS * NSLOT * M * 4);
static_assert(NSLOT <= 64, "slots written one per lane");
constexpr size_t WS_W = WS_SS + SS_BYTES;
constexpr size_t SZ_WGU = (size_t)2 * DFF * DM * 2, SZ_WD = (size_t)DM * DFF * 2, SZ_WIN = (size_t)NIN * DM * 2, SZ_WUA = (size_t)DM * AW * 2, SZ_WUB = (size_t)DM * BQ * 2, SZ_WO = (size_t)DM * DM * 2;
constexpr size_t OFF_WGU1 = 0, OFF_WD1 = OFF_WGU1 + SZ_WGU, OFF_WIN = OFF_WD1 + SZ_WD, OFF_WUA = OFF_WIN + SZ_WIN, OFF_WUB = OFF_WUA + SZ_WUA, OFF_WO = OFF_WUB + SZ_WUB,
                 OFF_WGU2 = OFF_WO + SZ_WO, OFF_WD2 = OFF_WGU2 + SZ_WGU, OFF_DW2T = OFF_WD2 + SZ_WD, OFF_IA2T = OFF_DW2T + (size_t)AW * 64 * 2, OFF_GG2T = OFF_IA2T + (size_t)AW * 64 * 2,
                 LAYER_W_BYTES = al256(OFF_GG2T + (size_t)AW * 160 * 2);
constexpr size_t WS_H = WS_W + (size_t)DEPTH * LAYER_W_BYTES;
constexpr size_t WS_PF = WS_H + al256((size_t)M * DM * 2);
constexpr size_t WS_SG = WS_PF + al256((size_t)M * FW * 4);
constexpr size_t WS_YA = WS_SG + al256((size_t)M * 2 * DM * 2);
constexpr size_t WS_YB = WS_YA + al256((size_t)M * AW * 2);
constexpr size_t WS_MG = WS_YB + al256((size_t)M * BQ * 2);
constexpr size_t WS_OV = WS_MG + al256((size_t)M * DM * 2);
constexpr size_t WS_G = WS_OV;
constexpr size_t WS_T1 = WS_OV;
constexpr size_t WS_PCT = WS_T1 + al256((size_t)M * DM * 4);
constexpr size_t WS_UCS = WS_PCT + (size_t)NU * 8192;
constexpr size_t WS_QTT = WS_UCS + (size_t)NU * 16384;
constexpr size_t WS_YLT = WS_QTT + (size_t)NU * 8192;
constexpr size_t WS_GT = WS_YLT + (size_t)NU * 16384;
constexpr size_t WS_BNT = WS_GT + (size_t)NU * 8192;
constexpr size_t WS_SC = WS_BNT + (size_t)NU * 8192;
constexpr size_t WS_LACT = WS_SC + (size_t)NUP * 8192;
constexpr size_t WS_OV_END_A = WS_LACT + al256((size_t)M * 288 * 2), WS_OV_END_B = WS_G + al256((size_t)M * DFF * 2);
constexpr size_t WS_END = WS_OV_END_A > WS_OV_END_B ? WS_OV_END_A : WS_OV_END_B;

constexpr int LDS_BYTES = 159744;
constexpr int LDS_CTL_OFF = LDS_BYTES - 1024;
constexpr int NWAVES = 8, NTHR = 512;
constexpr int CW_CONV = 8192;
constexpr int LDS_RINV_OFF = 131072;
static_assert(LDS_RINV_OFF + 8 * 1024 <= LDS_CTL_OFF, "rinv tables");

typedef unsigned short bf16_t;
typedef short bf16x8 __attribute__((ext_vector_type(8)));
typedef short bf16x4 __attribute__((ext_vector_type(4)));
typedef float f32x4 __attribute__((ext_vector_type(4)));
typedef unsigned u32x4 __attribute__((ext_vector_type(4)));
typedef unsigned u32x2 __attribute__((ext_vector_type(2)));
#ifdef EMU
#define LAS
#define TID() emu_tid()
#define BID() emu_bid()
#define GRID() emu_grid()
#define WG_SYNC() emu_wg_sync()
#define MFMA16(a, b, c) emu_mfma16(a, b, c)
#define SHFL_XOR(v, m) emu_shfl_xor(v, m)
#define DEV static inline
#define DEVM inline
#define EXP2F(x) exp2f(x)
#define RSQRTF(x) (1.0f / sqrtf(x))
#define WAVE_FENCE() emu_wave_sync()
#define WAVE_ID(t) ((t) >> 6)
#define PIN(p, i) ((p).in[i])
#define P_WS() (g_emu_params.ws)
#define P_OUT() (g_emu_params.out)
#define FRESH_LANE() (emu_tid() & 63)
#define SPIN_WAIT() emu_yield()
#define WG_SYNC_LDS() emu_wg_sync()
#define OPAQUE_S(x) (x)
static inline int claim_item(unsigned* ctr, unsigned inc, int lane) { (void)lane;
    static unsigned emu_last[1 << 16]; const int key = (emu_bid() * 8 + (emu_tid() >> 6)) & 0xffff; if ((emu_tid() & 63) == 0) { emu_last[key] = *ctr; *ctr += inc; } emu_wave_sync(); const unsigned v = emu_last[key]; emu_wave_sync(); return (int)v; }
#define ATOMIC_ADD_U64(ptr, v) (*(ptr) += (v))
#define RCPF(x) (1.0f / (x))
#define LOG2F_(x) log2f(x)
static inline float sum8(float v) { v += emu_shfl_xor(v, 1); v += emu_shfl_xor(v, 2); v += emu_shfl_xor(v, 4); return v; }
static inline float sum16(float v) { v = sum8(v); v += emu_shfl_xor(v, 8); return v; }
static inline float sum64(float v) { v = sum16(v); v += emu_shfl_xor(v, 16); v += emu_shfl_xor(v, 32); return v; }
#define LDS_DRAIN() do { } while (0)
#define COMPILER_FENCE() do { } while (0)
#else
#define LAS __attribute__((address_space(3)))
#define TID() ((int)threadIdx.x)
#define BID() ((int)blockIdx.x)
#define GRID() ((int)gridDim.x)
#define WG_SYNC() __syncthreads()
#define MFMA16(a, b, c) __builtin_amdgcn_mfma_f32_16x16x32_bf16(a, b, c, 0, 0, 0)
#define SHFL_XOR(v, m) __shfl_xor(v, m)
#define DEV __device__ __forceinline__
#define DEVM __device__ __forceinline__
#define EXP2F(x) __builtin_amdgcn_exp2f(x)
#define RSQRTF(x) (1.0f / sqrtf(x))
#define WAVE_FENCE() asm volatile("s_waitcnt lgkmcnt(0)" ::: "memory")
#define WAVE_ID(t) __builtin_amdgcn_readfirstlane((t) >> 6)
#define PIN(p, i) pin_load(i)
#define P_WS() ((unsigned char*)pin_load(34))
#define P_OUT() ((float*)pin_load(33))
#define FRESH_LANE() fresh_lane()
#define SPIN_WAIT() __builtin_amdgcn_s_sleep(1)
#define WG_SYNC_LDS() asm volatile("s_waitcnt lgkmcnt(0)\n\ts_barrier" ::: "memory")
__device__ __forceinline__ int opaque_s(int x) { asm volatile("" : "+s"(x)); return x; }
#define OPAQUE_S(x) opaque_s(x)
__device__ __forceinline__ int claim_item(unsigned* ctr, unsigned inc, int lane) { unsigned v = 0; if (lane == 0) v = __hip_atomic_fetch_add((__attribute__((address_space(1))) unsigned*)ctr, inc, __ATOMIC_RELAXED, __HIP_MEMORY_SCOPE_AGENT); return __builtin_amdgcn_readfirstlane(v); }
#define ATOMIC_ADD_U64(ptr, v) ((void)__hip_atomic_fetch_add((__attribute__((address_space(1))) unsigned long long*)(ptr), (v), __ATOMIC_RELAXED, __HIP_MEMORY_SCOPE_AGENT))
#define RCPF(x) __builtin_amdgcn_rcpf(x)
#define LOG2F_(x) __builtin_amdgcn_logf(x)
__device__ __forceinline__ float dpp_add(float v, const int ctrl_sel) {
    const int x = __builtin_bit_cast(int, v); int y;
    if (ctrl_sel == 0) y = __builtin_amdgcn_update_dpp(0, x, 0xB1, 0xF, 0xF, false); else if (ctrl_sel == 1) y = __builtin_amdgcn_update_dpp(0, x, 0x4E, 0xF, 0xF, false);
    else if (ctrl_sel == 2) y = __builtin_amdgcn_update_dpp(0, x, 0x141, 0xF, 0xF, false); else y = __builtin_amdgcn_update_dpp(0, x, 0x140, 0xF, 0xF, false);
    return v + __builtin_bit_cast(float, y);
}
__device__ __forceinline__ float sum8(float v) { v = dpp_add(v, 0); v = dpp_add(v, 1); v = dpp_add(v, 2); return v; }
__device__ __forceinline__ float sum16(float v) { v = sum8(v); v = dpp_add(v, 3); return v; }
__device__ __forceinline__ float sum64(float v) { v = sum16(v); v += __shfl_xor(v, 16); v += __shfl_xor(v, 32); return v; }
#define LDS_DRAIN() asm volatile("s_waitcnt lgkmcnt(0)" ::: "memory")
#define COMPILER_FENCE() asm volatile("" ::: "memory")
__device__ __forceinline__ int fresh_lane() { int l; asm volatile("v_mbcnt_lo_u32_b32 %0, -1, 0\n\tv_mbcnt_hi_u32_b32 %0, -1, %0" : "=v"(l)); return l; }
#endif
typedef LAS unsigned char* LDSP;
typedef unsigned long long ssq_t;
constexpr float SSQ_SCALE = 1048576.0f, SSQ_INV = 1.0f / 1048576.0f;
constexpr double TWO_PI = 6.283185307179586476925286766559;
#ifdef EMU
static const double ROPE_INV[32] = {1.0, 0.7498942093324559, 0.5623413251903491, 0.4216965034285822, 0.31622776601683794, 0.23713737056616552, 0.1778279410038923, 0.1333521432163324, 0.1, 0.07498942093324558, 0.05623413251903491, 0.042169650342858224, 0.03162277660168379, 0.023713737056616554, 0.01778279410038923, 0.01333521432163324, 0.01, 0.007498942093324558, 0.005623413251903491, 0.004216965034285823, 0.0031622776601683794, 0.0023713737056616554, 0.0017782794100389228, 0.001333521432163324, 0.001, 0.0007498942093324559, 0.0005623413251903491, 0.00042169650342858224, 0.00031622776601683794, 0.00023713737056616554, 0.00017782794100389227, 0.0001333521432163324};
#else
__device__ const double ROPE_INV[32] = {1.0, 0.7498942093324559, 0.5623413251903491, 0.4216965034285822, 0.31622776601683794, 0.23713737056616552, 0.1778279410038923, 0.1333521432163324, 0.1, 0.07498942093324558, 0.05623413251903491, 0.042169650342858224, 0.03162277660168379, 0.023713737056616554, 0.01778279410038923, 0.01333521432163324, 0.01, 0.007498942093324558, 0.005623413251903491, 0.004216965034285823, 0.0031622776601683794, 0.0023713737056616554, 0.0017782794100389228, 0.001333521432163324, 0.001, 0.0007498942093324559, 0.0005623413251903491, 0.00042169650342858224, 0.00031622776601683794, 0.00023713737056616554, 0.00017782794100389227, 0.0001333521432163324};
#endif

struct Params { const float* in[33]; float* out; unsigned char* ws; };
#ifdef EMU
static Params g_emu_params;
#endif
#ifndef EMU
__device__ __forceinline__ const float* pin_load(int i) {
    const __attribute__((address_space(4))) char* k = (const __attribute__((address_space(4))) char*)__builtin_amdgcn_kernarg_segment_ptr();
    asm volatile("" : "+s"(k));
    return *(const float* const __attribute__((address_space(4)))*)(k + 8 * i);
}
#endif
enum { I_XP = 0, I_XS, I_CK, I_CV, I_SWKV, I_SSH, I_NFF1, I_F1G, I_F1U, I_F1D, I_NMIX, I_WIN, I_MU, I_DW0, I_DW2, I_IA0, I_IA2, I_GG2, I_KK, I_KA, I_RK, I_GNG, I_GNB, I_QN, I_KN, I_SINK,
       I_WUA, I_WUB, I_WO, I_NFF2, I_F2G, I_F2U, I_F2D };

#ifdef EMU
DEV unsigned f2bf(float f) { unsigned u = __builtin_bit_cast(unsigned, f); return (u + 0x7fffu + ((u >> 16) & 1u)) >> 16; }
DEV unsigned pk2(float lo, float hi) { return f2bf(lo) | (f2bf(hi) << 16); }
#else
typedef float f32x2_t_ __attribute__((ext_vector_type(2))); typedef __bf16 bf16x2_t_ __attribute__((ext_vector_type(2)));
DEV unsigned pk2(float lo, float hi) { f32x2_t_ v = {lo, hi}; bf16x2_t_ b = __builtin_convertvector(v, bf16x2_t_); return __builtin_bit_cast(unsigned, b); }
DEV unsigned f2bf(float f) { return pk2(f, 0.f) & 0xffffu; }
#endif
DEV float bf2f(unsigned h) { return __builtin_bit_cast(float, h << 16); }
DEV bf16_t* lwp(const Params& p, int l, size_t off) { return (bf16_t*)(p.ws + WS_W + (size_t)l * LAYER_W_BYTES + off); }
DEV float wave_sum(float v) { return sum64(v); }
DEV float sigmoidf_(float x) { return RCPF(1.0f + EXP2F(-x * LOG2E)); }
DEV float tanhf_(float x) { return 1.0f - 2.0f * RCPF(1.0f + EXP2F(x * (2.0f * LOG2E))); }
DEV float expf_(float x) { return EXP2F(x * LOG2E); }
DEV float softplusf_(float z) { return fmaxf(z, 0.f) + LOG2F_(1.0f + EXP2F(-fabsf(z) * LOG2E)) * 0.6931471805599453f; }
DEV int swz(int row, int col) { return row * 128 + ((((col >> 3) ^ row) & 7) << 4) + ((col & 7) << 1); }
DEV int swz192(int row, int col) { const int ch = col >> 3; return row * 384 + (((ch & ~7) | ((ch ^ row) & 7)) << 4) + ((col & 7) << 1); }
DEV f32x4 mm64(LDSP A, int m0, LDSP B, int n0, f32x4 acc, int lane) {
    const int r = lane & 15, g4 = lane >> 4;
#pragma unroll
    for (int ks = 0; ks < 2; ++ks) {
        const bf16x8 a = *(const LAS bf16x8*)(A + swz(m0 + r, 32 * ks + 8 * g4));
        const bf16x8 b = *(const LAS bf16x8*)(B + swz(n0 + r, 32 * ks + 8 * g4));
        acc = MFMA16(a, b, acc);
    }
    return acc;
}
DEV void st_tile(LDSP O, int m0, int n0, f32x4 v, int lane) {
    const int r = lane & 15, g4 = lane >> 4;
#pragma unroll
    for (int reg = 0; reg < 4; ++reg) *(LAS bf16_t*)(O + swz(m0 + 4 * g4 + reg, n0 + r)) = (bf16_t)f2bf(v[reg]);
}
DEV void st_tile_T(LDSP O, int m0, int n0, f32x4 v, int lane) {
    const int r = lane & 15, g4 = lane >> 4;
    u32x2 w; w.x = pk2(v[0], v[1]); w.y = pk2(v[2], v[3]);
    *(LAS u32x2*)(O + swz(n0 + r, m0 + 4 * g4)) = w;
}
DEV bf16x8 pack8(f32x4 lo, f32x4 hi) {
    u32x4 w; w.x = pk2(lo[0], lo[1]); w.y = pk2(lo[2], lo[3]); w.z = pk2(hi[0], hi[1]); w.w = pk2(hi[2], hi[3]);
    return __builtin_bit_cast(bf16x8, w);
}

namespace pg8 {
#define PG8_LAS __attribute__((address_space(3)))
typedef unsigned short bf16_t;
typedef short bf16x8 __attribute__((ext_vector_type(8)));
typedef float f32x4 __attribute__((ext_vector_type(4)));
typedef unsigned u32x4 __attribute__((ext_vector_type(4)));
constexpr int BM = 256, BK = 64, HALF = 128, HTB = HALF * BK * 2  , STAGE_BYTES = 8 * HTB, NXCD = 8, WGM = 8;

__host__ __device__ __forceinline__ int lds_byte(int r, int c) { const int st = (r >> 4) * 2 + (c >> 5), rr = r & 15, cc = c & 31, ob = rr * 64 + cc * 2; return st * 1024 + (ob ^ (((ob >> 9) & 1) << 5)); }
__host__ __device__ __forceinline__ void stage_rc(int b, int& R, int& C) { const int st = b / 1024, sb = b % 1024, swz = sb ^ (((sb >> 9) & 1) << 5); R = (st >> 1) * 16 + swz / 64; C = (st & 1) * 32 + (swz % 64) / 2; }
__host__ __device__ __forceinline__ int perm32(int rho) { const int n = rho >> 4, i = rho & 15; return 8 * (i >> 2) + 4 * n + (i & 3); }

struct Unit { int pm, pn, idx; };
struct Gemm { const bf16_t* A; const bf16_t* Bt; int M, N, K; };

struct StaticOrder {
    int nM, nN, nwg, G, c;
    __host__ __device__ void init(int M, int N, int G_, int c_) { nM = M / BM; nN = N / BM; nwg = nM * nN; G = G_; c = c_; }
    __host__ __device__ bool next(int i, Unit& u) const {
        const long L = (long)i * G + c; if (L >= nwg) return false;
        int wgid = (int)L; { const int q = nwg / NXCD, r = nwg % NXCD, xcd = wgid % NXCD, off = wgid / NXCD; wgid = (xcd < r ? xcd * (q + 1) : r * (q + 1) + (xcd - r) * q) + off; }
        const int nig = WGM * nN, gid = wgid / nig, fm = gid * WGM, gsz = (nM - fm) < WGM ? (nM - fm) : WGM;
        u.pm = fm + ((wgid % nig) % gsz); u.pn = (wgid % nig) / gsz; u.idx = i; return true;
    }
    __device__ __forceinline__ void a_ready(const Unit&) const {}
    __device__ __forceinline__ void done(const Unit&) const {}
};

#ifndef EMU
template <class Epi, class Sched, bool ALIGN_EPI = false, bool SP2 = false>
__device__ __forceinline__ void gemm_phase(PG8_LAS unsigned char* lds, const Gemm g, const Sched& S, const Epi& E, const int wid) {
    const int lane = ::fresh_lane(), tid = wid * 64 + lane, wr = wid >> 2, wc = wid & 3, fr = lane & 15, fq = lane >> 4;
    const int K = g.K, nt = K / BK;
    unsigned voffA[2], voffB[2];
#pragma unroll
    for (int i = 0; i < 2; ++i) { int R, C; stage_rc(tid * 16 + i * 8192, R, C); const int Rb = Epi::PERM ? ((R & ~31) + perm32(R & 31)) : R;
        voffA[i] = (unsigned)(R * K + C) * 2u; voffB[i] = (unsigned)(Rb * K + C) * 2u; }
    const size_t kstep = (size_t)(BK * 2);
    const size_t hstep = (size_t)HALF * K * 2;
    const size_t tstep = 2 * hstep;
    const unsigned ldsw = (unsigned)wid * 1024u;
    const int aoff = lds_byte(wr * 64 + fr, fq * 8), boff = lds_byte(wc * 32 + fr, fq * 8);
#define PG8_SA(b, h) (((b) * 2 + (h)) * HTB)
#define PG8_SB(b, h) ((4 + (b) * 2 + (h)) * HTB)
#define PG8_STAGE(bufoff, gbase, voff) do { _Pragma("unroll") for (int _i = 0; _i < 2; ++_i) \
        __builtin_amdgcn_global_load_lds((const unsigned*)((const char*)(gbase) + (voff)[_i]), (PG8_LAS unsigned*)(lds + (bufoff) + ldsw + _i * 8192), 16, 0, 0); } while (0)
#define PG8_LDA(dst, b, h) do { _Pragma("unroll") for (int m = 0; m < 4; ++m) _Pragma("unroll") for (int k = 0; k < 2; ++k) dst[m][k] = *(const PG8_LAS bf16x8*)(lds + PG8_SA(b, h) + aoff + m * 2048 + k * 1024); } while (0)
#define PG8_LDB(dst, b, h) do { _Pragma("unroll") for (int n = 0; n < 2; ++n) _Pragma("unroll") for (int k = 0; k < 2; ++k) dst[n][k] = *(const PG8_LAS bf16x8*)(lds + PG8_SB(b, h) + boff + n * 2048 + k * 1024); } while (0)
#define PG8_MMA(ai, bj, At, Bt) do { __builtin_amdgcn_s_setprio(1); _Pragma("unroll") for (int m = 0; m < 4; ++m) _Pragma("unroll") for (int n = 0; n < 2; ++n) _Pragma("unroll") for (int k = 0; k < 2; ++k) \
        acc[ai][bj][m][n] = __builtin_amdgcn_mfma_f32_16x16x32_bf16(Bt[n][k], At[m][k], acc[ai][bj][m][n], 0, 0, 0); __builtin_amdgcn_s_setprio(0); } while (0)
#define PG8_WAIT_V(n) asm volatile("s_waitcnt vmcnt(" #n ")" ::: "memory")
#define PG8_WAIT_L(n) asm volatile("s_waitcnt lgkmcnt(" #n ")" ::: "memory")
#define PG8_BAR __builtin_amdgcn_s_barrier()
#define PG8_SCHED __builtin_amdgcn_sched_barrier(0)
    Unit cur, nxt; int ui = 0;
    if (!S.next(0, cur)) return;
    f32x4 acc[2][2][4][2];
#pragma unroll
    for (int a = 0; a < 2; ++a)
#pragma unroll
        for (int b = 0; b < 2; ++b)
#pragma unroll
            for (int m = 0; m < 4; ++m)
#pragma unroll
                for (int n = 0; n < 2; ++n) acc[a][b][m][n] = (f32x4){0.f, 0.f, 0.f, 0.f};
    bf16x8 At[4][2], B0[2][2], B1[2][2];
    const char* cA = (const char*)g.A + (size_t)cur.pm * tstep; const char* cB = (const char*)g.Bt + (size_t)cur.pn * tstep;
    S.a_ready(cur);
    if constexpr (SP2) {
        PG8_STAGE(PG8_SB(0, 0), cB, voffB); PG8_STAGE(PG8_SB(0, 1), cB + hstep, voffB); PG8_STAGE(PG8_SA(0, 0), cA, voffA); PG8_STAGE(PG8_SA(0, 1), cA + hstep, voffA);
        if (wr == 1) PG8_BAR;
        PG8_WAIT_V(2); PG8_BAR;
        PG8_STAGE(PG8_SB(1, 0), cB + kstep, voffB); PG8_STAGE(PG8_SA(1, 0), cA + kstep, voffA); PG8_STAGE(PG8_SB(1, 1), cB + hstep + kstep, voffB);
        PG8_WAIT_V(6); PG8_BAR;
    } else {
        PG8_STAGE(PG8_SB(0, 0), cB, voffB); PG8_STAGE(PG8_SA(0, 0), cA, voffA); PG8_STAGE(PG8_SB(0, 1), cB + hstep, voffB); PG8_STAGE(PG8_SA(0, 1), cA + hstep, voffA);
        if (wr == 1) PG8_BAR;
        PG8_WAIT_V(4); PG8_BAR;
        PG8_STAGE(PG8_SB(1, 0), cB + kstep, voffB); PG8_STAGE(PG8_SA(1, 0), cA + kstep, voffA); PG8_STAGE(PG8_SB(1, 1), cB + hstep + kstep, voffB);
        PG8_WAIT_V(6); PG8_BAR;
    }
    for (;;) {
        const bool has_next = S.next(ui + 1, nxt);
        const char* nA = has_next ? (const char*)g.A + (size_t)nxt.pm * tstep : cA; const char* nB = has_next ? (const char*)g.Bt + (size_t)nxt.pn * tstep : cB;
        for (int t = 0; t < nt; t += 2) {
            const bool last = (t == nt - 2);
            const char* a1 = cA + (size_t)(t + 1) * kstep;
            const char* a2 = last ? nA : cA + (size_t)(t + 2) * kstep; const char* b2 = last ? nB : cB + (size_t)(t + 2) * kstep;
            const char* a3 = a2 + kstep; const char* b3 = b2 + kstep;
            if (last && has_next) S.a_ready(nxt);
            if constexpr (SP2) {
            PG8_LDB(B0, 0, 0); PG8_LDB(B1, 0, 1); PG8_SCHED; PG8_LDA(At, 0, 0); PG8_STAGE(PG8_SA(1, 1), a1 + hstep, voffA);
            PG8_WAIT_V(8); PG8_WAIT_L(0); PG8_BAR; PG8_MMA(0, 0, At, B0); PG8_MMA(0, 1, At, B1); PG8_BAR; PG8_SCHED;
            PG8_LDA(At, 0, 1); PG8_STAGE(PG8_SB(0, 0), b2, voffB); PG8_STAGE(PG8_SB(0, 1), b2 + hstep, voffB); PG8_STAGE(PG8_SA(0, 0), a2, voffA);
            PG8_WAIT_V(8); PG8_WAIT_L(0); PG8_BAR; PG8_MMA(1, 0, At, B0); PG8_MMA(1, 1, At, B1); PG8_BAR; PG8_SCHED;
            PG8_LDB(B0, 1, 0); PG8_LDB(B1, 1, 1); PG8_SCHED; PG8_LDA(At, 1, 0); PG8_STAGE(PG8_SA(0, 1), a2 + hstep, voffA);
            PG8_WAIT_V(8); PG8_WAIT_L(0); PG8_BAR; PG8_MMA(0, 0, At, B0); PG8_MMA(0, 1, At, B1); PG8_BAR; PG8_SCHED;
            PG8_LDA(At, 1, 1); PG8_STAGE(PG8_SB(1, 0), b3, voffB); PG8_STAGE(PG8_SB(1, 1), b3 + hstep, voffB); PG8_STAGE(PG8_SA(1, 0), a3, voffA);
            PG8_WAIT_V(8); PG8_WAIT_L(0); PG8_BAR; PG8_MMA(1, 0, At, B0); PG8_MMA(1, 1, At, B1); PG8_BAR; PG8_SCHED;
            } else {
            PG8_LDB(B0, 0, 0); PG8_SCHED; PG8_LDA(At, 0, 0); PG8_STAGE(PG8_SA(1, 1), a1 + hstep, voffA);
            PG8_WAIT_L(8); PG8_BAR; PG8_WAIT_L(0); PG8_MMA(0, 0, At, B0); PG8_BAR; PG8_SCHED;
            PG8_LDB(B1, 0, 1); PG8_STAGE(PG8_SB(0, 0), b2, voffB);
            PG8_BAR; PG8_WAIT_L(0); PG8_MMA(0, 1, At, B1); PG8_BAR;
            PG8_LDA(At, 0, 1); PG8_STAGE(PG8_SA(0, 0), a2, voffA);
            PG8_BAR; PG8_WAIT_L(0); PG8_MMA(1, 0, At, B0); PG8_BAR; PG8_SCHED;
            PG8_STAGE(PG8_SB(0, 1), b2 + hstep, voffB);
            PG8_WAIT_V(6); PG8_BAR; PG8_MMA(1, 1, At, B1); PG8_BAR;
            PG8_LDB(B0, 1, 0); PG8_SCHED; PG8_LDA(At, 1, 0); PG8_STAGE(PG8_SA(0, 1), a2 + hstep, voffA);
            PG8_WAIT_L(8); PG8_BAR; PG8_WAIT_L(0); PG8_MMA(0, 0, At, B0); PG8_BAR; PG8_SCHED;
            PG8_LDB(B1, 1, 1); PG8_STAGE(PG8_SB(1, 0), b3, voffB);
            PG8_BAR; PG8_WAIT_L(0); PG8_MMA(0, 1, At, B1); PG8_BAR;
            PG8_LDA(At, 1, 1); PG8_STAGE(PG8_SA(1, 0), a3, voffA);
            PG8_BAR; PG8_WAIT_L(0); PG8_MMA(1, 0, At, B0); PG8_BAR; PG8_SCHED;
            PG8_STAGE(PG8_SB(1, 1), b3 + hstep, voffB);
            PG8_WAIT_V(6); PG8_BAR; PG8_MMA(1, 1, At, B1); PG8_BAR;
            }
        }
        if constexpr (ALIGN_EPI) { if (wr == 0) PG8_BAR; }
        if constexpr (!Epi::AFTER_DRAIN) { E(acc, cur, wr, wc, fr, fq); S.done(cur); }
        if (!has_next) break;
#pragma unroll
        for (int a = 0; a < 2; ++a)
#pragma unroll
            for (int b = 0; b < 2; ++b)
#pragma unroll
                for (int m = 0; m < 4; ++m)
#pragma unroll
                    for (int n = 0; n < 2; ++n) acc[a][b][m][n] = (f32x4){0.f, 0.f, 0.f, 0.f};
        cur = nxt; cA = nA; cB = nB; ++ui;
        if constexpr (ALIGN_EPI) { if (wr == 1) PG8_BAR; }
    }
    PG8_WAIT_V(0);
    if constexpr (!ALIGN_EPI) { if (wr == 0) PG8_BAR; }
    PG8_BAR;
    if constexpr (Epi::AFTER_DRAIN) { E.fused(acc, cur, wr, wc, fr, fq, lds, wid, lane); S.done(cur); }
#undef PG8_SA
#undef PG8_SB
#undef PG8_STAGE
#undef PG8_LDA
#undef PG8_LDB
#undef PG8_MMA
#undef PG8_WAIT_V
#undef PG8_WAIT_L
#undef PG8_BAR
#undef PG8_SCHED
}
}
#else
template <class Epi, class Sched, bool ALIGN_EPI = false, bool SP2 = false>
static void gemm_phase(LDSP lds, const Gemm g, const Sched& S, const Epi& E, const int wid_) {
    const int tid = TID(), wid = tid >> 6, lane = tid & 63, wr = wid >> 2, wc = wid & 3, fr = lane & 15, fq = lane >> 4;
    Unit u;
    for (int i = 0; S.next(i, u); ++i) {
        f32x4 acc[2][2][4][2];
        for (int ai = 0; ai < 2; ++ai) for (int bj = 0; bj < 2; ++bj) for (int m = 0; m < 4; ++m) for (int n = 0; n < 2; ++n) for (int e = 0; e < 4; ++e) {
            const int row = 256 * u.pm + 128 * ai + 64 * wr + 16 * m + fr;
            const int col = 256 * u.pn + 128 * bj + 32 * wc + (Epi::PERM ? 8 * fq + 4 * n + e : 16 * n + 4 * fq + e);
            const bf16_t* a = g.A + (size_t)row * g.K; const bf16_t* b = g.Bt + (size_t)col * g.K; float s = 0.f;
            for (int k = 0; k < g.K; ++k) s += ::bf2f(a[k]) * ::bf2f(b[k]);
            acc[ai][bj][m][n][e] = s; }
        E(acc, u, wr, wc, fr, fq);
    }
}
}
#endif

struct EpiSwiglu {
    static constexpr bool PERM = true, AFTER_DRAIN = false;
    LDSP rtab;
    DEVM void operator()(const f32x4 (&acc)[2][2][4][2], const pg8::Unit& u, int wr, int wc, int fr, int fq) const {
        const int row0 = u.pm * 256 + wr * 64 + fr, col0 = u.pn * 128 + wc * 32 + 8 * fq;
        unsigned char* ws_ = P_WS(); bf16_t* G = (bf16_t*)(ws_ + WS_G); const LAS float* rt = (const LAS float*)rtab + u.idx * 256 + wr * 64 + fr;
#pragma unroll
        for (int ai = 0; ai < 2; ++ai)
#pragma unroll
            for (int m = 0; m < 4; ++m) {
                bf16_t* rowp = G + (size_t)(row0 + ai * 128 + m * 16) * DFF + col0;
                const float rinv = rt[ai * 128 + m * 16];
                float o[8];
#pragma unroll
                for (int n = 0; n < 2; ++n)
#pragma unroll
                    for (int e = 0; e < 4; ++e) { const float g = acc[ai][0][m][n][e] * rinv, up = acc[ai][1][m][n][e] * rinv; o[4 * n + e] = g * up * RCPF(1.0f + EXP2F(-g * LOG2E)); }
                u32x4 w; w.x = pk2(o[0], o[1]); w.y = pk2(o[2], o[3]); w.z = pk2(o[4], o[5]); w.w = pk2(o[6], o[7]);
                *(u32x4*)rowp = w;
            }
    }
};
struct EpiResid {
    static constexpr bool PERM = true, AFTER_DRAIN = false;
    float scale; int nso;
    DEVM float apply4(size_t row, int col, f32x4 v) const { float* X = P_OUT(); bf16_t* XB = (bf16_t*)(P_WS() + WS_H); f32x4* q = (f32x4*)(X + row * DM + col); const f32x4 x = *q + v * scale; *q = x;
        u32x2 w; w.x = pk2(x[0], x[1]); w.y = pk2(x[2], x[3]); *(u32x2*)(XB + row * DM + col) = w; return (x[0] * x[0] + x[1] * x[1]) + (x[2] * x[2] + x[3] * x[3]); }
    DEVM void put_ss(size_t row, int slot, float ss) const { ((float*)(P_WS() + WS_SS))[((size_t)nso * NSLOT + slot) * M + row] = ss; }
    DEVM void operator()(const f32x4 (&acc)[2][2][4][2], const pg8::Unit& u, int wr, int wc, int fr, int fq) const {
        const int row0 = u.pm * 256 + wr * 64 + fr, col0 = u.pn * 256 + wc * 32 + 8 * fq;
        float* X = P_OUT(); unsigned char* ws_ = P_WS(); bf16_t* XB = (bf16_t*)(ws_ + WS_H); float* SSs = (float*)(ws_ + WS_SS) + ((size_t)nso * NSLOT + u.pn * 8 + wc) * M;
#pragma unroll
        for (int ai = 0; ai < 2; ++ai)
#pragma unroll
            for (int m = 0; m < 4; ++m) {
                const size_t row = (size_t)(row0 + ai * 128 + m * 16); float* rowp = X + row * DM + col0; bf16_t* rowb = XB + row * DM + col0;
#pragma unroll
                for (int bj = 0; bj < 2; ++bj) { float ss = 0.f;
#pragma unroll
                    for (int n = 0; n < 2; ++n) { f32x4* q = (f32x4*)(rowp + bj * 128 + n * 4); const f32x4 x = *q + acc[ai][bj][m][n] * scale; *q = x;
                        u32x2 w; w.x = pk2(x[0], x[1]); w.y = pk2(x[2], x[3]); *(u32x2*)(rowb + bj * 128 + n * 4) = w; ss += (x[0] * x[0] + x[1] * x[1]) + (x[2] * x[2] + x[3] * x[3]); }
                    ss += SHFL_XOR(ss, 16); ss += SHFL_XOR(ss, 32);
                    if (fq == 0) SSs[(size_t)bj * 4 * M + row] = ss; }
            }
    }
};
struct EpiWin {
    static constexpr bool PERM = true, AFTER_DRAIN = false;
    LDSP rtab;
    DEVM void operator()(const f32x4 (&acc)[2][2][4][2], const pg8::Unit& u, int wr, int wc, int fr, int fq) const {
        const int row0 = u.pm * 256 + wr * 64 + fr;
        unsigned char* ws_ = P_WS(); float* PF = (float*)(ws_ + WS_PF); bf16_t* SG = (bf16_t*)(ws_ + WS_SG); const LAS float* rt = (const LAS float*)rtab + u.idx * 256 + wr * 64 + fr;
        if (u.pn < FW / 256) {
            const int col0 = u.pn * 256 + wc * 32 + 8 * fq;
#pragma unroll
            for (int ai = 0; ai < 2; ++ai)
#pragma unroll
                for (int m = 0; m < 4; ++m) {
                    float* rowp = PF + (size_t)(row0 + ai * 128 + m * 16) * FW + col0; const float rinv = rt[ai * 128 + m * 16];
#pragma unroll
                    for (int bj = 0; bj < 2; ++bj)
#pragma unroll
                        for (int n = 0; n < 2; ++n) *(f32x4*)(rowp + bj * 128 + n * 4) = acc[ai][bj][m][n] * rinv;
                }
        } else {
            const int col0 = (u.pn - FW / 256) * 256 + wc * 32 + 8 * fq;
#pragma unroll
            for (int ai = 0; ai < 2; ++ai)
#pragma unroll
                for (int m = 0; m < 4; ++m) {
                    bf16_t* rowp = SG + (size_t)(row0 + ai * 128 + m * 16) * (2 * DM) + col0; const float rinv = rt[ai * 128 + m * 16];
#pragma unroll
                    for (int bj = 0; bj < 2; ++bj)
#pragma unroll
                        for (int n = 0; n < 2; ++n) { const f32x4 v = acc[ai][bj][m][n] * rinv; u32x2 w;
                            w.x = pk2(sigmoidf_(v[0]), sigmoidf_(v[1])); w.y = pk2(sigmoidf_(v[2]), sigmoidf_(v[3]));
                            *(u32x2*)(rowp + bj * 128 + n * 4) = w; }
                }
        }
    }
};
struct EpiUpA {
    static constexpr bool PERM = true, AFTER_DRAIN = false;
    int dummy;
    DEVM void put_ss(size_t, int, float) const {}
    DEVM float apply4(size_t row, int col, f32x4 v) const { unsigned char* ws_ = P_WS(); const bf16_t* SG = (const bf16_t*)(ws_ + WS_SG); float* T1 = (float*)(ws_ + WS_T1); const u32x2 s = *(const u32x2*)(SG + row * (2 * DM) + col);
        f32x4 o; o[0] = v[0] * bf2f(s.x & 0xffffu); o[1] = v[1] * bf2f(s.x >> 16); o[2] = v[2] * bf2f(s.y & 0xffffu); o[3] = v[3] * bf2f(s.y >> 16); *(f32x4*)(T1 + row * DM + col) = o; return 0.f; }
    DEVM void operator()(const f32x4 (&acc)[2][2][4][2], const pg8::Unit& u, int wr, int wc, int fr, int fq) const {
        const int row0 = u.pm * 256 + wr * 64 + fr, col0 = u.pn * 256 + wc * 32 + 8 * fq;
        unsigned char* ws_ = P_WS(); const bf16_t* SG = (const bf16_t*)(ws_ + WS_SG); float* T1 = (float*)(ws_ + WS_T1);
#pragma unroll
        for (int ai = 0; ai < 2; ++ai)
#pragma unroll
            for (int m = 0; m < 4; ++m) {
                const size_t row = (size_t)(row0 + ai * 128 + m * 16);
#pragma unroll
                for (int bj = 0; bj < 2; ++bj)
#pragma unroll
                    for (int n = 0; n < 2; ++n) { const int c = col0 + bj * 128 + n * 4; const u32x2 s = *(const u32x2*)(SG + row * (2 * DM) + c); const f32x4 v = acc[ai][bj][m][n];
                        f32x4 o; o[0] = v[0] * bf2f(s.x & 0xffffu); o[1] = v[1] * bf2f(s.x >> 16); o[2] = v[2] * bf2f(s.y & 0xffffu); o[3] = v[3] * bf2f(s.y >> 16);
                        *(f32x4*)(T1 + row * DM + c) = o; }
            }
    }
};
struct EpiUpB {
    static constexpr bool PERM = true, AFTER_DRAIN = false;
    int dummy;
    DEVM void put_ss(size_t, int, float) const {}
    DEVM float apply4(size_t row, int col, f32x4 v) const { unsigned char* ws_ = P_WS(); const bf16_t* SG = (const bf16_t*)(ws_ + WS_SG); const float* T1 = (const float*)(ws_ + WS_T1); bf16_t* MG = (bf16_t*)(ws_ + WS_MG); const u32x2 s = *(const u32x2*)(SG + row * (2 * DM) + DM + col); const f32x4 t = *(const f32x4*)(T1 + row * DM + col);
        u32x2 w; w.x = pk2(t[0] + v[0] * bf2f(s.x & 0xffffu), t[1] + v[1] * bf2f(s.x >> 16)); w.y = pk2(t[2] + v[2] * bf2f(s.y & 0xffffu), t[3] + v[3] * bf2f(s.y >> 16)); *(u32x2*)(MG + row * DM + col) = w; return 0.f; }
    DEVM void operator()(const f32x4 (&acc)[2][2][4][2], const pg8::Unit& u, int wr, int wc, int fr, int fq) const {
        const int row0 = u.pm * 256 + wr * 64 + fr, col0 = u.pn * 256 + wc * 32 + 8 * fq;
        unsigned char* ws_ = P_WS(); const bf16_t* SG = (const bf16_t*)(ws_ + WS_SG); const float* T1 = (const float*)(ws_ + WS_T1); bf16_t* MG = (bf16_t*)(ws_ + WS_MG);
#pragma unroll
        for (int ai = 0; ai < 2; ++ai)
#pragma unroll
            for (int m = 0; m < 4; ++m) {
                const size_t row = (size_t)(row0 + ai * 128 + m * 16);
#pragma unroll
                for (int bj = 0; bj < 2; ++bj)
#pragma unroll
                    for (int n = 0; n < 2; ++n) { const int c = col0 + bj * 128 + n * 4; const u32x2 s = *(const u32x2*)(SG + row * (2 * DM) + DM + c); const f32x4 v = acc[ai][bj][m][n];
                        const f32x4 t = *(const f32x4*)(T1 + row * DM + c);
                        u32x2 w; w.x = pk2(t[0] + v[0] * bf2f(s.x & 0xffffu), t[1] + v[1] * bf2f(s.x >> 16)); w.y = pk2(t[2] + v[2] * bf2f(s.y & 0xffffu), t[3] + v[3] * bf2f(s.y >> 16));
                        *(u32x2*)(MG + row * DM + c) = w; }
            }
    }
};


template <class Sched> DEV void rinv_table(const Sched& S, int nsi, LDSP lds, int tid) {
    const float* SS = (const float*)(P_WS() + WS_SS) + (size_t)nsi * NSLOT * M; LAS float* rt = (LAS float*)(lds + LDS_RINV_OFF);
    pg8::Unit u;
#pragma unroll 1
    for (int i = 0; S.next(i, u); ++i) if (tid < 256) { float s = 0.f;
#pragma unroll 8
        for (int k = 0; k < NSLOT; ++k) s += SS[(size_t)k * M + u.pm * 256 + tid];
        rt[i * 256 + tid] = RSQRTF(s * (1.0f / DM) + RMS_EPS); }
    WG_SYNC();
}

template <class Epi> DEV void sgemm_tile(const bf16_t* A, const bf16_t* Bt, int K, int m0, int n0, LDSP lds, int tid, const Epi& E) {
    const int lane = tid & 63, wave = WAVE_ID(tid), r = lane & 15, g4 = lane >> 4;
    f32x4 acc[4][4];
#pragma unroll
    for (int nt = 0; nt < 4; ++nt)
#pragma unroll
        for (int mt = 0; mt < 4; ++mt) acc[nt][mt] = (f32x4){0.f, 0.f, 0.f, 0.f};
    unsigned offA[4], offB[4];
#pragma unroll
    for (int t = 0; t < 4; ++t) { offA[t] = (unsigned)(((m0 + r + 16 * t) * K + 8 * g4) * 2); offB[t] = (unsigned)(((n0 + r + 16 * t) * K + 8 * g4) * 2); }
    const int nks = K >> 5;
    bf16x8 xa0[4], xb0[4], xa1[4], xb1[4], xa2[4], xb2[4];
#define SG_LOAD(A_, B_, ksv) do { const char* Ab_ = (const char*)A + 64 * (ksv); const char* Bb_ = (const char*)Bt + 64 * (ksv); _Pragma("unroll") for (int t = 0; t < 4; ++t) { \
        A_[t] = *(const bf16x8*)(Ab_ + offA[t]); B_[t] = *(const bf16x8*)(Bb_ + offB[t]); } } while (0)
#define SG_MMA(A_, B_) do { _Pragma("unroll") for (int nt = 0; nt < 4; ++nt) _Pragma("unroll") for (int mt = 0; mt < 4; ++mt) acc[nt][mt] = MFMA16(B_[nt], A_[mt], acc[nt][mt]); } while (0)
    const int npairs = nks >> 1, pq = npairs / NWAVES, prem = npairs % NWAVES, hcnt = 2 * (pq + (wave < prem ? 1 : 0)), hs = 2 * (wave * pq + (wave < prem ? wave : prem));
    int i = 0;
    if (hcnt > 0) SG_LOAD(xa0, xb0, hs);
    if (hcnt > 1) SG_LOAD(xa1, xb1, hs + 1);
#pragma unroll 1
    for (; i + 4 < hcnt; i += 3) {
        SG_LOAD(xa2, xb2, hs + i + 2); SG_MMA(xa0, xb0);
        SG_LOAD(xa0, xb0, hs + i + 3); SG_MMA(xa1, xb1);
        SG_LOAD(xa1, xb1, hs + i + 4); SG_MMA(xa2, xb2);
    }
    { const int R = hcnt - i;
      if (R >= 3) SG_LOAD(xa2, xb2, hs + i + 2);
      if (R >= 1) SG_MMA(xa0, xb0);
      if (R >= 4) SG_LOAD(xa0, xb0, hs + i + 3);
      if (R >= 2) SG_MMA(xa1, xb1);
      if (R >= 3) SG_MMA(xa2, xb2);
      if (R >= 4) SG_MMA(xa0, xb0); }
#undef SG_LOAD
#undef SG_MMA
#pragma unroll
    for (int nt = 0; nt < 4; ++nt)
#pragma unroll
        for (int mt = 0; mt < 4; ++mt) *(LAS f32x4*)(lds + wave * 16384 + ((nt * 4 + mt) * 64 + lane) * 16) = acc[nt][mt];
    WG_SYNC();
    {
        const int mt = wave & 3; float q = 0.f;
#pragma unroll
        for (int k = 0; k < 2; ++k) {
            const int nt = 2 * (wave >> 2) + k, s = (nt * 4 + mt) * 64 + lane;
            f32x4 v = *(const LAS f32x4*)(lds + s * 16);
#pragma unroll
            for (int w = 1; w < NWAVES; ++w) v = v + *(const LAS f32x4*)(lds + w * 16384 + s * 16);
            q += E.apply4((size_t)(m0 + 16 * mt + r), n0 + 16 * nt + 4 * g4, v);
        }
        q += SHFL_XOR(q, 16); q += SHFL_XOR(q, 32);
        if (g4 == 0) E.put_ss((size_t)(m0 + 16 * mt + r), (n0 >> 5) + (wave >> 2), q);
    }
    WG_SYNC();
}

constexpr int IT_G = (DM / 64) * (DFF / 32), IT_D = (DFF / 64) * (DM / 32), IT_IN = (DM / 64) * (INCOLS / 32), IT_UA = (AW / 64) * (DM / 32), IT_UB = (BQ / 64) * (DM / 32), IT_O = (DM / 64) * (DM / 32);
constexpr int IT_LAYER = 4 * IT_G + 2 * IT_D + IT_IN + IT_UA + IT_UB + IT_O;
struct ConvItem { const float* src; bf16_t* dst; const float* gain; int K, N, k0, n0, drow; };
DEV ConvItem conv_decode(const Params& p, int l, int r) {
    int src, K, N, mode, gsrc = -1; size_t doff, soff;
    if (r < IT_G) { src = I_F1G; gsrc = I_NFF1; K = DM; N = DFF; mode = 1; doff = OFF_WGU1; soff = (size_t)l * DM * DFF; }
    else if ((r -= IT_G) < IT_G) { src = I_F1U; gsrc = I_NFF1; K = DM; N = DFF; mode = 2; doff = OFF_WGU1; soff = (size_t)l * DM * DFF; }
    else if ((r -= IT_G) < IT_D) { src = I_F1D; K = DFF; N = DM; mode = 0; doff = OFF_WD1; soff = (size_t)l * DFF * DM; }
    else if ((r -= IT_D) < IT_IN) { src = I_WIN; gsrc = I_NMIX; K = DM; N = INCOLS; mode = 3; doff = OFF_WIN; soff = (size_t)l * DM * INCOLS; }
    else if ((r -= IT_IN) < IT_UA) { src = I_WUA; K = AW; N = DM; mode = 0; doff = OFF_WUA; soff = (size_t)l * AW * DM; }
    else if ((r -= IT_UA) < IT_UB) { src = I_WUB; K = BQ; N = DM; mode = 0; doff = OFF_WUB; soff = (size_t)l * BQ * DM; }
    else if ((r -= IT_UB) < IT_O) { src = I_WO; K = DM; N = DM; mode = 0; doff = OFF_WO; soff = (size_t)l * DM * DM; }
    else if ((r -= IT_O) < IT_G) { src = I_F2G; gsrc = I_NFF2; K = DM; N = DFF; mode = 1; doff = OFF_WGU2; soff = (size_t)l * DM * DFF; }
    else if ((r -= IT_G) < IT_G) { src = I_F2U; gsrc = I_NFF2; K = DM; N = DFF; mode = 2; doff = OFF_WGU2; soff = (size_t)l * DM * DFF; }
    else { r -= IT_G; src = I_F2D; K = DFF; N = DM; mode = 0; doff = OFF_WD2; soff = (size_t)l * DFF * DM; }
    ConvItem d; d.src = PIN(p, src) + soff; d.dst = lwp(p, l, doff); d.gain = gsrc >= 0 ? PIN(p, gsrc) + (size_t)l * DM : nullptr; d.K = K; d.N = N;
    const int nblk = N / 32, kb = r / nblk, nb = r % nblk; d.k0 = 64 * kb; d.n0 = 32 * nb;
    const int n0 = d.n0; int drow = n0;
    if (mode == 1) drow = (n0 >> 7) * 256 + (n0 & 127); else if (mode == 2) drow = (n0 >> 7) * 256 + 128 + (n0 & 127); else if (mode == 3) drow = n0 < FW_RAW ? n0 : FW + (n0 - FW_RAW);
    d.drow = drow; return d;
}
DEV void conv_load(const ConvItem& d, f32x4 (&v)[8], f32x4 (&g)[2], int lane) {
#pragma unroll
    for (int i = 0; i < 8; ++i) v[i] = *(const f32x4*)(d.src + (size_t)(d.k0 + 8 * i + (lane >> 3)) * d.N + d.n0 + 4 * (lane & 7));
    g[0] = (f32x4){1.f, 1.f, 1.f, 1.f}; g[1] = g[0];
    if (d.gain) { g[0] = *(const f32x4*)(d.gain + d.k0 + 8 * (lane & 7)); g[1] = *(const f32x4*)(d.gain + d.k0 + 8 * (lane & 7) + 4); }
}
DEV void conv_finish(const ConvItem& d, const f32x4 (&v)[8], const f32x4 (&g)[2], LAS float* scr, int lane) {
#pragma unroll
    for (int i = 0; i < 8; ++i) { LAS float* q = scr + (8 * i + (lane >> 3)) * 33 + 4 * (lane & 7); q[0] = v[i][0]; q[1] = v[i][1]; q[2] = v[i][2]; q[3] = v[i][3]; }
    WAVE_FENCE();
    const int c = lane & 7;
#pragma unroll
    for (int j = 0; j < 4; ++j) { const int n = (lane >> 3) + 8 * j; const LAS float* s = scr + (8 * c) * 33 + n;
        u32x4 o; o.x = pk2(s[0 * 33] * g[0][0], s[1 * 33] * g[0][1]); o.y = pk2(s[2 * 33] * g[0][2], s[3 * 33] * g[0][3]); o.z = pk2(s[4 * 33] * g[1][0], s[5 * 33] * g[1][1]); o.w = pk2(s[6 * 33] * g[1][2], s[7 * 33] * g[1][3]);
        *(u32x4*)(d.dst + (size_t)(d.drow + n) * d.K + d.k0 + 8 * c) = o; }
    WAVE_FENCE();
}
DEV void conv_range(const Params& p, int l, int r0, int r1, LDSP lds, int wave, int lane) {
    if (r0 >= r1) return;
    LAS float* scrA = (LAS float*)(lds + wave * 16896); LAS float* scrB = scrA + 2112;
    f32x4 va[8], vb[8], ga[2], gb[2];
    ConvItem da = conv_decode(p, l, r0), db = da;
    conv_load(da, va, ga, lane);
#pragma unroll 1
    for (int r = r0; r < r1; r += 2) {
        db = conv_decode(p, l, r + 1 < r1 ? r + 1 : r1 - 1); conv_load(db, vb, gb, lane);
        conv_finish(da, va, ga, scrA, lane);
        da = conv_decode(p, l, r + 2 < r1 ? r + 2 : r1 - 1); conv_load(da, va, ga, lane);
        if (r + 1 < r1) conv_finish(db, vb, gb, scrB, lane);
    }
}
constexpr int CONV_CH = 16;
DEV void conv_some(const Params& p, int l, int nchunks, LDSP lds, int wave, int lane) {
    if (l >= DEPTH) return;
    unsigned* ctr = (unsigned*)(p.ws + WS_CTL) + CW_CONV + 64 * l;
#pragma unroll 1
    for (int n = 0; n < nchunks; ++n) { const int base = claim_item(ctr, (unsigned)CONV_CH, lane); if (base >= IT_LAYER) break; conv_range(p, l, base, base + CONV_CH < IT_LAYER ? base + CONV_CH : IT_LAYER, lds, wave, lane); }
}
DEV void prologue(const Params& p, LDSP lds, int gw, int NGW, int wave, int lane, int gtid, int NGT) {
    { const int per = (IT_LAYER + NGW - 1) / NGW, r0 = gw * per; conv_range(p, 0, r0, r0 + per < IT_LAYER ? r0 + per : IT_LAYER, lds, wave, lane); }
    for (int idx = gtid; idx < DEPTH * AW * 288; idx += NGT) {
        const int l = idx / (AW * 288), r = idx % (AW * 288), n = r / 288, k = r % 288;
        if (k < 64) lwp(p, l, OFF_DW2T)[n * 64 + k] = (bf16_t)f2bf(PIN(p, I_DW2)[((size_t)l * 64 + k) * AW + n]);
        else if (k < 128) lwp(p, l, OFF_IA2T)[n * 64 + (k - 64)] = (bf16_t)f2bf(PIN(p, I_IA2)[((size_t)l * 64 + (k - 64)) * AW + n]);
        else lwp(p, l, OFF_GG2T)[n * 160 + (k - 128)] = (bf16_t)f2bf(PIN(p, I_GG2)[((size_t)l * 160 + (k - 128)) * AW + n]);
    }
    float* rope = (float*)(p.ws + WS_ROPE);
    for (int idx = gtid; idx < (SEQ + DECS) * 32; idx += NGT) {
        const int slot = idx >> 5, i = idx & 31; const double pos = slot < SEQ ? (double)slot : (double)(PAST + slot - SEQ);
        const double ang = pos * ROPE_INV[i]; const double red = ang - TWO_PI * __builtin_rint(ang * (1.0 / TWO_PI));
        rope[2 * idx] = cosf((float)red); rope[2 * idx + 1] = sinf((float)red);
    }
}
DEV void x0_phase(const Params& p, int gw, int NGW, int lane, int gtid, int NGT) {
    float* X = p.out; bf16_t* XB = (bf16_t*)(p.ws + WS_H); float* SS = (float*)(p.ws + WS_SS);
    const float* xp = PIN(p, I_XP); const float* xs = PIN(p, I_XS);
    for (int m = gw; m < M; m += NGW) {
        const float* xr = m < SEQ ? xp + (size_t)m * DM : xs + (size_t)(m - SEQ) * DM;
        f32x4 v[DM / 256]; float ss = 0.f;
#pragma unroll
        for (int j = 0; j < DM / 256; ++j) { v[j] = *(const f32x4*)(xr + 4 * lane + 256 * j); ss += (v[j][0] * v[j][0] + v[j][1] * v[j][1]) + (v[j][2] * v[j][2] + v[j][3] * v[j][3]); }
#pragma unroll
        for (int j = 0; j < DM / 256; ++j) { *(f32x4*)(X + (size_t)m * DM + 4 * lane + 256 * j) = v[j]; u32x2 w; w.x = pk2(v[j][0], v[j][1]); w.y = pk2(v[j][2], v[j][3]); *(u32x2*)(XB + (size_t)m * DM + 4 * lane + 256 * j) = w; }
        ss = wave_sum(ss);
        if (lane < NSLOT) SS[(size_t)lane * M + m] = lane == 0 ? ss : 0.f;
    }
}


DEV void lact_phase(const Params& p, int l, int gtid, int NGT) {
    const float* PF = (const float*)(p.ws + WS_PF); const float* mu = PIN(p, I_MU) + (size_t)l * ACOLS; const float* ssh = PIN(p, I_SSH) + (size_t)l * DECB * ACOLS;
    bf16_t* LACT = (bf16_t*)(p.ws + WS_LACT);
#pragma unroll 1
    for (int idx = gtid; idx < M * 72; idx += NGT) {
        const int m = idx / 72, g = idx % 72, col = 4 * g;
        const int pc = col < 64 ? C_WLO + col : (col < 128 ? C_ALO + (col - 64) : C_GLO + (col - 128));
        const float* cur = PF + (size_t)m * FW; const f32x4 c4 = *(const f32x4*)(cur + pc), m4 = *(const f32x4*)(mu + pc);
        f32x4 p4 = (f32x4){0.f, 0.f, 0.f, 0.f};
        if (m < SEQ) { if (m > 0) p4 = *(const f32x4*)(cur - FW + pc); }
        else { const int s = m - SEQ; p4 = (s & 15) ? *(const f32x4*)(cur - FW + pc) : *(const f32x4*)(ssh + (size_t)(s >> 4) * ACOLS + pc); }
        float x[4];
#pragma unroll
        for (int e = 0; e < 4; ++e) { const float v = c4[e] + (p4[e] - c4[e]) * m4[e]; x[e] = col < 64 ? tanhf_(v) : (col < 128 ? v : sigmoidf_(v)); }
        u32x2 w; w.x = pk2(x[0], x[1]); w.y = pk2(x[2], x[3]);
        *(u32x2*)(LACT + (size_t)m * 288 + col) = w;
    }
}

constexpr int R1_RA = 3 * 64 * 65 * 4, R1_RB = 65536 + 64 * 65 * 4;
static_assert(R1_RA + R1_RB + 2304 <= LDS_CTL_OFF && 6 * 8192 <= R1_RA, "R1 LDS map");
#define R1IN_PARAMS bf16x8 (&Xbw)[2][2], bf16x8 (&Xba)[2][2], bf16x8 (&Xbg)[2][5], bf16x8 (&Xa1)[2], bf16x8 (&Xa2)[2], bf16x8 (&Xa3)[5], float (&Xcr8)[8], float (&Xck8)[8], float (&Xcv8)[8], float& Xpr0, float& Xpk0, float& Xpv0
#define R1IN_ARGS Xbw, Xba, Xbg, Xa1, Xa2, Xa3, Xcr8, Xck8, Xcv8, Xpr0, Xpk0, Xpv0
#define R1IN_DECL bf16x8 Xbw[2][2], Xba[2][2], Xbg[2][5], Xa1[2], Xa2[2], Xa3[5]; float Xcr8[8], Xck8[8], Xcv8[8], Xpr0, Xpk0, Xpv0
DEV void r1_fetch(const Params& p, int l, int u, R1IN_PARAMS, int lane, int wave) {
    const int r = lane & 15, g4 = lane >> 4, mt1 = wave & 3, nh = wave >> 2;
    const bool samp = u >= NUP;
    int c = 0, b = 0, h, ntok; size_t row0;
    if (!samp) { c = u / AH; h = u % AH; row0 = (size_t)64 * c; ntok = 64; } else { const int s = u - NUP; b = s / AH; h = s % AH; row0 = (size_t)SEQ + 16 * b; ntok = DECS; }
    const float* PF = (const float*)(p.ws + WS_PF);
#pragma unroll
    for (int n = 0; n < 2; ++n) { const size_t wrow = (size_t)(64 * h + 16 * (2 * nh + n) + r);
#pragma unroll
        for (int ks = 0; ks < 2; ++ks) { Xbw[n][ks] = *(const bf16x8*)(lwp(p, l, OFF_DW2T) + wrow * 64 + 32 * ks + 8 * g4); Xba[n][ks] = *(const bf16x8*)(lwp(p, l, OFF_IA2T) + wrow * 64 + 32 * ks + 8 * g4); }
#pragma unroll
        for (int ks = 0; ks < 5; ++ks) Xbg[n][ks] = *(const bf16x8*)(lwp(p, l, OFF_GG2T) + wrow * 160 + 32 * ks + 8 * g4); }
    { const int tr = 16 * mt1 + r; const bf16_t* LA_ = (const bf16_t*)(p.ws + WS_LACT) + (row0 + (tr < ntok ? tr : ntok - 1)) * 288 + 8 * g4;
#pragma unroll
      for (int ks = 0; ks < 2; ++ks) { Xa1[ks] = *(const bf16x8*)(LA_ + 32 * ks); Xa2[ks] = *(const bf16x8*)(LA_ + 64 + 32 * ks); }
#pragma unroll
      for (int ks = 0; ks < 5; ++ks) Xa3[ks] = *(const bf16x8*)(LA_ + 128 + 32 * ks); }
    { const int ch_ = 64 * h + lane, t0 = 8 * wave; const float* pp; float ps = 1.f;
      if (t0 > 0) { pp = PF + (row0 + (t0 - 1 < ntok ? t0 - 1 : ntok - 1)) * FW; ps = t0 - 1 < ntok ? 1.f : 0.f; } else if (samp) pp = PIN(p, I_SSH) + ((size_t)l * DECB + b) * ACOLS; else if (c > 0) pp = PF + (row0 - 1) * FW; else { pp = PF + row0 * FW; ps = 0.f; }
      Xpr0 = pp[C_R + ch_] * ps; Xpk0 = pp[C_K + ch_] * ps; Xpv0 = pp[C_V + ch_] * ps;
#pragma unroll
      for (int tt = 0; tt < 8; ++tt) { const int t = t0 + tt; const float* cp = PF + (row0 + (t < ntok ? t : ntok - 1)) * FW; Xcr8[tt] = cp[C_R + ch_]; Xck8[tt] = cp[C_K + ch_]; Xcv8[tt] = cp[C_V + ch_]; } }
}
DEV void r1_unit(const Params& p, int l, int u, int unext, R1IN_PARAMS, LDSP lds, int tid) {
    const int lane = tid & 63, wave = WAVE_ID(tid), r = lane & 15, g4 = lane >> 4;
    const bool samp = u >= NUP;
    int c = 0, b = 0, h, ntok; size_t row0;
    if (!samp) { c = u / AH; h = u % AH; row0 = (size_t)64 * c; ntok = 64; } else { const int s = u - NUP; b = s / AH; h = s % AH; row0 = (size_t)SEQ + 16 * b; ntok = DECS; }
    const float* mu = PIN(p, I_MU) + (size_t)l * ACOLS;
    LDSP RA = lds, RB = lds + R1_RA;
    LAS float* DWf = (LAS float*)RA; LAS float* IAf = DWf + 64 * 65; LAS float* GGf = IAf + 64 * 65;
    LDSP B0 = RB, B1 = RB + 8192, B2 = RB + 16384, B3 = RB + 24576, B4 = RB + 32768, B5 = RB + 40960, B6 = RB + 49152, B7 = RB + 57344;
    LAS float* RtF = (LAS float*)(RB + 65536);
    LDSP A0 = RA, A1 = RA + 8192, A2 = RA + 16384, A3 = RA + 24576, A4 = RA + 32768, A5 = RA + 40960;
    LAS float* part = (LAS float*)(lds + R1_RA + R1_RB); LAS float* gam = part + 512;
    const int mt1 = wave & 3, nh = wave >> 2;
    if (16 * mt1 < ntok) {
        f32x4 aw[2], aa[2], ag[2];
#pragma unroll
        for (int n = 0; n < 2; ++n) { aw[n] = (f32x4){0.f, 0.f, 0.f, 0.f}; aa[n] = aw[n]; ag[n] = aw[n]; }
#pragma unroll
        for (int ks = 0; ks < 2; ++ks)
#pragma unroll
            for (int n = 0; n < 2; ++n) { aw[n] = MFMA16(Xa1[ks], Xbw[n][ks], aw[n]); aa[n] = MFMA16(Xa2[ks], Xba[n][ks], aa[n]); }
#pragma unroll
        for (int ks = 0; ks < 5; ++ks)
#pragma unroll
            for (int n = 0; n < 2; ++n) ag[n] = MFMA16(Xa3[ks], Xbg[n][ks], ag[n]);
#pragma unroll
        for (int n = 0; n < 2; ++n)
#pragma unroll
            for (int reg = 0; reg < 4; ++reg) { const int o = (16 * mt1 + 4 * g4 + reg) * 65 + 16 * (2 * nh + n) + r; DWf[o] = aw[n][reg]; IAf[o] = aa[n][reg]; GGf[o] = ag[n][reg]; }
    }
    WG_SYNC_LDS();
    {
        const int j = lane, tq = wave, ch = 64 * h + j;
        const float w0 = PIN(p, I_DW0)[(size_t)l * AW + ch], a0 = PIN(p, I_IA0)[(size_t)l * AW + ch], kkw = PIN(p, I_KK)[(size_t)l * AW + ch], kaw = PIN(p, I_KA)[(size_t)l * AW + ch], rkw = PIN(p, I_RK)[(size_t)l * AW + ch];
        const float mur = mu[C_R + ch], muk = mu[C_K + ch], muv = mu[C_V + ch];
        float pr = Xpr0, pk = Xpk0, pv = Xpv0;
        float rr[8], kq[8], kp[8], av[8], vv[8], ld[8], Lc[8], bs[8]; float Lacc = 0.f;
#pragma unroll
        for (int tt = 0; tt < 8; ++tt) {
            const int t = 8 * tq + tt; const bool valid = t < ntok;
            const float cr = valid ? Xcr8[tt] : 0.f, ck = valid ? Xck8[tt] : 0.f, cv = valid ? Xcv8[tt] : 0.f;
            float r_ = cr + (pr - cr) * mur, k_ = ck + (pk - ck) * muk, v_ = cv + (pv - cv) * muv; pr = cr; pk = ck; pv = cv;
            const float w = -softplusf_(-(w0 + DWf[t * 65 + j])) - 0.5f;
            float logd = -expf_(w);
            float a = sigmoidf_(a0 + IAf[t * 65 + j]);
            float kn = k_ * kkw; const float ss = wave_sum(kn * kn); kn = kn * RCPF(fmaxf(sqrtf(ss), 1e-12f));
            float kpp = k_ * (1.0f + (a - 1.0f) * kaw);
            float bsum = wave_sum(r_ * kpp * rkw);
            if (!valid) { logd = 0.f; kn = 0.f; kpp = 0.f; r_ = 0.f; v_ = 0.f; a = 0.f; bsum = 0.f; }
            Lacc += logd; ld[tt] = logd; Lc[tt] = Lacc; rr[tt] = r_; kq[tt] = kn; kp[tt] = kpp; av[tt] = a; vv[tt] = v_; bs[tt] = bsum;
        }
        part[tq * 64 + j] = Lacc;
        WG_SYNC_LDS();
        float off = 0.f;
#pragma unroll
        for (int q = 0; q < 8; ++q) if (q < tq) off += part[q * 64 + j];
        float fa[8], fb[8], fk[8], gt[8], bn[8];
#pragma unroll
        for (int tt = 0; tt < 8; ++tt) {
            const int t = 8 * tq + tt; const float L = Lc[tt] + off, Lm = L - ld[tt], eL = expf_(L), eLm = expf_(Lm), enL = expf_(-L);
            const float At = -kq[tt] * eLm, Bt = kq[tt] * av[tt] * enL, Kt = kp[tt] * enL, Rt = rr[tt] * eL;
            *(LAS bf16_t*)(B0 + swz(t, j)) = (bf16_t)f2bf(At); *(LAS bf16_t*)(B2 + swz(t, j)) = (bf16_t)f2bf(Bt); *(LAS bf16_t*)(B4 + swz(t, j)) = (bf16_t)f2bf(Kt); *(LAS bf16_t*)(B6 + swz(t, j)) = (bf16_t)f2bf(Rt);
            RtF[t * 65 + j] = Rt; fa[tt] = At; fb[tt] = Bt; fk[tt] = Kt; gt[tt] = GGf[t * 65 + j]; bn[tt] = bs[tt] * vv[tt];
            if (t == 63) gam[j] = eL;
        }
#define R1_PK8(a) ((u32x4){pk2(a[0], a[1]), pk2(a[2], a[3]), pk2(a[4], a[5]), pk2(a[6], a[7])})
        *(LAS u32x4*)(B1 + swz(j, 8 * tq)) = R1_PK8(fa); *(LAS u32x4*)(B3 + swz(j, 8 * tq)) = R1_PK8(fb); *(LAS u32x4*)(B5 + swz(j, 8 * tq)) = R1_PK8(fk); *(LAS u32x4*)(B7 + swz(j, 8 * tq)) = R1_PK8(vv);
        *(u32x4*)((bf16_t*)(p.ws + WS_GT) + (size_t)u * 4096 + j * 64 + 8 * tq) = R1_PK8(gt);
        *(u32x4*)((bf16_t*)(p.ws + WS_BNT) + (size_t)u * 4096 + j * 64 + 8 * tq) = R1_PK8(bn);
#undef R1_PK8
    }
    WG_SYNC_LDS();
    r1_fetch(p, l, unext, R1IN_ARGS, lane, wave);
    f32x4 accP[2];
    const f32x4 zero4 = (f32x4){0.f, 0.f, 0.f, 0.f};
#pragma unroll
    for (int q = 0; q < 2; ++q) {
        const int ti = 2 * wave + q, m0 = 16 * (ti >> 2), n0 = 16 * (ti & 3), t = m0 + r;
        f32x4 x = mm64(B2, n0, B0, m0, zero4, lane);
        f32x4 pI;
#pragma unroll
        for (int reg = 0; reg < 4; ++reg) { const int s = n0 + 4 * g4 + reg; if (!(t > s)) x[reg] = 0.f; pI[reg] = x[reg] + (t == s ? 1.f : 0.f); }
        st_tile_T(A0, n0, m0, x, lane); st_tile_T(A2, n0, m0, pI, lane); accP[q] = pI;
        f32x4 y = mm64(B0, m0, B2, n0, zero4, lane);
#pragma unroll
        for (int reg = 0; reg < 4; ++reg) { if (!(m0 + 4 * g4 + reg > n0 + r)) y[reg] = 0.f; }
        st_tile_T(A1, m0, n0, y, lane);
        x = mm64(B4, n0, B0, m0, zero4, lane);
#pragma unroll
        for (int reg = 0; reg < 4; ++reg) { if (!(t > n0 + 4 * g4 + reg)) x[reg] = 0.f; }
        st_tile_T(A3, n0, m0, x, lane);
        x = mm64(B2, n0, B6, m0, zero4, lane);
#pragma unroll
        for (int reg = 0; reg < 4; ++reg) { if (!(t >= n0 + 4 * g4 + reg)) x[reg] = 0.f; }
        st_tile_T(A4, n0, m0, x, lane);
        x = mm64(B4, n0, B6, m0, zero4, lane);
#pragma unroll
        for (int reg = 0; reg < 4; ++reg) { if (!(t >= n0 + 4 * g4 + reg)) x[reg] = 0.f; }
        st_tile_T(A5, n0, m0, x, lane);
    }
    WG_SYNC_LDS();
#define R1_STAGE_A(Ys, YTs, Yd, YTd) do { _Pragma("unroll") for (int q = 0; q < 2; ++q) { const int ti = 2 * wave + q, m0 = 16 * (ti >> 2), n0 = 16 * (ti & 3); \
        st_tile_T(Yd, n0, m0, mm64(YTs, n0, Ys, m0, zero4, lane), lane); st_tile_T(YTd, m0, n0, mm64(Ys, m0, YTs, n0, zero4, lane), lane); } } while (0)
#define R1_STAGE_B(Ps, YTn, Pd) do { _Pragma("unroll") for (int q = 0; q < 2; ++q) { const int ti = 2 * wave + q, m0 = 16 * (ti >> 2), n0 = 16 * (ti & 3); \
        accP[q] = mm64(YTn, n0, Ps, m0, accP[q], lane); st_tile_T(Pd, n0, m0, accP[q], lane); } } while (0)
    R1_STAGE_A(A0, A1, B0, B2);
    WG_SYNC_LDS();
#pragma unroll 1
    for (int it = 1; it <= 5; ++it) {
        const int nxt = it & 1;
        LDSP Ps = nxt ? A2 : B4, Pd = nxt ? B4 : A2, YTn = nxt ? B2 : A1;
        R1_STAGE_B(Ps, YTn, Pd);
        if (it < 5) { LDSP Ys = nxt ? B0 : A0, YTs = nxt ? B2 : A1, Yd = nxt ? A0 : B0, YTd = nxt ? A1 : B2; R1_STAGE_A(Ys, YTs, Yd, YTd); }
        WG_SYNC_LDS();
    }
#undef R1_STAGE_A
#undef R1_STAGE_B
#pragma unroll
    for (int q = 0; q < 2; ++q) {
        const int ti = 2 * wave + q, m0 = 16 * (ti >> 2), n0 = 16 * (ti & 3);
        st_tile_T(B6, n0, m0, mm64(B4, n0, B1, m0, zero4, lane), lane);
        st_tile_T(A0, n0, m0, mm64(A3, n0, B7, m0, zero4, lane), lane);
    }
    WG_SYNC_LDS();
#pragma unroll
    for (int q = 0; q < 2; ++q) {
        const int ti = 2 * wave + q, m0 = 16 * (ti >> 2), n0 = 16 * (ti & 3);
        st_tile_T(A1, n0, m0, mm64(B4, n0, A0, m0, zero4, lane), lane);
        f32x4 x = mm64(B6, m0, B3, n0, zero4, lane);
        { const int jp = n0 + r; const float gj = gam[jp]; u32x2 w;
          float y[4];
#pragma unroll
          for (int reg = 0; reg < 4; ++reg) y[reg] = (x[reg] + ((m0 + 4 * g4 + reg) == jp ? 1.f : 0.f)) * gj;
          w.x = pk2(y[0], y[1]); w.y = pk2(y[2], y[3]);
          *(u32x2*)((bf16_t*)(p.ws + WS_PCT) + (size_t)u * 4096 + jp * 64 + m0 + 4 * g4) = w; }
        x = mm64(B6, n0, A4, m0, zero4, lane);
        { const int t = m0 + r, j0 = n0 + 4 * g4; u32x2 w;
          w.x = pk2(x[0] + RtF[t * 65 + j0], x[1] + RtF[t * 65 + j0 + 1]); w.y = pk2(x[2] + RtF[t * 65 + j0 + 2], x[3] + RtF[t * 65 + j0 + 3]);
          *(u32x2*)((bf16_t*)(p.ws + WS_QTT) + (size_t)u * 4096 + t * 64 + j0) = w; }
    }
    WG_SYNC_LDS();
#pragma unroll
    for (int q = 0; q < 2; ++q) {
        const int ti = 2 * wave + q, m0 = 16 * (ti >> 2), n0 = 16 * (ti & 3);
        f32x4 x = mm64(B3, m0, A1, n0, zero4, lane); x = mm64(B5, m0, B7, n0, x, lane);
#pragma unroll
        for (int reg = 0; reg < 4; ++reg) x[reg] *= gam[m0 + 4 * g4 + reg];
        *(f32x4*)((float*)(p.ws + WS_UCS) + (size_t)u * 4096 + (n0 + r) * 64 + m0 + 4 * g4) = x;
        x = mm64(A4, m0, A1, n0, zero4, lane); x = mm64(A5, m0, B7, n0, x, lane);
        *(f32x4*)((float*)(p.ws + WS_YLT) + (size_t)u * 4096 + (ti * 64 + lane) * 4) = x;
    }
    WG_SYNC_LDS();
}

DEV void r2_chain(const Params& p, int l, int task, int lane) {
    const int h = task >> 2, q = task & 3, r = lane & 15, g4 = lane >> 4, i = 16 * q + r;
    const bf16_t* PCT = (const bf16_t*)(p.ws + WS_PCT); const float* UCS = (const float*)(p.ws + WS_UCS); bf16_t* SC = (bf16_t*)(p.ws + WS_SC);
    f32x4 S[4];
#pragma unroll
    for (int mt = 0; mt < 4; ++mt) S[mt] = (f32x4){0.f, 0.f, 0.f, 0.f};
    bf16x4 a0[4][2], a1[4][2]; f32x4 ci[4];
#define R2_LOAD(cc) do { const size_t u_ = (size_t)(cc) * AH + h; _Pragma("unroll") for (int mt = 0; mt < 4; ++mt) { ci[mt] = *(const f32x4*)(UCS + u_ * 4096 + i * 64 + 16 * mt + 4 * g4); \
        _Pragma("unroll") for (int ks = 0; ks < 2; ++ks) { a0[mt][ks] = *(const bf16x4*)(PCT + u_ * 4096 + (16 * mt + r) * 64 + 32 * ks + 4 * g4); a1[mt][ks] = *(const bf16x4*)(PCT + u_ * 4096 + (16 * mt + r) * 64 + 32 * ks + 16 + 4 * g4); } } } while (0)
    R2_LOAD(0);
#pragma unroll 1
    for (int c = 0; c < NCH; ++c) {
        const size_t u = (size_t)c * AH + h;
        bf16x8 pb[2];
#pragma unroll
        for (int ks = 0; ks < 2; ++ks) pb[ks] = pack8(S[2 * ks], S[2 * ks + 1]);
#pragma unroll
        for (int mt = 0; mt < 4; ++mt) { u32x2 w; w.x = pk2(S[mt][0], S[mt][1]); w.y = pk2(S[mt][2], S[mt][3]); *(u32x2*)(SC + u * 4096 + i * 64 + 16 * mt + 4 * g4) = w; }
        bf16x8 af[4][2]; f32x4 cc[4];
#pragma unroll
        for (int mt = 0; mt < 4; ++mt) { cc[mt] = ci[mt];
#pragma unroll
            for (int ks = 0; ks < 2; ++ks) af[mt][ks] = (bf16x8){a0[mt][ks][0], a0[mt][ks][1], a0[mt][ks][2], a0[mt][ks][3], a1[mt][ks][0], a1[mt][ks][1], a1[mt][ks][2], a1[mt][ks][3]}; }
        if (c + 1 < NCH) R2_LOAD(c + 1);
#pragma unroll
        for (int mt = 0; mt < 4; ++mt) { f32x4 x = MFMA16(af[mt][0], pb[0], cc[mt]); S[mt] = MFMA16(af[mt][1], pb[1], x); }
    }
#undef R2_LOAD
    float* o = p.out + O_PWKV + ((size_t)l * AH + h) * 4096;
#pragma unroll
    for (int mt = 0; mt < 4; ++mt) *(f32x4*)(o + i * 64 + 16 * mt + 4 * g4) = S[mt];
}

constexpr int R2_NSLOT = 12, R2_SLOTB = 12288, R2_FLAGS = R2_NSLOT * R2_SLOTB;
static_assert(R2_FLAGS + 128 <= LDS_CTL_OFF, "R2 ring");
DEV void r2_chain_ring(const Params& p, int l, int task, LDSP lds, int wave, int lane) {
    const int h = task >> 2, q = task & 3, r = lane & 15, g4 = lane >> 4, i = 16 * q + r;
    volatile LAS unsigned* full = (volatile LAS unsigned*)(lds + R2_FLAGS); volatile LAS unsigned* prog = full + 16;
    if (wave == 0 && lane < 32) full[lane] = 0u;
    WG_SYNC();
    if (wave > 0) {
        const unsigned char* PCT = p.ws + WS_PCT; const unsigned char* UCS = p.ws + WS_UCS;
#define R2_LOAD(V_, cc) do { const size_t u_ = (size_t)((cc) < NCH ? (cc) : NCH - 1) * AH + h; _Pragma("unroll") for (int k = 0; k < 8; ++k) V_[k] = *(const u32x4*)(PCT + u_ * 8192 + k * 1024 + lane * 16); \
        _Pragma("unroll") for (int k = 0; k < 4; ++k) V_[8 + k] = *(const u32x4*)(UCS + u_ * 16384 + (size_t)q * 4096 + k * 1024 + lane * 16); } while (0)
#define R2_PUT(V_, cc) do { if ((cc) < NCH) { const int slot = (cc) % R2_NSLOT; while ((int)*prog + R2_NSLOT <= (cc)) SPIN_WAIT(); COMPILER_FENCE(); \
        _Pragma("unroll") for (int k = 0; k < 8; ++k) { const int row = 8 * k + (lane >> 3); *(LAS u32x4*)(lds + slot * R2_SLOTB + row * 128 + (((lane & 7) ^ (row & 7)) << 4)) = V_[k]; } \
        _Pragma("unroll") for (int k = 0; k < 4; ++k) { const int row = 4 * k + (lane >> 4); *(LAS u32x4*)(lds + slot * R2_SLOTB + 8192 + row * 256 + (((lane & 15) ^ row) << 4)) = V_[8 + k]; } \
        LDS_DRAIN(); if (lane == 0) full[slot] = (unsigned)(cc) + 1u; } } while (0)
        u32x4 va[12], vb[12];
        int c = wave - 1;
        R2_LOAD(va, c);
#pragma unroll 1
        for (; c < NCH; c += 2 * (NWAVES - 1)) {
            R2_LOAD(vb, c + (NWAVES - 1));
            R2_PUT(va, c);
            R2_LOAD(va, c + 2 * (NWAVES - 1));
            R2_PUT(vb, c + (NWAVES - 1));
        }
#undef R2_LOAD
#undef R2_PUT
        return;
    }
    bf16_t* SC = (bf16_t*)(p.ws + WS_SC);
    f32x4 S[4];
#pragma unroll
    for (int mt = 0; mt < 4; ++mt) S[mt] = (f32x4){0.f, 0.f, 0.f, 0.f};
#pragma unroll 1
    for (int c = 0; c < NCH; ++c) {
        const size_t u = (size_t)c * AH + h; const int slot = c % R2_NSLOT;
        bf16x8 pb[2];
#pragma unroll
        for (int ks = 0; ks < 2; ++ks) pb[ks] = pack8(S[2 * ks], S[2 * ks + 1]);
#pragma unroll
        for (int mt = 0; mt < 4; ++mt) { u32x2 w; w.x = pk2(S[mt][0], S[mt][1]); w.y = pk2(S[mt][2], S[mt][3]); *(u32x2*)(SC + u * 4096 + i * 64 + 16 * mt + 4 * g4) = w; }
        while (full[slot] != (unsigned)c + 1u) SPIN_WAIT();
        COMPILER_FENCE();
        LDSP sl = lds + slot * R2_SLOTB;
        bf16x8 af[4][2]; f32x4 cc[4];
#pragma unroll
        for (int mt = 0; mt < 4; ++mt) { cc[mt] = *(const LAS f32x4*)(sl + 8192 + r * 256 + ((((4 * mt + g4) ^ r) & 15) << 4));
#pragma unroll
            for (int ks = 0; ks < 2; ++ks) { const int prow = 16 * mt + r, pch = 4 * ks + (g4 >> 1), pof = (g4 & 1) * 8;
                const bf16x4 lo = *(const LAS bf16x4*)(sl + prow * 128 + (((pch ^ prow) & 7) << 4) + pof), hi = *(const LAS bf16x4*)(sl + prow * 128 + ((((pch + 2) ^ prow) & 7) << 4) + pof);
                af[mt][ks] = (bf16x8){lo[0], lo[1], lo[2], lo[3], hi[0], hi[1], hi[2], hi[3]}; } }
        LDS_DRAIN();
        if (lane == 0) *prog = (unsigned)c + 1u;
#pragma unroll
        for (int mt = 0; mt < 4; ++mt) { f32x4 x = MFMA16(af[mt][0], pb[0], cc[mt]); S[mt] = MFMA16(af[mt][1], pb[1], x); }
    }
    float* o = p.out + O_PWKV + ((size_t)l * AH + h) * 4096;
#pragma unroll
    for (int mt = 0; mt < 4; ++mt) *(f32x4*)(o + i * 64 + 16 * mt + 4 * g4) = S[mt];
}
DEV void r2_sample(const Params& p, int l, int task, int lane) {
    const int q = task & 3, bh = task >> 2, r = lane & 15, g4 = lane >> 4, i = 16 * q + r;
    const size_t u = (size_t)NUP + bh;
    const bf16_t* PCT = (const bf16_t*)(p.ws + WS_PCT) + u * 4096; const float* UCS = (const float*)(p.ws + WS_UCS) + u * 4096;
    const float* S0 = PIN(p, I_SWKV) + ((size_t)l * DECB * AH + bh) * 4096;
    bf16x8 pb[2];
#pragma unroll
    for (int ks = 0; ks < 2; ++ks) { const f32x4 lo = *(const f32x4*)(S0 + i * 64 + 32 * ks + 8 * g4), hi = *(const f32x4*)(S0 + i * 64 + 32 * ks + 8 * g4 + 4); pb[ks] = pack8(lo, hi); }
    float* o = p.out + O_SWKV + ((size_t)l * DECB * AH + bh) * 4096;
#pragma unroll
    for (int mt = 0; mt < 4; ++mt) {
        f32x4 x = *(const f32x4*)(UCS + i * 64 + 16 * mt + 4 * g4);
#pragma unroll
        for (int ks = 0; ks < 2; ++ks) { const bf16x8 a = *(const bf16x8*)(PCT + (16 * mt + r) * 64 + 32 * ks + 8 * g4); x = MFMA16(a, pb[ks], x); }
        *(f32x4*)(o + i * 64 + 16 * mt + 4 * g4) = x;
    }
}

DEV void r3_work(const Params& p, int l, int u, int mt, int lane) {
    const bool samp = u >= NUP; int c = 0, b = 0, h;
    if (!samp) { c = u / AH; h = u % AH; } else { const int s = u - NUP; b = s / AH; h = s % AH; if (mt > 0) return; }
    const int r = lane & 15, g4 = lane >> 4;
    const bf16_t* Q = (const bf16_t*)(p.ws + WS_QTT) + (size_t)u * 4096;
    bf16x8 a[2];
#pragma unroll
    for (int ks = 0; ks < 2; ++ks) a[ks] = *(const bf16x8*)(Q + (16 * mt + r) * 64 + 32 * ks + 8 * g4);
    f32x4 acc[4];
#pragma unroll
    for (int nt = 0; nt < 4; ++nt) {
        acc[nt] = *(const f32x4*)((const float*)(p.ws + WS_YLT) + (size_t)u * 4096 + ((mt * 4 + nt) * 64 + lane) * 4);
#pragma unroll
        for (int ks = 0; ks < 2; ++ks) {
            bf16x8 bb;
            if (!samp) bb = *(const bf16x8*)((const bf16_t*)(p.ws + WS_SC) + (size_t)u * 4096 + (16 * nt + r) * 64 + 32 * ks + 8 * g4);
            else { const float* S0 = PIN(p, I_SWKV) + (((size_t)l * DECB + b) * AH + h) * 4096 + (16 * nt + r) * 64 + 32 * ks + 8 * g4; bb = pack8(*(const f32x4*)S0, *(const f32x4*)(S0 + 4)); }
            acc[nt] = MFMA16(a[ks], bb, acc[nt]);
        }
    }
    float mean[4], rs[4];
#pragma unroll
    for (int reg = 0; reg < 4; ++reg) {
        float s = (acc[0][reg] + acc[1][reg]) + (acc[2][reg] + acc[3][reg]);
        s = sum16(s);
        const float mn = s * (1.0f / 64.0f); float v = 0.f;
#pragma unroll
        for (int nt = 0; nt < 4; ++nt) { const float d = acc[nt][reg] - mn; v += d * d; }
        v = sum16(v);
        mean[reg] = mn; rs[reg] = RSQRTF(v * (1.0f / 64.0f) + GN_EPS);
    }
    bf16_t* YA = (bf16_t*)(p.ws + WS_YA);
#pragma unroll
    for (int nt = 0; nt < 4; ++nt) {
        const int i = 16 * nt + r; const float gain = PIN(p, I_GNG)[(size_t)l * AW + 64 * h + i], bias = PIN(p, I_GNB)[(size_t)l * AW + 64 * h + i];
        const u32x2 g2 = *(const u32x2*)((const bf16_t*)(p.ws + WS_GT) + (size_t)u * 4096 + i * 64 + 16 * mt + 4 * g4);
        const u32x2 b2 = *(const u32x2*)((const bf16_t*)(p.ws + WS_BNT) + (size_t)u * 4096 + i * 64 + 16 * mt + 4 * g4);
        const float gg[4] = {bf2f(g2.x & 0xffffu), bf2f(g2.x >> 16), bf2f(g2.y & 0xffffu), bf2f(g2.y >> 16)};
        const float bn[4] = {bf2f(b2.x & 0xffffu), bf2f(b2.x >> 16), bf2f(b2.y & 0xffffu), bf2f(b2.y >> 16)};
#pragma unroll
        for (int reg = 0; reg < 4; ++reg) {
            const int t = 16 * mt + 4 * g4 + reg; const size_t row = samp ? (size_t)SEQ + 16 * b + t : (size_t)64 * c + t;
            const float y = ((acc[nt][reg] - mean[reg]) * rs[reg] * gain + bias + bn[reg]) * gg[reg];
            YA[row * AW + 64 * h + i] = (bf16_t)f2bf(y);
        }
    }
}

constexpr int AT_KB = 0, AT_VT = 24576, AT_QB = 49152;
constexpr float QSCALE = 0.125f * LOG2E;
DEV void attn_unit(const Params& p, int l, int au, LDSP lds, int tid) {
    const int lane = tid & 63, wave = WAVE_ID(tid), r = lane & 15, g4 = lane >> 4;
    const bool samp = au >= NAP; int c = 0, b = 0, kh, nk, kbase = 0, nq;
    if (!samp) { c = au / BKV; kh = au % BKV; nk = 64 * (c + 1 < 3 ? c + 1 : 3); kbase = 64 * (c > 2 ? c - 2 : 0); nq = 64 * GRP; }
    else { const int s = au - NAP; b = s / BKV; kh = s % BKV; nk = WIN + DECS; nq = DECS * GRP; }
    const float* PF = (const float*)(p.ws + WS_PF); const float* rope = (const float*)(p.ws + WS_ROPE);
    LDSP Kb = lds + AT_KB, Vt = lds + AT_VT, Qb = lds + AT_QB;
    const int sub = tid & 7, rowi = tid >> 3;
    f32x4 K1[3], K2[3], V1[3], V2[3], KC0[3], KC1[3];
#pragma unroll
    for (int pp = 0; pp < 3; ++pp) {
        const int kidx = pp * 64 + rowi;
        if (kidx < nk) {
            if (samp && kidx < WIN) {
                const size_t o = ((((size_t)l * DECB + b) * WIN + kidx) * BKV + kh) * 64; const float* ck = PIN(p, I_CK) + o; const float* cv = PIN(p, I_CV) + o;
                K1[pp] = *(const f32x4*)(ck + 4 * sub); K2[pp] = *(const f32x4*)(ck + 32 + 4 * sub); V1[pp] = *(const f32x4*)(cv + 4 * sub); V2[pp] = *(const f32x4*)(cv + 32 + 4 * sub);
            } else {
                const size_t tok = samp ? (size_t)SEQ + 16 * b + (kidx - WIN) : (size_t)kbase + kidx; const int slot = samp ? SEQ + (kidx - WIN) : (int)tok;
                const float* src = PF + tok * FW;
                K1[pp] = *(const f32x4*)(src + C_BK + 64 * kh + 4 * sub); K2[pp] = *(const f32x4*)(src + C_BK + 64 * kh + 32 + 4 * sub);
                V1[pp] = *(const f32x4*)(src + C_BV + 64 * kh + 4 * sub); V2[pp] = *(const f32x4*)(src + C_BV + 64 * kh + 32 + 4 * sub);
                KC0[pp] = *(const f32x4*)(rope + (size_t)slot * 64 + 8 * sub); KC1[pp] = *(const f32x4*)(rope + (size_t)slot * 64 + 8 * sub + 4);
            }
        }
    }
    f32x4 Q1[GRP], Q2[GRP], QC0[GRP], QC1[GRP];
#pragma unroll
    for (int pp = 0; pp < GRP; ++pp) {
        const int q = pp * 64 + rowi;
        if (q < nq) {
            const int g = samp ? q >> 4 : q >> 6, t = samp ? q & 15 : q & 63, head = kh * GRP + g;
            const size_t tok = samp ? (size_t)SEQ + 16 * b + t : (size_t)64 * c + t; const int slot = samp ? SEQ + t : (int)tok;
            const float* src = PF + tok * FW + C_Q + 64 * head;
            Q1[pp] = *(const f32x4*)(src + 4 * sub); Q2[pp] = *(const f32x4*)(src + 32 + 4 * sub);
            QC0[pp] = *(const f32x4*)(rope + (size_t)slot * 64 + 8 * sub); QC1[pp] = *(const f32x4*)(rope + (size_t)slot * 64 + 8 * sub + 4);
        }
    }
    const f32x4 kg1 = *(const f32x4*)(PIN(p, I_KN) + (size_t)l * 64 + 4 * sub), kg2 = *(const f32x4*)(PIN(p, I_KN) + (size_t)l * 64 + 32 + 4 * sub);
    const f32x4 qg1 = *(const f32x4*)(PIN(p, I_QN) + (size_t)l * 64 + 4 * sub), qg2 = *(const f32x4*)(PIN(p, I_QN) + (size_t)l * 64 + 32 + 4 * sub);
#pragma unroll
    for (int pp = 0; pp < 3; ++pp) {
        const int kidx = pp * 64 + rowi;
        if (kidx < nk) {
            f32x4 k1 = K1[pp], k2 = K2[pp]; const f32x4 v1 = V1[pp], v2 = V2[pp];
            if (!(samp && kidx < WIN)) {
                const size_t tok = samp ? (size_t)SEQ + 16 * b + (kidx - WIN) : (size_t)kbase + kidx;
                const f32x4 x1 = k1, x2 = k2;
                float ss = (x1[0] * x1[0] + x1[1] * x1[1]) + (x1[2] * x1[2] + x1[3] * x1[3]) + (x2[0] * x2[0] + x2[1] * x2[1]) + (x2[2] * x2[2] + x2[3] * x2[3]);
                ss = sum8(ss);
                const float rinv = RSQRTF(ss * (1.0f / 64.0f) + RMS_EPS);
                const float cc[4] = {KC0[pp][0], KC0[pp][2], KC1[pp][0], KC1[pp][2]}, sn[4] = {KC0[pp][1], KC0[pp][3], KC1[pp][1], KC1[pp][3]};
#pragma unroll
                for (int e = 0; e < 4; ++e) { const float y1 = x1[e] * rinv * kg1[e], y2 = x2[e] * rinv * kg2[e]; k1[e] = y1 * cc[e] - y2 * sn[e]; k2[e] = y2 * cc[e] + y1 * sn[e]; }
                if (samp) { const size_t o = ((((size_t)l * DECB + b) * DECS + (kidx - WIN)) * BKV + kh) * 64;
                    *(f32x4*)(p.out + O_SK + o + 4 * sub) = k1; *(f32x4*)(p.out + O_SK + o + 32 + 4 * sub) = k2; *(f32x4*)(p.out + O_SV + o + 4 * sub) = v1; *(f32x4*)(p.out + O_SV + o + 32 + 4 * sub) = v2; }
                else if (kidx >= nk - 64 && tok >= (size_t)(SEQ - WIN)) { const size_t o = (((size_t)l * WIN + (tok - (SEQ - WIN))) * BKV + kh) * 64;
                    *(f32x4*)(p.out + O_PK + o + 4 * sub) = k1; *(f32x4*)(p.out + O_PK + o + 32 + 4 * sub) = k2; *(f32x4*)(p.out + O_PV + o + 4 * sub) = v1; *(f32x4*)(p.out + O_PV + o + 32 + 4 * sub) = v2; }
            }
            u32x2 w; w.x = pk2(k1[0], k1[1]); w.y = pk2(k1[2], k1[3]); *(LAS u32x2*)(Kb + swz(kidx, 4 * sub)) = w;
            w.x = pk2(k2[0], k2[1]); w.y = pk2(k2[2], k2[3]); *(LAS u32x2*)(Kb + swz(kidx, 32 + 4 * sub)) = w;
#pragma unroll
            for (int e = 0; e < 4; ++e) { *(LAS bf16_t*)(Vt + swz192(4 * sub + e, kidx)) = (bf16_t)f2bf(v1[e]); *(LAS bf16_t*)(Vt + swz192(32 + 4 * sub + e, kidx)) = (bf16_t)f2bf(v2[e]); }
        } else if (kidx < ((nk + 31) & ~31)) {
#pragma unroll
            for (int e = 0; e < 4; ++e) { *(LAS bf16_t*)(Vt + swz192(4 * sub + e, kidx)) = 0; *(LAS bf16_t*)(Vt + swz192(32 + 4 * sub + e, kidx)) = 0; }
        }
    }
#pragma unroll
    for (int pp = 0; pp < GRP; ++pp) {
        const int q = pp * 64 + rowi;
        if (q < nq) {
            const f32x4 x1 = Q1[pp], x2 = Q2[pp];
            float ss = (x1[0] * x1[0] + x1[1] * x1[1]) + (x1[2] * x1[2] + x1[3] * x1[3]) + (x2[0] * x2[0] + x2[1] * x2[1]) + (x2[2] * x2[2] + x2[3] * x2[3]);
            ss = sum8(ss);
            const float rinv = RSQRTF(ss * (1.0f / 64.0f) + RMS_EPS) * QSCALE;
            const float cc[4] = {QC0[pp][0], QC0[pp][2], QC1[pp][0], QC1[pp][2]}, sn[4] = {QC0[pp][1], QC0[pp][3], QC1[pp][1], QC1[pp][3]};
            float o1[4], o2[4];
#pragma unroll
            for (int e = 0; e < 4; ++e) { const float y1 = x1[e] * rinv * qg1[e], y2 = x2[e] * rinv * qg2[e]; o1[e] = y1 * cc[e] - y2 * sn[e]; o2[e] = y2 * cc[e] + y1 * sn[e]; }
            u32x2 w; w.x = pk2(o1[0], o1[1]); w.y = pk2(o1[2], o1[3]); *(LAS u32x2*)(Qb + swz(q, 4 * sub)) = w;
            w.x = pk2(o2[0], o2[1]); w.y = pk2(o2[2], o2[3]); *(LAS u32x2*)(Qb + swz(q, 32 + 4 * sub)) = w;
        }
    }
    WG_SYNC_LDS();
    const int nqt = nq >> 4, nkt = nk >> 4;
    bf16_t* YB = (bf16_t*)(p.ws + WS_YB);
#pragma unroll 1
    for (int qt = wave; qt < nqt; qt += NWAVES) {
        const int g = samp ? qt : qt >> 2, head = kh * GRP + g;
        const float sink2 = PIN(p, I_SINK)[(size_t)l * BH + head] * LOG2E;
        bf16x8 bq[2];
#pragma unroll
        for (int ks = 0; ks < 2; ++ks) bq[ks] = *(const LAS bf16x8*)(Qb + swz(16 * qt + r, 32 * ks + 8 * g4));
        f32x4 s[12];
#pragma unroll
        for (int kt = 0; kt < 12; ++kt) { s[kt] = (f32x4){0.f, 0.f, 0.f, 0.f};
            if (kt < nkt) {
#pragma unroll
                for (int ks = 0; ks < 2; ++ks) { const bf16x8 a = *(const LAS bf16x8*)(Kb + swz(16 * kt + r, 32 * ks + 8 * g4)); s[kt] = MFMA16(a, bq[ks], s[kt]); } } }
        float mx = sink2;
#pragma unroll
        for (int kt = 0; kt < 12; ++kt) if (kt < nkt) mx = fmaxf(fmaxf(mx, fmaxf(s[kt][0], s[kt][1])), fmaxf(s[kt][2], s[kt][3]));
        mx = fmaxf(mx, SHFL_XOR(mx, 16)); mx = fmaxf(mx, SHFL_XOR(mx, 32));
        float sum = 0.f;
#pragma unroll
        for (int kt = 0; kt < 12; ++kt) if (kt < nkt) {
#pragma unroll
            for (int e = 0; e < 4; ++e) { s[kt][e] = EXP2F(s[kt][e] - mx); sum += s[kt][e]; } }
        sum += SHFL_XOR(sum, 16); sum += SHFL_XOR(sum, 32);
        const float rden = 1.0f / (sum + EXP2F(sink2 - mx));
        f32x4 o[4];
#pragma unroll
        for (int dt = 0; dt < 4; ++dt) o[dt] = (f32x4){0.f, 0.f, 0.f, 0.f};
#pragma unroll
        for (int s2 = 0; s2 < 6; ++s2) if (2 * s2 < nkt) {
            const bf16x8 pb = pack8(s[2 * s2], s[2 * s2 + 1]);
#pragma unroll
            for (int dt = 0; dt < 4; ++dt) {
                const bf16x4 lo = *(const LAS bf16x4*)(Vt + swz192(16 * dt + r, 32 * s2 + 4 * g4)), hi = *(const LAS bf16x4*)(Vt + swz192(16 * dt + r, 32 * s2 + 16 + 4 * g4));
                o[dt] = MFMA16(((bf16x8){lo[0], lo[1], lo[2], lo[3], hi[0], hi[1], hi[2], hi[3]}), pb, o[dt]);
            }
        }
        const int q = 16 * qt + r, t = samp ? q & 15 : q & 63; const size_t tok = samp ? (size_t)SEQ + 16 * b + t : (size_t)64 * c + t;
#pragma unroll
        for (int dt = 0; dt < 4; ++dt) { u32x2 w; w.x = pk2(o[dt][0] * rden, o[dt][1] * rden); w.y = pk2(o[dt][2] * rden, o[dt][3] * rden); *(u32x2*)(YB + tok * BQ + 64 * head + 16 * dt + 4 * g4) = w; }
    }
    WG_SYNC_LDS();
}

#ifndef EMU
#define XB_TMO      128
#define XB_XCNT(j)  (256  + 64 * (j))
#define XB_XSUB(j)  (1280 + 64 * (j))
#define XB_XGEN(j)  (2304 + 64 * (j))
#define XB_TOP      3328
#define XB_TOPGEN   3392
#define XCD_BAR_WORDS 3456
#define XB_SPIN_CAP (1u << 18)

__device__ __forceinline__ unsigned xb_ld(unsigned* p)              { return __hip_atomic_load(p, __ATOMIC_RELAXED, __HIP_MEMORY_SCOPE_AGENT); }
__device__ __forceinline__ unsigned xb_add(unsigned* p, unsigned v) { return __hip_atomic_fetch_add(p, v, __ATOMIC_RELAXED, __HIP_MEMORY_SCOPE_AGENT); }
__device__ __forceinline__ unsigned xb_xcc_id() { return (unsigned)__builtin_amdgcn_s_getreg((3 << 11) | 20) & 0xFu; }
#define XB_SPIN(cond, bar) do { unsigned _sp = 0; while (cond) { __builtin_amdgcn_s_sleep(1); \
    if ((++_sp & 255u) == 0u) { if (xb_ld(&(bar)[XB_TMO])) break; if (_sp > XB_SPIN_CAP) { atomicAdd(&(bar)[XB_TMO], 1u); break; } } } } while (0)

struct XcdBarrier {
    unsigned* bar; unsigned x;
    volatile LAS unsigned* st;
};

__device__ __forceinline__ XcdBarrier xcd_barrier_post(unsigned* bar, volatile LAS unsigned* st) {
    XcdBarrier b; b.bar = bar; b.x = xb_xcc_id(); b.st = st;
    if (threadIdx.x == 0) (void)xb_add(&bar[XB_XCNT(b.x)], 1u);
    return b;
}
__device__ __forceinline__ void xcd_barrier_complete(unsigned* bar, unsigned x, unsigned& nloc, unsigned& nx) {
    const unsigned G = gridDim.x * gridDim.y * gridDim.z;
    unsigned sum, cnt, mine, sp = 0u;
    for (;;) {
        sum = 0u; cnt = 0u; mine = 0u;
#pragma unroll
        for (unsigned j = 0; j < 16; ++j) { const unsigned c = xb_ld(&bar[XB_XCNT(j)]); sum += c; cnt += (c > 0u) ? 1u : 0u; mine = (j == x) ? c : mine; }
        if (sum == G) break;
        __builtin_amdgcn_s_sleep(1);
        if ((++sp & 255u) == 0u) { if (xb_ld(&bar[XB_TMO])) break; if (sp > XB_SPIN_CAP) { atomicAdd(&bar[XB_TMO], 1u); break; } }
    }
    nloc = mine > 0u ? mine : 1u; nx = cnt > 0u ? cnt : 1u;
}

__device__ __forceinline__ void xcd_barrier(const XcdBarrier& b) {
    asm volatile("s_waitcnt vmcnt(0)" ::: "memory");
    __syncthreads();
    if (threadIdx.x == 0) {
        unsigned* bar = b.bar;
        __builtin_amdgcn_s_waitcnt(0);
        unsigned nloc = b.st[0], nx = b.st[1];
        if (nloc == 0u) { xcd_barrier_complete(bar, b.x, nloc, nx); b.st[0] = nloc; b.st[1] = nx; }
        const unsigned old = xb_add(&bar[XB_XSUB(b.x)], 1u);
        const unsigned gen = old / nloc;
        if (old + 1u == (gen + 1u) * nloc) {
            __builtin_amdgcn_fence(__ATOMIC_RELEASE, "agent");
            asm volatile("s_waitcnt vmcnt(0)" ::: "memory");
            const unsigned og = xb_add(&bar[XB_TOP], 1u);
            const unsigned tg = og / nx;
            if (og + 1u == (tg + 1u) * nx) xb_add(&bar[XB_TOPGEN], 1u);
            else XB_SPIN(xb_ld(&bar[XB_TOPGEN]) == tg, bar);
            __builtin_amdgcn_fence(__ATOMIC_ACQUIRE, "agent");
            xb_add(&bar[XB_XGEN(b.x)], 1u);
            asm volatile("s_waitcnt vmcnt(0)" ::: "memory");
        } else {
            XB_SPIN(xb_ld(&bar[XB_XGEN(b.x)]) == gen, bar);
            __builtin_amdgcn_fence(__ATOMIC_ACQUIRE, "agent");
            asm volatile("s_waitcnt vmcnt(0)" ::: "memory");
        }
    }
    __syncthreads();
}
#endif

#ifndef REP_GU
#define REP_GU 1
#endif
#ifndef REP_DOWN
#define REP_DOWN 1
#endif
#ifndef REP_WIN
#define REP_WIN 1
#endif
#ifndef REP_UP
#define REP_UP 1
#endif
#ifndef REP_WO
#define REP_WO 1
#endif
#ifndef CONV_N_GU
#define CONV_N_GU 0
#endif
#ifndef CONV_N_WIN
#define CONV_N_WIN 0
#endif
#ifndef CONV_N_R2
#define CONV_N_R2 00
#endif
#ifndef CONV_N_GU
#define CONV_N_GU 0
#endif
#ifndef CONV_N_WIN
#define CONV_N_WIN 0
#endif
#ifndef CONV_N_R2
#define CONV_N_R2 0
#endif
#ifndef REP_PRO
#define REP_PRO 1
#endif
#ifndef REP_NORM
#define REP_NORM 1
#endif
#ifndef REP_R1
#define REP_R1 1
#endif
#ifndef REP_R2
#define REP_R2 1
#endif
#ifndef REP_R3
#define REP_R3 1
#endif

#ifndef EMU
#define GRID_BAR() do { XcdBarrier b_; b_.bar = (unsigned*)(P_WS() + WS_CTL) + CW_BAR; b_.x = xb_xcc_id(); b_.st = (volatile LAS unsigned*)(lds + LDS_CTL_OFF + 32); xcd_barrier(b_); } while (0)
constexpr int CW_BAR = 4096;
__global__ void __launch_bounds__(NTHR, 2) fwd(Params p) {
    extern __shared__ __attribute__((aligned(16))) unsigned char lds_raw[];
    LDSP lds = (LDSP)lds_raw;
    const int wave = __builtin_amdgcn_readfirstlane(TID() >> 6), G = GRID(), bid = BID();
    for (int u = TID(); u < (LDS_BYTES - LDS_CTL_OFF) / 4; u += NTHR) ((LAS unsigned*)(lds + LDS_CTL_OFF))[u] = 0u;
    __syncthreads();
    (void)xcd_barrier_post((unsigned*)(p.ws + WS_CTL) + CW_BAR, (volatile LAS unsigned*)(lds + LDS_CTL_OFF + 32));
#else
#define GRID_BAR() emu_grid_sync()
static void fwd(Params p) {
    g_emu_params = p;
    LDSP lds = emu_lds();
    const int wave = TID() >> 6, G = GRID(), bid = BID();
#endif
    const int gw = bid * NWAVES + wave, NGW = G * NWAVES, NGT = G * NTHR;
#define LANE_TID() const int lane = FRESH_LANE(), tid = wave * 64 + lane; (void)tid
    bf16_t* XB = (bf16_t*)(p.ws + WS_H);


#ifndef SKIP_PRO
    for (int rep_ = 0; rep_ < REP_PRO; ++rep_) { LANE_TID(); prologue(p, lds, gw, NGW, wave, lane, bid * NTHR + tid, NGT); x0_phase(p, gw, NGW, lane, bid * NTHR + tid, NGT); if (rep_ + 1 < REP_PRO) GRID_BAR(); }
    GRID_BAR();
#endif

#pragma unroll 1
    for (int it = 0; it < 2 * DEPTH; ++it) {
        const int l = it >> 1; const bool sec = (it & 1) != 0;
        const int Gq_ = OPAQUE_S(G), bq_ = OPAQUE_S(bid);
        const int nsi = 3 * l + (sec ? 2 : 0);

for (int rep_ = 0; rep_ < REP_GU; ++rep_) {
#ifndef SKIP_GU
        { pg8::Gemm g{XB, lwp(p, l, sec ? OFF_WGU2 : OFF_WGU1), M, 2 * DFF, DM}; pg8::StaticOrder S; S.init(M, 2 * DFF, Gq_, bq_);
          { LANE_TID(); rinv_table(S, nsi, lds, tid); }
          EpiSwiglu E{lds + LDS_RINV_OFF};
          pg8::gemm_phase<EpiSwiglu, pg8::StaticOrder, true, true>(lds, g, S, E, wave); }
        { constexpr int nwg_ = (M / 256) * (2 * DFF / 256); if (((nwg_ + G - 1) / G - 1) * G + bid >= nwg_) { LANE_TID(); conv_some(p, l + 1, CONV_N_GU, lds, wave, lane); } }
#endif

        GRID_BAR(); }

for (int rep_ = 0; rep_ < REP_DOWN; ++rep_) {
#ifndef SKIP_DOWN
        { pg8::Gemm g{(const bf16_t*)(p.ws + WS_G), lwp(p, l, sec ? OFF_WD2 : OFF_WD1), SEQ, DM, DFF}; pg8::StaticOrder S; S.init(SEQ, DM, Gq_, bq_);
          EpiResid E{0.5f / REP_DOWN, nsi + 1};
#pragma unroll 1
          for (int step = 0; step < 2; ++step) {
              if (((step ^ bid) & 1) == 0) pg8::gemm_phase<EpiResid, pg8::StaticOrder, true, true>(lds, g, S, E, wave);
              else {
#pragma unroll 1
                  for (int tile = bid; tile < (MS / 64) * (DM / 64); tile += G) { LANE_TID(); sgemm_tile(g.A, g.Bt, DFF, SEQ + 64 * (tile % (MS / 64)), 64 * (tile / (MS / 64)), lds, tid, E); } } } }
#endif
        if (rep_ + 1 < REP_DOWN) GRID_BAR(); }
        if (sec) { LANE_TID(); conv_some(p, l + 1, 1 << 30, lds, wave, lane); }

        if (it == 2 * DEPTH - 1) break;
        GRID_BAR();
        if (!sec) {


for (int rep_ = 0; rep_ < REP_WIN; ++rep_) {
#ifndef SKIP_WIN
            { pg8::Gemm g{XB, lwp(p, l, OFF_WIN), M, NIN, DM}; pg8::StaticOrder S; S.init(M, NIN, Gq_, bq_);
              { LANE_TID(); rinv_table(S, 3 * l + 1, lds, tid); }
              EpiWin E{lds + LDS_RINV_OFF};
              pg8::gemm_phase<EpiWin, pg8::StaticOrder, true, true>(lds, g, S, E, wave); }
            { constexpr int nwg_ = (M / 256) * (NIN / 256); if (((nwg_ + Gq_ - 1) / Gq_ - 1) * Gq_ + bq_ >= nwg_) { LANE_TID(); conv_some(p, l + 1, CONV_N_WIN, lds, wave, lane); } }
#endif

            GRID_BAR(); }

            for (int rep_ = 0; rep_ < REP_R1; ++rep_) {
#ifndef SKIP_R1
            { LANE_TID(); lact_phase(p, l, bq_ * NTHR + tid, NGT); }
            GRID_BAR();
            { LANE_TID(); R1IN_DECL; r1_fetch(p, l, bq_ < NU ? bq_ : 0, R1IN_ARGS, lane, wave);
#pragma unroll 1
              for (int u = bq_; u < NU; u += Gq_) r1_unit(p, l, u, u + Gq_ < NU ? u + Gq_ : u, R1IN_ARGS, lds, tid); }
#endif

            GRID_BAR(); }

            for (int rep_ = 0; rep_ < REP_R2; ++rep_) {
#ifndef SKIP_R2
            { constexpr int nchain = 4 * AH; LANE_TID();
              int a0, as_;
              if (Gq_ > nchain) {
                  if (bq_ < nchain) { r2_chain_ring(p, l, bq_, lds, wave, lane); a0 = 1 << 20; as_ = 1; }
                  else { a0 = bq_ - nchain; as_ = Gq_ - nchain; }
              } else {
#pragma unroll 1
                  for (int task = bq_; task < nchain; task += Gq_) r2_chain_ring(p, l, task, lds, wave, lane);
                  WG_SYNC();
                  a0 = bq_; as_ = Gq_;
              }
#pragma unroll 1
              for (int au = a0; au < NA; au += as_) attn_unit(p, l, au, lds, tid);
#pragma unroll 1
              for (int task = a0 * NWAVES + wave; task < 4 * NUS; task += as_ * NWAVES) r2_sample(p, l, task, lane);
              if (a0 < (1 << 20)) conv_some(p, l + 1, CONV_N_R2, lds, wave, lane);
            }
#endif

            GRID_BAR(); }

            for (int rep_ = 0; rep_ < REP_R3; ++rep_) {
#ifndef SKIP_R3
            { const int worker = bq_ * 2 + (wave >> 2), NW = 2 * Gq_; LANE_TID(); const int gtid = bq_ * NTHR + tid;
#pragma unroll 1
              for (int u = worker; u < NU; u += NW) r3_work(p, l, u, wave & 3, lane);
              const float* PF = (const float*)(p.ws + WS_PF);
              for (int idx = gtid; idx < (1 + DECB) * ACOLS; idx += NGT) { const int s = idx / ACOLS, col = idx % ACOLS;
                  if (s == 0) p.out[O_PSH + (size_t)l * ACOLS + col] = PF[(size_t)(SEQ - 1) * FW + col];
                  else p.out[O_SSH + ((size_t)l * DECB + (s - 1)) * ACOLS + col] = PF[((size_t)SEQ + 16 * (s - 1) + 15) * FW + col]; } }
#endif

            GRID_BAR(); }

for (int rep_ = 0; rep_ < REP_UP; ++rep_) {
#ifndef SKIP_UPA
            { pg8::Gemm g{(const bf16_t*)(p.ws + WS_YA), lwp(p, l, OFF_WUA), SEQ, DM, AW}; pg8::StaticOrder S; S.init(SEQ, DM, Gq_, bq_);
              EpiUpA E{0};
              pg8::gemm_phase<EpiUpA, pg8::StaticOrder, true, true>(lds, g, S, E, wave);
#pragma unroll 1
          for (int tile = bid; tile < (MS / 64) * (DM / 64); tile += G) { LANE_TID(); sgemm_tile(g.A, g.Bt, AW, SEQ + 64 * (tile % (MS / 64)), 64 * (tile / (MS / 64)), lds, tid, E); } }
#endif


#ifndef SKIP_UPB
            { pg8::Gemm g{(const bf16_t*)(p.ws + WS_YB), lwp(p, l, OFF_WUB), SEQ, DM, BQ}; pg8::StaticOrder S; S.init(SEQ, DM, Gq_, bq_);
              EpiUpB E{0};
              pg8::gemm_phase<EpiUpB, pg8::StaticOrder, true, true>(lds, g, S, E, wave);
#pragma unroll 1
          for (int tile = bid; tile < (MS / 64) * (DM / 64); tile += G) { LANE_TID(); sgemm_tile(g.A, g.Bt, BQ, SEQ + 64 * (tile % (MS / 64)), 64 * (tile / (MS / 64)), lds, tid, E); } }
#endif

            GRID_BAR(); }
for (int rep_ = 0; rep_ < REP_WO; ++rep_) {
#ifndef SKIP_WO
            { pg8::Gemm g{(const bf16_t*)(p.ws + WS_MG), lwp(p, l, OFF_WO), SEQ, DM, DM}; pg8::StaticOrder S; S.init(SEQ, DM, Gq_, bq_);
              EpiResid E{1.0f / REP_WO, 3 * l + 2};
              pg8::gemm_phase<EpiResid, pg8::StaticOrder, true, true>(lds, g, S, E, wave);
#pragma unroll 1
          for (int tile = bid; tile < (MS / 64) * (DM / 64); tile += G) { LANE_TID(); sgemm_tile(g.A, g.Bt, DM, SEQ + 64 * (tile % (MS / 64)), 64 * (tile / (MS / 64)), lds, tid, E); } }
#endif

            GRID_BAR(); }
        }
    }
}

#ifndef EMU
extern "C" void kernel_launch(void* const* d_in, const int* in_sizes, int n_in, void* d_out, int out_size, void* d_ws, size_t ws_size, hipStream_t stream) {
    static int grid = 0;
    if (grid == 0) {
        if (n_in != 33 || (size_t)out_size != O_END || ws_size < WS_END) { fprintf(stderr, "kernel_launch: unexpected shapes (n_in %d, out %d, ws %zu, need %zu)\n", n_in, out_size, ws_size, (size_t)WS_END); grid = -1; return; }
        int dev = 0, cus = 0, per_cu = 0;
        if (hipGetDevice(&dev) != hipSuccess || hipDeviceGetAttribute(&cus, hipDeviceAttributeMultiprocessorCount, dev) != hipSuccess) { grid = -1; return; }
        if (hipFuncSetAttribute((const void*)fwd, hipFuncAttributeMaxDynamicSharedMemorySize, LDS_BYTES) != hipSuccess) { fprintf(stderr, "kernel_launch: hipFuncSetAttribute failed\n"); grid = -1; return; }
        if (hipOccupancyMaxActiveBlocksPerMultiprocessor(&per_cu, (const void*)fwd, NTHR, LDS_BYTES) != hipSuccess || per_cu < 1) fprintf(stderr, "kernel_launch: occupancy query reports %d\n", per_cu);
        (void)hipGetLastError();
        grid = cus;
    }
    if (grid < 0) return;
    if (hipMemsetAsync((char*)d_ws + WS_CTL, 0, CTL_BYTES, stream) != hipSuccess) return;
    Params p{};
    for (int i = 0; i < 33; ++i) p.in[i] = (const float*)d_in[i];
    p.out = (float*)d_out; p.ws = (unsigned char*)d_ws;
    hipLaunchKernelGGL(fwd, dim3(grid), dim3(NTHR), LDS_BYTES, stream, p);
}
#endif
```

```cpp
#ifndef EMU
#include <hip/hip_runtime.h>
#include <cstdio>
#include <cstdint>
#endif

#ifndef CFG_SMALL
constexpr int DM = 2048, SEQ = 8192, DEPTH = 4, DECB = 32, DECS = 16, PAST = 1024, AW = 1024, BH = 16, BKV = 4, DFF = 5504;
#else
constexpr int DM = 256, SEQ = 256, DEPTH = 2, DECB = 16, DECS = 16, PAST = 1024, AW = 256, BH = 4, BKV = 1, DFF = 384;
#endif
constexpr int HD = 64, AH = AW / HD, DLORA = 64, ILORA = 64, GLORA = 160, WIN = 128, GRP = BH / BKV;
constexpr int ACOLS = 3 * AW + DLORA + ILORA + GLORA, BQ = BH * HD, BKVW = BKV * HD, INCOLS = ACOLS + BQ + 2 * BKVW + 2 * DM;
constexpr int MS = DECB * DECS, M = SEQ + MS;
constexpr int FW_RAW = ACOLS + BQ + 2 * BKVW, FW = ((FW_RAW + 255) / 256) * 256, NIN = FW + 2 * DM;
constexpr int C_R = 0, C_WLO = AW, C_K = AW + DLORA, C_V = 2 * AW + DLORA, C_ALO = 3 * AW + DLORA, C_GLO = C_ALO + ILORA, C_Q = ACOLS, C_BK = ACOLS + BQ, C_BV = C_BK + BKVW;
constexpr int NCH = SEQ / 64, NUP = NCH * AH, NUS = DECB * AH, NU = NUP + NUS;
constexpr int NAP = NCH * BKV, NAS = DECB * BKV, NA = NAP + NAS;
constexpr float RMS_EPS = 1e-6f, GN_EPS = 64e-5f, LOG2E = 1.4426950408889634f;
static_assert(AW == BQ && (AW + BQ) % 256 == 0 && M % 256 == 0 && DM % 256 == 0 && DFF % 128 == 0 && AW % 128 == 0 && BQ % 128 == 0 && FW_RAW % 32 == 0 && DECS == 16 && GRP == 4, "shape constraints");

constexpr size_t O_YP = 0, O_YS = (size_t)SEQ * DM, O_PWKV = O_YS + (size_t)MS * DM, O_PSH = O_PWKV + (size_t)DEPTH * AH * 4096, O_PK = O_PSH + (size_t)DEPTH * ACOLS,
                 O_PV = O_PK + (size_t)DEPTH * WIN * BKVW, O_SWKV = O_PV + (size_t)DEPTH * WIN * BKVW, O_SSH = O_SWKV + (size_t)DEPTH * DECB * AH * 4096,
                 O_SK = O_SSH + (size_t)DEPTH * DECB * ACOLS, O_SV = O_SK + (size_t)DEPTH * DECB * DECS * BKVW, O_END = O_SV + (size_t)DEPTH * DECB * DECS * BKVW;

constexpr size_t al256(size_t x) { return (x + 255) & ~(size_t)255; }
constexpr size_t WS_CTL = 0, CTL_BYTES = 1u << 20;
constexpr size_t WS_ROPE = CTL_BYTES, ROPE_BYTES = al256((size_t)(SEQ + DECS) * 64 * 4);
constexpr int NSS = 3 * DEPTH + 1;
constexpr int NSLOT = DM / 32;
constexpr size_t WS_SS = WS_ROPE + ROPE_BYTES, SS_BYTES = al256((size_t)NSS * NSLOT * M * 4);
static_assert(NSLOT <= 64, "slots written one per lane");
constexpr size_t WS_W = WS_SS + SS_BYTES;
constexpr size_t SZ_WGU = (size_t)2 * DFF * DM * 2, SZ_WD = (size_t)DM * DFF * 2, SZ_WIN = (size_t)NIN * DM * 2, SZ_WUA = (size_t)DM * (AW + BQ) * 2  , SZ_WUB = 0, SZ_WO = (size_t)DM * DM * 2;
constexpr size_t OFF_WGU1 = 0, OFF_WD1 = OFF_WGU1 + SZ_WGU, OFF_WIN = OFF_WD1 + SZ_WD, OFF_WUA = OFF_WIN + SZ_WIN, OFF_WUB = OFF_WUA + SZ_WUA, OFF_WO = OFF_WUB + SZ_WUB,
                 OFF_WGU2 = OFF_WO + SZ_WO, OFF_WD2 = OFF_WGU2 + SZ_WGU, OFF_DW2T = OFF_WD2 + SZ_WD, OFF_IA2T = OFF_DW2T + (size_t)AW * 64 * 2, OFF_GG2T = OFF_IA2T + (size_t)AW * 64 * 2,
                 LAYER_W_BYTES = al256(OFF_GG2T + (size_t)AW * 160 * 2);
constexpr size_t WS_H = WS_W + (size_t)DEPTH * LAYER_W_BYTES;
constexpr size_t WS_PF = WS_H + al256((size_t)M * DM * 2);
constexpr size_t WS_SG = WS_PF + al256((size_t)M * FW * 2);
constexpr size_t WS_YA = WS_SG + al256((size_t)M * 2 * DM * 2);
constexpr int YLD = AW + BQ;
constexpr size_t WS_MG = WS_YA + al256((size_t)M * YLD * 2);
constexpr size_t WS_OV = WS_MG + al256((size_t)M * DM * 2);
constexpr size_t WS_G = WS_OV;
constexpr size_t WS_T1 = WS_OV;
constexpr size_t WS_PCT = WS_T1 + al256((size_t)M * DM * 4);
constexpr size_t WS_UCS = WS_PCT + (size_t)NU * 8192;
constexpr size_t WS_QTT = WS_UCS + (size_t)NU * 16384;
constexpr size_t WS_YLT = WS_QTT + (size_t)NU * 8192;
constexpr size_t WS_GT = WS_YLT + (size_t)NU * 16384;
constexpr size_t WS_BNT = WS_GT + (size_t)NU * 8192;
constexpr size_t WS_SC = WS_BNT + (size_t)NU * 8192;
constexpr size_t WS_LACT = WS_SC + (size_t)NUP * 8192;
constexpr size_t WS_OV_END_A = WS_LACT + al256((size_t)M * 288 * 2), WS_OV_END_B = WS_G + al256((size_t)M * DFF * 2);
constexpr size_t WS_END = WS_OV_END_A > WS_OV_END_B ? WS_OV_END_A : WS_OV_END_B;

constexpr int LDS_BYTES = 159744;
constexpr int LDS_CTL_OFF = LDS_BYTES - 1024;
constexpr int NWAVES = 8, NTHR = 512;
constexpr int CW_CONV = 8192;
constexpr int LDS_RINV_OFF = 131072;
static_assert(LDS_RINV_OFF + 8 * 1024 <= LDS_CTL_OFF, "rinv tables");

typedef unsigned short bf16_t;
typedef short bf16x8 __attribute__((ext_vector_type(8)));
typedef short bf16x4 __attribute__((ext_vector_type(4)));
typedef float f32x4 __attribute__((ext_vector_type(4)));
typedef unsigned u32x4 __attribute__((ext_vector_type(4)));
typedef unsigned u32x2 __attribute__((ext_vector_type(2)));
#ifdef EMU
#define LAS
#define TID() emu_tid()
#define BID() emu_bid()
#define GRID() emu_grid()
#define WG_SYNC() emu_wg_sync()
#define MFMA16(a, b, c) emu_mfma16(a, b, c)
#define SHFL_XOR(v, m) emu_shfl_xor(v, m)
#define DEV static inline
#define DEVM inline
#define EXP2F(x) exp2f(x)
#define RSQRTF(x) (1.0f / sqrtf(x))
#define WAVE_FENCE() emu_wave_sync()
#define WAVE_ID(t) ((t) >> 6)
#define PIN(p, i) ((p).in[i])
#define P_WS() (g_emu_params.ws)
#define P_OUT() (g_emu_params.out)
#define FRESH_LANE() (emu_tid() & 63)
#define SPIN_WAIT() emu_yield()
#define WG_SYNC_LDS() emu_wg_sync()
#define OPAQUE_S(x) (x)
#define OPAQUE_V(x) (x)
static inline int claim_item(unsigned* ctr, unsigned inc, int lane) { (void)lane;
    static unsigned emu_last[1 << 16]; const int key = (emu_bid() * 8 + (emu_tid() >> 6)) & 0xffff; if ((emu_tid() & 63) == 0) { emu_last[key] = *ctr; *ctr += inc; } emu_wave_sync(); const unsigned v = emu_last[key]; emu_wave_sync(); return (int)v; }
#define ATOMIC_ADD_U64(ptr, v) (*(ptr) += (v))
#define RCPF(x) (1.0f / (x))
#define LOG2F_(x) log2f(x)
static inline float sum8(float v) { v += emu_shfl_xor(v, 1); v += emu_shfl_xor(v, 2); v += emu_shfl_xor(v, 4); return v; }
static inline float sum16(float v) { v = sum8(v); v += emu_shfl_xor(v, 8); return v; }
static inline float sum64(float v) { v = sum16(v); v += emu_shfl_xor(v, 16); v += emu_shfl_xor(v, 32); return v; }
#define LDS_DRAIN() do { } while (0)
#define COMPILER_FENCE() do { } while (0)
#else
#define LAS __attribute__((address_space(3)))
#define TID() ((int)threadIdx.x)
#define BID() ((int)blockIdx.x)
#define GRID() ((int)gridDim.x)
#define WG_SYNC() __syncthreads()
#define MFMA16(a, b, c) __builtin_amdgcn_mfma_f32_16x16x32_bf16(a, b, c, 0, 0, 0)
#define SHFL_XOR(v, m) __shfl_xor(v, m)
#define DEV __device__ __forceinline__
#define DEVM __device__ __forceinline__
#define EXP2F(x) __builtin_amdgcn_exp2f(x)
#define RSQRTF(x) (1.0f / sqrtf(x))
#define WAVE_FENCE() asm volatile("s_waitcnt lgkmcnt(0)" ::: "memory")
#define WAVE_ID(t) __builtin_amdgcn_readfirstlane((t) >> 6)
#define PIN(p, i) pin_load(i)
#define P_WS() ((unsigned char*)pin_load(34))
#define P_OUT() ((float*)pin_load(33))
#define FRESH_LANE() fresh_lane()
#define SPIN_WAIT() __builtin_amdgcn_s_sleep(1)
#define WG_SYNC_LDS() asm volatile("s_waitcnt lgkmcnt(0)\n\ts_barrier" ::: "memory")
__device__ __forceinline__ int opaque_s(int x) { asm volatile("" : "+s"(x)); return x; }
#define OPAQUE_S(x) opaque_s(x)
__device__ __forceinline__ int opaque_v(int x) { asm volatile("" : "+v"(x)); return x; }
#define OPAQUE_V(x) opaque_v(x)
__device__ __forceinline__ int claim_item(unsigned* ctr, unsigned inc, int lane) { unsigned v = 0; if (lane == 0) v = __hip_atomic_fetch_add((__attribute__((address_space(1))) unsigned*)ctr, inc, __ATOMIC_RELAXED, __HIP_MEMORY_SCOPE_AGENT); return __builtin_amdgcn_readfirstlane(v); }
#define ATOMIC_ADD_U64(ptr, v) ((void)__hip_atomic_fetch_add((__attribute__((address_space(1))) unsigned long long*)(ptr), (v), __ATOMIC_RELAXED, __HIP_MEMORY_SCOPE_AGENT))
#define RCPF(x) __builtin_amdgcn_rcpf(x)
#define LOG2F_(x) __builtin_amdgcn_logf(x)
__device__ __forceinline__ float dpp_add(float v, const int ctrl_sel) {
    const int x = __builtin_bit_cast(int, v); int y;
    if (ctrl_sel == 0) y = __builtin_amdgcn_update_dpp(0, x, 0xB1, 0xF, 0xF, false); else if (ctrl_sel == 1) y = __builtin_amdgcn_update_dpp(0, x, 0x4E, 0xF, 0xF, false);
    else if (ctrl_sel == 2) y = __builtin_amdgcn_update_dpp(0, x, 0x141, 0xF, 0xF, false); else y = __builtin_amdgcn_update_dpp(0, x, 0x140, 0xF, 0xF, false);
    return v + __builtin_bit_cast(float, y);
}
__device__ __forceinline__ float sum8(float v) { v = dpp_add(v, 0); v = dpp_add(v, 1); v = dpp_add(v, 2); return v; }
__device__ __forceinline__ float sum16(float v) { v = sum8(v); v = dpp_add(v, 3); return v; }
__device__ __forceinline__ float sum64(float v) { v = sum16(v); v += __shfl_xor(v, 16); v += __shfl_xor(v, 32); return v; }
#define LDS_DRAIN() asm volatile("s_waitcnt lgkmcnt(0)" ::: "memory")
#define COMPILER_FENCE() asm volatile("" ::: "memory")
__device__ __forceinline__ int fresh_lane() { int l; asm volatile("v_mbcnt_lo_u32_b32 %0, -1, 0\n\tv_mbcnt_hi_u32_b32 %0, -1, %0" : "=v"(l)); return l; }
#endif
typedef LAS unsigned char* LDSP;
typedef unsigned long long ssq_t;
constexpr float SSQ_SCALE = 1048576.0f, SSQ_INV = 1.0f / 1048576.0f;
constexpr double TWO_PI = 6.283185307179586476925286766559;
#ifdef EMU
static const double ROPE_INV[32] = {1.0, 0.7498942093324559, 0.5623413251903491, 0.4216965034285822, 0.31622776601683794, 0.23713737056616552, 0.1778279410038923, 0.1333521432163324, 0.1, 0.07498942093324558, 0.05623413251903491, 0.042169650342858224, 0.03162277660168379, 0.023713737056616554, 0.01778279410038923, 0.01333521432163324, 0.01, 0.007498942093324558, 0.005623413251903491, 0.004216965034285823, 0.0031622776601683794, 0.0023713737056616554, 0.0017782794100389228, 0.001333521432163324, 0.001, 0.0007498942093324559, 0.0005623413251903491, 0.00042169650342858224, 0.00031622776601683794, 0.00023713737056616554, 0.00017782794100389227, 0.0001333521432163324};
#else
__device__ const double ROPE_INV[32] = {1.0, 0.7498942093324559, 0.5623413251903491, 0.4216965034285822, 0.31622776601683794, 0.23713737056616552, 0.1778279410038923, 0.1333521432163324, 0.1, 0.07498942093324558, 0.05623413251903491, 0.042169650342858224, 0.03162277660168379, 0.023713737056616554, 0.01778279410038923, 0.01333521432163324, 0.01, 0.007498942093324558, 0.005623413251903491, 0.004216965034285823, 0.0031622776601683794, 0.0023713737056616554, 0.0017782794100389228, 0.001333521432163324, 0.001, 0.0007498942093324559, 0.0005623413251903491, 0.00042169650342858224, 0.00031622776601683794, 0.00023713737056616554, 0.00017782794100389227, 0.0001333521432163324};
#endif

struct Params { const float* in[33]; float* out; unsigned char* ws; };
#ifdef EMU
static Params g_emu_params;
#endif
#ifndef EMU
__device__ __forceinline__ const float* pin_load(int i) {
    const __attribute__((address_space(4))) char* k = (const __attribute__((address_space(4))) char*)__builtin_amdgcn_kernarg_segment_ptr();
    asm volatile("" : "+s"(k));
    return *(const float* const __attribute__((address_space(4)))*)(k + 8 * i);
}
#endif
enum { I_XP = 0, I_XS, I_CK, I_CV, I_SWKV, I_SSH, I_NFF1, I_F1G, I_F1U, I_F1D, I_NMIX, I_WIN, I_MU, I_DW0, I_DW2, I_IA0, I_IA2, I_GG2, I_KK, I_KA, I_RK, I_GNG, I_GNB, I_QN, I_KN, I_SINK,
       I_WUA, I_WUB, I_WO, I_NFF2, I_F2G, I_F2U, I_F2D };

#ifdef EMU
DEV unsigned f2bf(float f) { unsigned u = __builtin_bit_cast(unsigned, f); return (u + 0x7fffu + ((u >> 16) & 1u)) >> 16; }
DEV unsigned pk2(float lo, float hi) { return f2bf(lo) | (f2bf(hi) << 16); }
#else
typedef float f32x2_t_ __attribute__((ext_vector_type(2))); typedef __bf16 bf16x2_t_ __attribute__((ext_vector_type(2)));
DEV unsigned pk2(float lo, float hi) { f32x2_t_ v = {lo, hi}; bf16x2_t_ b = __builtin_convertvector(v, bf16x2_t_); return __builtin_bit_cast(unsigned, b); }
DEV unsigned f2bf(float f) { return pk2(f, 0.f) & 0xffffu; }
#endif
DEV float bf2f(unsigned h) { return __builtin_bit_cast(float, h << 16); }
DEV f32x4 ldbf4(const bf16_t* q) { const u32x2 w = *(const u32x2*)q; f32x4 o; o[0] = bf2f(w.x & 0xffffu); o[1] = __builtin_bit_cast(float, w.x & 0xffff0000u); o[2] = bf2f(w.y & 0xffffu); o[3] = __builtin_bit_cast(float, w.y & 0xffff0000u); return o; }
DEV bf16_t* lwp(const Params& p, int l, size_t off) { return (bf16_t*)(p.ws + WS_W + (size_t)l * LAYER_W_BYTES + off); }
DEV float wave_sum(float v) { return sum64(v); }
DEV float sigmoidf_(float x) { return RCPF(1.0f + EXP2F(-x * LOG2E)); }
DEV float tanhf_(float x) { return 1.0f - 2.0f * RCPF(1.0f + EXP2F(x * (2.0f * LOG2E))); }
DEV float expf_(float x) { return EXP2F(x * LOG2E); }
DEV float softplusf_(float z) { return fmaxf(z, 0.f) + LOG2F_(1.0f + EXP2F(-fabsf(z) * LOG2E)) * 0.6931471805599453f; }
DEV int swz(int row, int col) { return row * 128 + ((((col >> 3) ^ row) & 7) << 4) + ((col & 7) << 1); }
DEV int swz192(int row, int col) { const int ch = col >> 3; return row * 384 + (((ch & ~7) | ((ch ^ row) & 7)) << 4) + ((col & 7) << 1); }
DEV f32x4 mm64(LDSP A, int m0, LDSP B, int n0, f32x4 acc, int lane) {
    const int r = lane & 15, g4 = lane >> 4;
#pragma unroll
    for (int ks = 0; ks < 2; ++ks) {
        const bf16x8 a = *(const LAS bf16x8*)(A + swz(m0 + r, 32 * ks + 8 * g4));
        const bf16x8 b = *(const LAS bf16x8*)(B + swz(n0 + r, 32 * ks + 8 * g4));
        acc = MFMA16(a, b, acc);
    }
    return acc;
}
DEV void st_tile(LDSP O, int m0, int n0, f32x4 v, int lane) {
    const int r = lane & 15, g4 = lane >> 4;
#pragma unroll
    for (int reg = 0; reg < 4; ++reg) *(LAS bf16_t*)(O + swz(m0 + 4 * g4 + reg, n0 + r)) = (bf16_t)f2bf(v[reg]);
}
DEV void st_tile_T(LDSP O, int m0, int n0, f32x4 v, int lane) {
    const int r = lane & 15, g4 = lane >> 4;
    u32x2 w; w.x = pk2(v[0], v[1]); w.y = pk2(v[2], v[3]);
    *(LAS u32x2*)(O + swz(n0 + r, m0 + 4 * g4)) = w;
}
DEV bf16x8 pack8(f32x4 lo, f32x4 hi) {
    u32x4 w; w.x = pk2(lo[0], lo[1]); w.y = pk2(lo[2], lo[3]); w.z = pk2(hi[0], hi[1]); w.w = pk2(hi[2], hi[3]);
    return __builtin_bit_cast(bf16x8, w);
}

namespace pg8 {
#define PG8_LAS __attribute__((address_space(3)))
typedef unsigned short bf16_t;
typedef short bf16x8 __attribute__((ext_vector_type(8)));
typedef float f32x4 __attribute__((ext_vector_type(4)));
typedef unsigned u32x4 __attribute__((ext_vector_type(4)));
constexpr int BM = 256, BK = 64, HALF = 128, HTB = HALF * BK * 2  , STAGE_BYTES = 8 * HTB, NXCD = 8, WGM = 8;

__host__ __device__ __forceinline__ int lds_byte(int r, int c) { const int st = (r >> 4) * 2 + (c >> 5), rr = r & 15, cc = c & 31, ob = rr * 64 + cc * 2; return st * 1024 + (ob ^ (((ob >> 9) & 1) << 5)); }
__host__ __device__ __forceinline__ void stage_rc(int b, int& R, int& C) { const int st = b / 1024, sb = b % 1024, swz = sb ^ (((sb >> 9) & 1) << 5); R = (st >> 1) * 16 + swz / 64; C = (st & 1) * 32 + (swz % 64) / 2; }
__host__ __device__ __forceinline__ int perm32(int rho) { const int n = rho >> 4, i = rho & 15; return 8 * (i >> 2) + 4 * n + (i & 3); }

struct Unit { int pm, pn, idx; };
struct Gemm { const bf16_t* A; const bf16_t* Bt; int M, N, K; };

struct StaticOrder {
    int nM, nN, nwg, G, c;
    __host__ __device__ void init(int M, int N, int G_, int c_) { nM = M / BM; nN = N / BM; nwg = nM * nN; G = G_; c = c_; }
    __host__ __device__ bool next(int i, Unit& u) const {
        const long L = (long)i * G + c; if (L >= nwg) return false;
        int wgid = (int)L; { const int q = nwg / NXCD, r = nwg % NXCD, xcd = wgid % NXCD, off = wgid / NXCD; wgid = (xcd < r ? xcd * (q + 1) : r * (q + 1) + (xcd - r) * q) + off; }
        const int nig = WGM * nN, gid = wgid / nig, fm = gid * WGM, gsz = (nM - fm) < WGM ? (nM - fm) : WGM;
        u.pm = fm + ((wgid % nig) % gsz); u.pn = (wgid % nig) / gsz; u.idx = i; return true;
    }
    __device__ __forceinline__ void a_ready(const Unit&) const {}
    __device__ __forceinline__ void done(const Unit&) const {}
};

#ifndef EMU
template <class Epi, class Sched, bool ALIGN_EPI = false, bool SP2 = false>
__device__ __forceinline__ void gemm_phase(PG8_LAS unsigned char* lds, const Gemm g, const Sched& S, const Epi& E, const int wid) {
    const int lane = ::fresh_lane(), tid = wid * 64 + lane, wr = wid >> 2, wc = wid & 3, fr = lane & 15, fq = lane >> 4;
    const int K = g.K, nt = K / BK;
    unsigned voffA[2], voffB[2];
#pragma unroll
    for (int i = 0; i < 2; ++i) { int R, C; stage_rc(tid * 16 + i * 8192, R, C); const int Rb = Epi::PERM ? ((R & ~31) + perm32(R & 31)) : R;
        voffA[i] = (unsigned)(R * K + C) * 2u; voffB[i] = (unsigned)(Rb * K + C) * 2u; }
    const size_t kstep = (size_t)(BK * 2);
    const size_t hstep = (size_t)HALF * K * 2;
    const size_t tstep = 2 * hstep;
    const unsigned ldsw = (unsigned)wid * 1024u;
    const int aoff = lds_byte(wr * 64 + fr, fq * 8), boff = lds_byte(wc * 32 + fr, fq * 8);
#define PG8_SA(b, h) (((b) * 2 + (h)) * HTB)
#define PG8_SB(b, h) ((4 + (b) * 2 + (h)) * HTB)
#define PG8_STAGE(bufoff, gbase, voff) do { _Pragma("unroll") for (int _i = 0; _i < 2; ++_i) \
        __builtin_amdgcn_global_load_lds((const unsigned*)((const char*)(gbase) + (voff)[_i]), (PG8_LAS unsigned*)(lds + (bufoff) + ldsw + _i * 8192), 16, 0, 0); } while (0)
#define PG8_LDA(dst, b, h) do { _Pragma("unroll") for (int m = 0; m < 4; ++m) _Pragma("unroll") for (int k = 0; k < 2; ++k) dst[m][k] = *(const PG8_LAS bf16x8*)(lds + PG8_SA(b, h) + aoff + m * 2048 + k * 1024); } while (0)
#define PG8_LDB(dst, b, h) do { _Pragma("unroll") for (int n = 0; n < 2; ++n) _Pragma("unroll") for (int k = 0; k < 2; ++k) dst[n][k] = *(const PG8_LAS bf16x8*)(lds + PG8_SB(b, h) + boff + n * 2048 + k * 1024); } while (0)
#define PG8_MMA(ai, bj, At, Bt) do { __builtin_amdgcn_s_setprio(1); _Pragma("unroll") for (int m = 0; m < 4; ++m) _Pragma("unroll") for (int n = 0; n < 2; ++n) _Pragma("unroll") for (int k = 0; k < 2; ++k) \
        acc[ai][bj][m][n] = __builtin_amdgcn_mfma_f32_16x16x32_bf16(Bt[n][k], At[m][k], acc[ai][bj][m][n], 0, 0, 0); __builtin_amdgcn_s_setprio(0); } while (0)
#define PG8_WAIT_V(n) asm volatile("s_waitcnt vmcnt(" #n ")" ::: "memory")
#define PG8_WAIT_L(n) asm volatile("s_waitcnt lgkmcnt(" #n ")" ::: "memory")
#define PG8_BAR __builtin_amdgcn_s_barrier()
#define PG8_SCHED __builtin_amdgcn_sched_barrier(0)
    Unit cur, nxt; int ui = 0;
    if (!S.next(0, cur)) return;
    f32x4 acc[2][2][4][2];
#pragma unroll
    for (int a = 0; a < 2; ++a)
#pragma unroll
        for (int b = 0; b < 2; ++b)
#pragma unroll
            for (int m = 0; m < 4; ++m)
#pragma unroll
                for (int n = 0; n < 2; ++n) acc[a][b][m][n] = (f32x4){0.f, 0.f, 0.f, 0.f};
    bf16x8 At[4][2], B0[2][2], B1[2][2];
    const char* cA = (const char*)g.A + (size_t)cur.pm * tstep; const char* cB = (const char*)g.Bt + (size_t)cur.pn * tstep;
    S.a_ready(cur);
    if constexpr (SP2) {
        PG8_STAGE(PG8_SB(0, 0), cB, voffB); PG8_STAGE(PG8_SB(0, 1), cB + hstep, voffB); PG8_STAGE(PG8_SA(0, 0), cA, voffA); PG8_STAGE(PG8_SA(0, 1), cA + hstep, voffA);
        if (wr == 1) PG8_BAR;
        PG8_WAIT_V(2); PG8_BAR;
        PG8_STAGE(PG8_SB(1, 0), cB + kstep, voffB); PG8_STAGE(PG8_SA(1, 0), cA + kstep, voffA); PG8_STAGE(PG8_SB(1, 1), cB + hstep + kstep, voffB);
        PG8_WAIT_V(6); PG8_BAR;
    } else {
        PG8_STAGE(PG8_SB(0, 0), cB, voffB); PG8_STAGE(PG8_SA(0, 0), cA, voffA); PG8_STAGE(PG8_SB(0, 1), cB + hstep, voffB); PG8_STAGE(PG8_SA(0, 1), cA + hstep, voffA);
        if (wr == 1) PG8_BAR;
        PG8_WAIT_V(4); PG8_BAR;
        PG8_STAGE(PG8_SB(1, 0), cB + kstep, voffB); PG8_STAGE(PG8_SA(1, 0), cA + kstep, voffA); PG8_STAGE(PG8_SB(1, 1), cB + hstep + kstep, voffB);
        PG8_WAIT_V(6); PG8_BAR;
    }
    for (;;) {
        const bool has_next = S.next(ui + 1, nxt);
        const char* nA = has_next ? (const char*)g.A + (size_t)nxt.pm * tstep : cA; const char* nB = has_next ? (const char*)g.Bt + (size_t)nxt.pn * tstep : cB;
        for (int t = 0; t < nt; t += 2) {
            if constexpr (Epi::MID) { if (t == (nt >> 1)) E.mid(acc, cur, wr, wc, fr, fq); }
            const bool last = (t == nt - 2);
            const char* a1 = cA + (size_t)(t + 1) * kstep;
            const char* a2 = last ? nA : cA + (size_t)(t + 2) * kstep; const char* b2 = last ? nB : cB + (size_t)(t + 2) * kstep;
            const char* a3 = a2 + kstep; const char* b3 = b2 + kstep;
            if (last && has_next) S.a_ready(nxt);
            if constexpr (SP2) {
            PG8_LDB(B0, 0, 0); PG8_LDB(B1, 0, 1); PG8_SCHED; PG8_LDA(At, 0, 0); PG8_STAGE(PG8_SA(1, 1), a1 + hstep, voffA);
            PG8_WAIT_V(8); PG8_WAIT_L(0); PG8_BAR; PG8_MMA(0, 0, At, B0); PG8_MMA(0, 1, At, B1); PG8_BAR; PG8_SCHED;
            PG8_LDA(At, 0, 1); PG8_STAGE(PG8_SB(0, 0), b2, voffB); PG8_STAGE(PG8_SB(0, 1), b2 + hstep, voffB); PG8_STAGE(PG8_SA(0, 0), a2, voffA);
            PG8_WAIT_V(8); PG8_WAIT_L(0); PG8_BAR; PG8_MMA(1, 0, At, B0); PG8_MMA(1, 1, At, B1); PG8_BAR; PG8_SCHED;
            PG8_LDB(B0, 1, 0); PG8_LDB(B1, 1, 1); PG8_SCHED; PG8_LDA(At, 1, 0); PG8_STAGE(PG8_SA(0, 1), a2 + hstep, voffA);
            PG8_WAIT_V(8); PG8_WAIT_L(0); PG8_BAR; PG8_MMA(0, 0, At, B0); PG8_MMA(0, 1, At, B1); PG8_BAR; PG8_SCHED;
            PG8_LDA(At, 1, 1); PG8_STAGE(PG8_SB(1, 0), b3, voffB); PG8_STAGE(PG8_SB(1, 1), b3 + hstep, voffB); PG8_STAGE(PG8_SA(1, 0), a3, voffA);
            PG8_WAIT_V(8); PG8_WAIT_L(0); PG8_BAR; PG8_MMA(1, 0, At, B0); PG8_MMA(1, 1, At, B1); PG8_BAR; PG8_SCHED;
            } else {
            PG8_LDB(B0, 0, 0); PG8_SCHED; PG8_LDA(At, 0, 0); PG8_STAGE(PG8_SA(1, 1), a1 + hstep, voffA);
            PG8_WAIT_L(8); PG8_BAR; PG8_WAIT_L(0); PG8_MMA(0, 0, At, B0); PG8_BAR; PG8_SCHED;
            PG8_LDB(B1, 0, 1); PG8_STAGE(PG8_SB(0, 0), b2, voffB);
            PG8_BAR; PG8_WAIT_L(0); PG8_MMA(0, 1, At, B1); PG8_BAR;
            PG8_LDA(At, 0, 1); PG8_STAGE(PG8_SA(0, 0), a2, voffA);
            PG8_BAR; PG8_WAIT_L(0); PG8_MMA(1, 0, At, B0); PG8_BAR; PG8_SCHED;
            PG8_STAGE(PG8_SB(0, 1), b2 + hstep, voffB);
            PG8_WAIT_V(6); PG8_BAR; PG8_MMA(1, 1, At, B1); PG8_BAR;
            PG8_LDB(B0, 1, 0); PG8_SCHED; PG8_LDA(At, 1, 0); PG8_STAGE(PG8_SA(0, 1), a2 + hstep, voffA);
            PG8_WAIT_L(8); PG8_BAR; PG8_WAIT_L(0); PG8_MMA(0, 0, At, B0); PG8_BAR; PG8_SCHED;
            PG8_LDB(B1, 1, 1); PG8_STAGE(PG8_SB(1, 0), b3, voffB);
            PG8_BAR; PG8_WAIT_L(0); PG8_MMA(0, 1, At, B1); PG8_BAR;
            PG8_LDA(At, 1, 1); PG8_STAGE(PG8_SA(1, 0), a3, voffA);
            PG8_BAR; PG8_WAIT_L(0); PG8_MMA(1, 0, At, B0); PG8_BAR; PG8_SCHED;
            PG8_STAGE(PG8_SB(1, 1), b3 + hstep, voffB);
            PG8_WAIT_V(6); PG8_BAR; PG8_MMA(1, 1, At, B1); PG8_BAR;
            }
        }
        if constexpr (ALIGN_EPI) { if (wr == 0) PG8_BAR; }
        if constexpr (!Epi::AFTER_DRAIN) { E(acc, cur, wr, wc, fr, fq); S.done(cur); }
        if (!has_next) break;
#pragma unroll
        for (int a = 0; a < 2; ++a)
#pragma unroll
            for (int b = 0; b < 2; ++b)
#pragma unroll
                for (int m = 0; m < 4; ++m)
#pragma unroll
                    for (int n = 0; n < 2; ++n) acc[a][b][m][n] = (f32x4){0.f, 0.f, 0.f, 0.f};
        cur = nxt; cA = nA; cB = nB; ++ui;
        if constexpr (ALIGN_EPI) { if (wr == 1) PG8_BAR; }
    }
    PG8_WAIT_V(0);
    if constexpr (!ALIGN_EPI) { if (wr == 0) PG8_BAR; }
    PG8_BAR;
    if constexpr (Epi::AFTER_DRAIN) { E.fused(acc, cur, wr, wc, fr, fq, lds, wid, lane); S.done(cur); }
#undef PG8_SA
#undef PG8_SB
#undef PG8_STAGE
#undef PG8_LDA
#undef PG8_LDB
#undef PG8_MMA
#undef PG8_WAIT_V
#undef PG8_WAIT_L
#undef PG8_BAR
#undef PG8_SCHED
}
}
#else
template <class Epi, class Sched, bool ALIGN_EPI = false, bool SP2 = false>
static void gemm_phase(LDSP lds, const Gemm g, const Sched& S, const Epi& E, const int wid_) {
    const int tid = TID(), wid = tid >> 6, lane = tid & 63, wr = wid >> 2, wc = wid & 3, fr = lane & 15, fq = lane >> 4;
    Unit u;
    for (int i = 0; S.next(i, u); ++i) {
        f32x4 acc[2][2][4][2];
        for (int ai = 0; ai < 2; ++ai) for (int bj = 0; bj < 2; ++bj) for (int m = 0; m < 4; ++m) for (int n = 0; n < 2; ++n) for (int e = 0; e < 4; ++e) {
            const int row = 256 * u.pm + 128 * ai + 64 * wr + 16 * m + fr;
            const int col = 256 * u.pn + 128 * bj + 32 * wc + (Epi::PERM ? 8 * fq + 4 * n + e : 16 * n + 4 * fq + e);
            const bf16_t* a = g.A + (size_t)row * g.K; const bf16_t* b = g.Bt + (size_t)col * g.K; float s = 0.f;
            for (int k = 0; k < (Epi::MID ? g.K / 2 : g.K); ++k) s += ::bf2f(a[k]) * ::bf2f(b[k]);
            acc[ai][bj][m][n][e] = s; }
        if constexpr (Epi::MID) { E.mid(acc, u, wr, wc, fr, fq);
            for (int ai = 0; ai < 2; ++ai) for (int bj = 0; bj < 2; ++bj) for (int m = 0; m < 4; ++m) for (int n = 0; n < 2; ++n) for (int e = 0; e < 4; ++e) {
                const int row = 256 * u.pm + 128 * ai + 64 * wr + 16 * m + fr; const int col = 256 * u.pn + 128 * bj + 32 * wc + (Epi::PERM ? 8 * fq + 4 * n + e : 16 * n + 4 * fq + e);
                const bf16_t* a = g.A + (size_t)row * g.K; const bf16_t* b = g.Bt + (size_t)col * g.K; float s = 0.f;
                for (int k = g.K / 2; k < g.K; ++k) s += ::bf2f(a[k]) * ::bf2f(b[k]);
                acc[ai][bj][m][n][e] += s; } }
        E(acc, u, wr, wc, fr, fq);
    }
}
}
#endif

struct EpiSwiglu {
    static constexpr bool PERM = true, AFTER_DRAIN = false, MID = false;
    LDSP rtab;
    DEVM void operator()(const f32x4 (&acc)[2][2][4][2], const pg8::Unit& u, int wr, int wc, int fr, int fq) const {
        const int row0 = u.pm * 256 + wr * 64 + fr, col0 = u.pn * 128 + wc * 32 + 8 * fq;
        unsigned char* ws_ = P_WS(); bf16_t* G = (bf16_t*)(ws_ + WS_G); const LAS float* rt = (const LAS float*)rtab + u.idx * 256 + wr * 64 + fr;
#pragma unroll
        for (int ai = 0; ai < 2; ++ai)
#pragma unroll
            for (int m = 0; m < 4; ++m) {
                bf16_t* rowp = G + (size_t)(row0 + ai * 128 + m * 16) * DFF + col0;
                const float rinv = rt[ai * 128 + m * 16];
                float o[8];
#pragma unroll
                for (int n = 0; n < 2; ++n)
#pragma unroll
                    for (int e = 0; e < 4; ++e) { const float g = acc[ai][0][m][n][e] * rinv, up = acc[ai][1][m][n][e] * rinv; o[4 * n + e] = g * up * RCPF(1.0f + EXP2F(-g * LOG2E)); }
                u32x4 w; w.x = pk2(o[0], o[1]); w.y = pk2(o[2], o[3]); w.z = pk2(o[4], o[5]); w.w = pk2(o[6], o[7]);
                *(u32x4*)rowp = w;
            }
    }
};
struct EpiResid {
    static constexpr bool PERM = true, AFTER_DRAIN = false, MID = false;
    float scale; int nso; int fin;
    DEVM float apply4(size_t row, int col, f32x4 v) const { bf16_t* XB = (bf16_t*)(P_WS() + WS_H); const f32x4 x = ldbf4(XB + row * DM + col) + v * scale;
        if (fin) *(f32x4*)(P_OUT() + row * DM + col) = x; else { u32x2 w; w.x = pk2(x[0], x[1]); w.y = pk2(x[2], x[3]); *(u32x2*)(XB + row * DM + col) = w; }
        return (x[0] * x[0] + x[1] * x[1]) + (x[2] * x[2] + x[3] * x[3]); }
    DEVM void put_ss(size_t row, int slot, float ss) const { ((float*)(P_WS() + WS_SS))[((size_t)nso * NSLOT + slot) * M + row] = ss; }
    DEVM void operator()(const f32x4 (&acc)[2][2][4][2], const pg8::Unit& u, int wr, int wc, int fr, int fq) const {
        const int row0 = u.pm * 256 + wr * 64 + fr, col0 = u.pn * 256 + wc * 32 + 8 * fq;
        float* X = P_OUT(); unsigned char* ws_ = P_WS(); bf16_t* XB = (bf16_t*)(ws_ + WS_H); float* SSs = (float*)(ws_ + WS_SS) + ((size_t)nso * NSLOT + u.pn * 8 + wc) * M;
#pragma unroll
        for (int ai = 0; ai < 2; ++ai)
#pragma unroll
            for (int m = 0; m < 4; ++m) {
                const size_t row = (size_t)(row0 + ai * 128 + m * 16); bf16_t* rowb = XB + row * DM + col0;
#pragma unroll
                for (int bj = 0; bj < 2; ++bj) {
                    const u32x4 o = *(const u32x4*)(rowb + bj * 128);
                    f32x4 x0, x1; x0[0] = bf2f(o.x & 0xffffu); x0[1] = __builtin_bit_cast(float, o.x & 0xffff0000u); x0[2] = bf2f(o.y & 0xffffu); x0[3] = __builtin_bit_cast(float, o.y & 0xffff0000u);
                    x1[0] = bf2f(o.z & 0xffffu); x1[1] = __builtin_bit_cast(float, o.z & 0xffff0000u); x1[2] = bf2f(o.w & 0xffffu); x1[3] = __builtin_bit_cast(float, o.w & 0xffff0000u);
                    x0 = x0 + acc[ai][bj][m][0] * scale; x1 = x1 + acc[ai][bj][m][1] * scale;
                    if (fin) { float* q = X + row * DM + col0 + bj * 128; *(f32x4*)q = x0; *(f32x4*)(q + 4) = x1; }
                    else { u32x4 w; w.x = pk2(x0[0], x0[1]); w.y = pk2(x0[2], x0[3]); w.z = pk2(x1[0], x1[1]); w.w = pk2(x1[2], x1[3]); *(u32x4*)(rowb + bj * 128) = w; }
                    float ss = ((x0[0] * x0[0] + x0[1] * x0[1]) + (x0[2] * x0[2] + x0[3] * x0[3])) + ((x1[0] * x1[0] + x1[1] * x1[1]) + (x1[2] * x1[2] + x1[3] * x1[3]));
                    ss += SHFL_XOR(ss, 16); ss += SHFL_XOR(ss, 32);
                    if (fq == 0) SSs[(size_t)bj * 4 * M + row] = ss; }
            }
    }
};
struct EpiWin {
    static constexpr bool PERM = true, AFTER_DRAIN = false, MID = false;
    LDSP rtab;
    DEVM void operator()(const f32x4 (&acc)[2][2][4][2], const pg8::Unit& u, int wr, int wc, int fr, int fq) const {
        const int row0 = u.pm * 256 + wr * 64 + fr;
        unsigned char* ws_ = P_WS(); bf16_t* PF = (bf16_t*)(ws_ + WS_PF); bf16_t* SG = (bf16_t*)(ws_ + WS_SG); const LAS float* rt = (const LAS float*)rtab + u.idx * 256 + wr * 64 + fr;
        if (u.pn < FW / 256) {
            const int col0 = u.pn * 256 + wc * 32 + 8 * fq;
#pragma unroll
            for (int ai = 0; ai < 2; ++ai)
#pragma unroll
                for (int m = 0; m < 4; ++m) {
                    bf16_t* rowp = PF + (size_t)(row0 + ai * 128 + m * 16) * FW + col0; const float rinv = rt[ai * 128 + m * 16];
#pragma unroll
                    for (int bj = 0; bj < 2; ++bj) { const f32x4 v0 = acc[ai][bj][m][0] * rinv, v1 = acc[ai][bj][m][1] * rinv;
                        u32x4 w; w.x = pk2(v0[0], v0[1]); w.y = pk2(v0[2], v0[3]); w.z = pk2(v1[0], v1[1]); w.w = pk2(v1[2], v1[3]); *(u32x4*)(rowp + bj * 128) = w; }
                }
        } else {
            const int col0 = (u.pn - FW / 256) * 256 + wc * 32 + 8 * fq;
#pragma unroll
            for (int ai = 0; ai < 2; ++ai)
#pragma unroll
                for (int m = 0; m < 4; ++m) {
                    bf16_t* rowp = SG + (size_t)(row0 + ai * 128 + m * 16) * (2 * DM) + col0; const float rinv = rt[ai * 128 + m * 16];
#pragma unroll
                    for (int bj = 0; bj < 2; ++bj)
#pragma unroll
                        for (int n = 0; n < 2; ++n) { const f32x4 v = acc[ai][bj][m][n] * rinv; u32x2 w;
                            w.x = pk2(sigmoidf_(v[0]), sigmoidf_(v[1])); w.y = pk2(sigmoidf_(v[2]), sigmoidf_(v[3]));
                            *(u32x2*)(rowp + bj * 128 + n * 4) = w; }
                }
        }
    }
};
struct EpiUp {
    static constexpr bool PERM = true, AFTER_DRAIN = false, MID = true;
    int dummy;
    DEVM void mid(f32x4 (&acc)[2][2][4][2], const pg8::Unit& u, int wr, int wc, int fr, int fq) const {
        const int row0 = OPAQUE_V(u.pm * 256 + wr * 64 + fr), col0 = OPAQUE_V(u.pn * 256 + wc * 32 + 8 * fq); const bf16_t* SG = (const bf16_t*)(P_WS() + WS_SG);
#pragma unroll
        for (int ai = 0; ai < 2; ++ai)
#pragma unroll
            for (int m = 0; m < 4; ++m) { const bf16_t* sr = SG + (size_t)(row0 + ai * 128 + m * 16) * (2 * DM) + col0;
#pragma unroll
                for (int bj = 0; bj < 2; ++bj) { const u32x4 sa = *(const u32x4*)(sr + bj * 128), sb = *(const u32x4*)(sr + DM + bj * 128);
                    f32x4& a0 = acc[ai][bj][m][0]; f32x4& a1 = acc[ai][bj][m][1];
                    a0[0] *= bf2f(sa.x & 0xffffu) * RCPF(bf2f(sb.x & 0xffffu)); a0[1] *= bf2f(sa.x >> 16) * RCPF(bf2f(sb.x >> 16)); a0[2] *= bf2f(sa.y & 0xffffu) * RCPF(bf2f(sb.y & 0xffffu)); a0[3] *= bf2f(sa.y >> 16) * RCPF(bf2f(sb.y >> 16));
                    a1[0] *= bf2f(sa.z & 0xffffu) * RCPF(bf2f(sb.z & 0xffffu)); a1[1] *= bf2f(sa.z >> 16) * RCPF(bf2f(sb.z >> 16)); a1[2] *= bf2f(sa.w & 0xffffu) * RCPF(bf2f(sb.w & 0xffffu)); a1[3] *= bf2f(sa.w >> 16) * RCPF(bf2f(sb.w >> 16)); }
                COMPILER_FENCE(); }
    }
    DEVM void operator()(const f32x4 (&acc)[2][2][4][2], const pg8::Unit& u, int wr, int wc, int fr, int fq) const {
        const int row0 = u.pm * 256 + wr * 64 + fr, col0 = u.pn * 256 + wc * 32 + 8 * fq; unsigned char* ws_ = P_WS(); const bf16_t* SG = (const bf16_t*)(ws_ + WS_SG); bf16_t* MG = (bf16_t*)(ws_ + WS_MG);
#pragma unroll
        for (int ai = 0; ai < 2; ++ai)
#pragma unroll
            for (int m = 0; m < 4; ++m) { const size_t row = (size_t)(row0 + ai * 128 + m * 16);
#pragma unroll
                for (int bj = 0; bj < 2; ++bj) { const u32x4 sb = *(const u32x4*)(SG + row * (2 * DM) + DM + col0 + bj * 128); const f32x4 v0 = acc[ai][bj][m][0], v1 = acc[ai][bj][m][1];
                    u32x4 w; w.x = pk2(v0[0] * bf2f(sb.x & 0xffffu), v0[1] * bf2f(sb.x >> 16)); w.y = pk2(v0[2] * bf2f(sb.y & 0xffffu), v0[3] * bf2f(sb.y >> 16));
                    w.z = pk2(v1[0] * bf2f(sb.z & 0xffffu), v1[1] * bf2f(sb.z >> 16)); w.w = pk2(v1[2] * bf2f(sb.w & 0xffffu), v1[3] * bf2f(sb.w >> 16));
                    *(u32x4*)(MG + row * DM + col0 + bj * 128) = w; } }
    }
    DEVM void apply4_2(size_t row, int col, f32x4 vA, f32x4 vB) const { unsigned char* ws_ = P_WS(); const bf16_t* SG = (const bf16_t*)(ws_ + WS_SG); bf16_t* MG = (bf16_t*)(ws_ + WS_MG);
        const u32x2 sa = *(const u32x2*)(SG + row * (2 * DM) + col), sb = *(const u32x2*)(SG + row * (2 * DM) + DM + col);
        u32x2 w; w.x = pk2(vA[0] * bf2f(sa.x & 0xffffu) + vB[0] * bf2f(sb.x & 0xffffu), vA[1] * bf2f(sa.x >> 16) + vB[1] * bf2f(sb.x >> 16));
        w.y = pk2(vA[2] * bf2f(sa.y & 0xffffu) + vB[2] * bf2f(sb.y & 0xffffu), vA[3] * bf2f(sa.y >> 16) + vB[3] * bf2f(sb.y >> 16)); *(u32x2*)(MG + row * DM + col) = w; }
};

template <class Sched> DEV void rinv_table(const Sched& S, int nsi, LDSP lds, int tid) {
    const float* SS = (const float*)(P_WS() + WS_SS) + (size_t)nsi * NSLOT * M; LAS float* rt = (LAS float*)(lds + LDS_RINV_OFF);
    pg8::Unit u;
#pragma unroll 1
    for (int i = 0; S.next(i, u); ++i) if (tid < 256) { float s = 0.f;
#pragma unroll 8
        for (int k = 0; k < NSLOT; ++k) s += SS[(size_t)k * M + u.pm * 256 + tid];
        rt[i * 256 + tid] = RSQRTF(s * (1.0f / DM) + RMS_EPS); }
    WG_SYNC();
}

template <class Epi> DEV void sgemm_tile(const bf16_t* A, const bf16_t* Bt, int K, int m0, int n0, LDSP lds, int tid, const Epi& E) {
    static_assert(!Epi::MID || NWAVES == 8, "two-half reduce assumes 8 waves");
    const int lane = tid & 63, wave = WAVE_ID(tid), r = lane & 15, g4 = lane >> 4;
    f32x4 acc[4][4];
#pragma unroll
    for (int nt = 0; nt < 4; ++nt)
#pragma unroll
        for (int mt = 0; mt < 4; ++mt) acc[nt][mt] = (f32x4){0.f, 0.f, 0.f, 0.f};
    unsigned offA[4], offB[4];
#pragma unroll
    for (int t = 0; t < 4; ++t) { offA[t] = (unsigned)(((m0 + r + 16 * t) * K + 8 * g4) * 2); offB[t] = (unsigned)(((n0 + r + 16 * t) * K + 8 * g4) * 2); }
    const int nks = K >> 5;
    bf16x8 xa0[4], xb0[4], xa1[4], xb1[4], xa2[4], xb2[4];
#define SG_LOAD(A_, B_, ksv) do { const char* Ab_ = (const char*)A + 64 * (ksv); const char* Bb_ = (const char*)Bt + 64 * (ksv); _Pragma("unroll") for (int t = 0; t < 4; ++t) { \
        A_[t] = *(const bf16x8*)(Ab_ + offA[t]); B_[t] = *(const bf16x8*)(Bb_ + offB[t]); } } while (0)
#define SG_MMA(A_, B_) do { _Pragma("unroll") for (int nt = 0; nt < 4; ++nt) _Pragma("unroll") for (int mt = 0; mt < 4; ++mt) acc[nt][mt] = MFMA16(B_[nt], A_[mt], acc[nt][mt]); } while (0)
    const int npairs = nks >> 1, pq = npairs / NWAVES, prem = npairs % NWAVES, hcnt = 2 * (pq + (wave < prem ? 1 : 0)), hs = 2 * (wave * pq + (wave < prem ? wave : prem));
    int i = 0;
    if (hcnt > 0) SG_LOAD(xa0, xb0, hs);
    if (hcnt > 1) SG_LOAD(xa1, xb1, hs + 1);
#pragma unroll 1
    for (; i + 4 < hcnt; i += 3) {
        SG_LOAD(xa2, xb2, hs + i + 2); SG_MMA(xa0, xb0);
        SG_LOAD(xa0, xb0, hs + i + 3); SG_MMA(xa1, xb1);
        SG_LOAD(xa1, xb1, hs + i + 4); SG_MMA(xa2, xb2);
    }
    { const int R = hcnt - i;
      if (R >= 3) SG_LOAD(xa2, xb2, hs + i + 2);
      if (R >= 1) SG_MMA(xa0, xb0);
      if (R >= 4) SG_LOAD(xa0, xb0, hs + i + 3);
      if (R >= 2) SG_MMA(xa1, xb1);
      if (R >= 3) SG_MMA(xa2, xb2);
      if (R >= 4) SG_MMA(xa0, xb0); }
#undef SG_LOAD
#undef SG_MMA
#pragma unroll
    for (int nt = 0; nt < 4; ++nt)
#pragma unroll
        for (int mt = 0; mt < 4; ++mt) *(LAS f32x4*)(lds + wave * 16384 + ((nt * 4 + mt) * 64 + lane) * 16) = acc[nt][mt];
    WG_SYNC();
    {
        const int mt = wave & 3; float q = 0.f;
#pragma unroll
        for (int k = 0; k < 2; ++k) {
            const int nt = 2 * (wave >> 2) + k, s = (nt * 4 + mt) * 64 + lane;
            if constexpr (Epi::MID) {
                f32x4 vA = *(const LAS f32x4*)(lds + s * 16), vB = *(const LAS f32x4*)(lds + 4 * 16384 + s * 16);
#pragma unroll
                for (int w = 1; w < 4; ++w) { vA = vA + *(const LAS f32x4*)(lds + w * 16384 + s * 16); vB = vB + *(const LAS f32x4*)(lds + (4 + w) * 16384 + s * 16); }
                E.apply4_2((size_t)(m0 + 16 * mt + r), n0 + 16 * nt + 4 * g4, vA, vB);
            } else {
            f32x4 v = *(const LAS f32x4*)(lds + s * 16);
#pragma unroll
            for (int w = 1; w < NWAVES; ++w) v = v + *(const LAS f32x4*)(lds + w * 16384 + s * 16);
            q += E.apply4((size_t)(m0 + 16 * mt + r), n0 + 16 * nt + 4 * g4, v);
            }
        }
        q += SHFL_XOR(q, 16); q += SHFL_XOR(q, 32);
        if constexpr (!Epi::MID) { if (g4 == 0) E.put_ss((size_t)(m0 + 16 * mt + r), (n0 >> 5) + (wave >> 2), q); }
    }
    WG_SYNC();
}

constexpr int IT_G = (DM / 64) * (DFF / 32), IT_D = (DFF / 64) * (DM / 32), IT_IN = (DM / 64) * (INCOLS / 32), IT_UA = (AW / 64) * (DM / 32), IT_UB = (BQ / 64) * (DM / 32), IT_O = (DM / 64) * (DM / 32);
constexpr int IT_LAYER = 4 * IT_G + 2 * IT_D + IT_IN + IT_UA + IT_UB + IT_O;
struct ConvItem { const float* src; bf16_t* dst; const float* gain; int K, N, k0, n0, drow, ldk, koff; };
DEV ConvItem conv_decode(const Params& p, int l, int r) {
    int src, K, N, mode, gsrc = -1, ldk = 0, koff = 0; size_t doff, soff;
    if (r < IT_G) { src = I_F1G; gsrc = I_NFF1; K = DM; N = DFF; mode = 1; doff = OFF_WGU1; soff = (size_t)l * DM * DFF; }
    else if ((r -= IT_G) < IT_G) { src = I_F1U; gsrc = I_NFF1; K = DM; N = DFF; mode = 2; doff = OFF_WGU1; soff = (size_t)l * DM * DFF; }
    else if ((r -= IT_G) < IT_D) { src = I_F1D; K = DFF; N = DM; mode = 0; doff = OFF_WD1; soff = (size_t)l * DFF * DM; }
    else if ((r -= IT_D) < IT_IN) { src = I_WIN; gsrc = I_NMIX; K = DM; N = INCOLS; mode = 3; doff = OFF_WIN; soff = (size_t)l * DM * INCOLS; }
    else if ((r -= IT_IN) < IT_UA) { src = I_WUA; K = AW; N = DM; mode = 0; doff = OFF_WUA; soff = (size_t)l * AW * DM; ldk = AW + BQ; }
    else if ((r -= IT_UA) < IT_UB) { src = I_WUB; K = BQ; N = DM; mode = 0; doff = OFF_WUA; soff = (size_t)l * BQ * DM; ldk = AW + BQ; koff = AW; }
    else if ((r -= IT_UB) < IT_O) { src = I_WO; K = DM; N = DM; mode = 0; doff = OFF_WO; soff = (size_t)l * DM * DM; }
    else if ((r -= IT_O) < IT_G) { src = I_F2G; gsrc = I_NFF2; K = DM; N = DFF; mode = 1; doff = OFF_WGU2; soff = (size_t)l * DM * DFF; }
    else if ((r -= IT_G) < IT_G) { src = I_F2U; gsrc = I_NFF2; K = DM; N = DFF; mode = 2; doff = OFF_WGU2; soff = (size_t)l * DM * DFF; }
    else { r -= IT_G; src = I_F2D; K = DFF; N = DM; mode = 0; doff = OFF_WD2; soff = (size_t)l * DFF * DM; }
    ConvItem d; d.src = PIN(p, src) + soff; d.dst = lwp(p, l, doff); d.gain = gsrc >= 0 ? PIN(p, gsrc) + (size_t)l * DM : nullptr; d.K = K; d.N = N; d.ldk = ldk ? ldk : K; d.koff = koff;
    const int nblk = N / 32, kb = r / nblk, nb = r % nblk; d.k0 = 64 * kb; d.n0 = 32 * nb;
    const int n0 = d.n0; int drow = n0;
    if (mode == 1) drow = (n0 >> 7) * 256 + (n0 & 127); else if (mode == 2) drow = (n0 >> 7) * 256 + 128 + (n0 & 127); else if (mode == 3) drow = n0 < FW_RAW ? n0 : FW + (n0 - FW_RAW);
    d.drow = drow; return d;
}
DEV void conv_load(const ConvItem& d, f32x4 (&v)[8], f32x4 (&g)[2], int lane) {
#pragma unroll
    for (int i = 0; i < 8; ++i) v[i] = *(const f32x4*)(d.src + (size_t)(d.k0 + 8 * i + (lane >> 3)) * d.N + d.n0 + 4 * (lane & 7));
    g[0] = (f32x4){1.f, 1.f, 1.f, 1.f}; g[1] = g[0];
    if (d.gain) { g[0] = *(const f32x4*)(d.gain + d.k0 + 8 * (lane & 7)); g[1] = *(const f32x4*)(d.gain + d.k0 + 8 * (lane & 7) + 4); }
}
DEV void conv_finish(const ConvItem& d, const f32x4 (&v)[8], const f32x4 (&g)[2], LAS float* scr, int lane) {
#pragma unroll
    for (int i = 0; i < 8; ++i) { LAS float* q = scr + (8 * i + (lane >> 3)) * 33 + 4 * (lane & 7); q[0] = v[i][0]; q[1] = v[i][1]; q[2] = v[i][2]; q[3] = v[i][3]; }
    WAVE_FENCE();
    const int c = lane & 7;
#pragma unroll
    for (int j = 0; j < 4; ++j) { const int n = (lane >> 3) + 8 * j; const LAS float* s = scr + (8 * c) * 33 + n;
        u32x4 o; o.x = pk2(s[0 * 33] * g[0][0], s[1 * 33] * g[0][1]); o.y = pk2(s[2 * 33] * g[0][2], s[3 * 33] * g[0][3]); o.z = pk2(s[4 * 33] * g[1][0], s[5 * 33] * g[1][1]); o.w = pk2(s[6 * 33] * g[1][2], s[7 * 33] * g[1][3]);
        *(u32x4*)(d.dst + (size_t)(d.drow + n) * d.ldk + d.koff + d.k0 + 8 * c) = o; }
    WAVE_FENCE();
}
DEV void conv_range(const Params& p, int l, int r0, int r1, LDSP lds, int wave, int lane) {
    if (r0 >= r1) return;
    LAS float* scrA = (LAS float*)(lds + wave * 16896); LAS float* scrB = scrA + 2112;
    f32x4 va[8], vb[8], ga[2], gb[2];
    ConvItem da = conv_decode(p, l, r0), db = da;
    conv_load(da, va, ga, lane);
#pragma unroll 1
    for (int r = r0; r < r1; r += 2) {
        db = conv_decode(p, l, r + 1 < r1 ? r + 1 : r1 - 1); conv_load(db, vb, gb, lane);
        conv_finish(da, va, ga, scrA, lane);
        da = conv_decode(p, l, r + 2 < r1 ? r + 2 : r1 - 1); conv_load(da, va, ga, lane);
        if (r + 1 < r1) conv_finish(db, vb, gb, scrB, lane);
    }
}
constexpr int CONV_CH = 16;
DEV void conv_some(const Params& p, int l, int nchunks, LDSP lds, int wave, int lane) {
    if (l >= DEPTH) return;
    unsigned* ctr = (unsigned*)(p.ws + WS_CTL) + CW_CONV + 64 * l;
#pragma unroll 1
    for (int n = 0; n < nchunks; ++n) { const int base = claim_item(ctr, (unsigned)CONV_CH, lane); if (base >= IT_LAYER) break; conv_range(p, l, base, base + CONV_CH < IT_LAYER ? base + CONV_CH : IT_LAYER, lds, wave, lane); }
}
DEV void prologue(const Params& p, LDSP lds, int gw, int NGW, int wave, int lane, int gtid, int NGT) {
    { const int per = (IT_LAYER + NGW - 1) / NGW, r0 = gw * per; conv_range(p, 0, r0, r0 + per < IT_LAYER ? r0 + per : IT_LAYER, lds, wave, lane); }
    for (int idx = gtid; idx < DEPTH * AW * 288; idx += NGT) {
        const int l = idx / (AW * 288), r = idx % (AW * 288), n = r / 288, k = r % 288;
        if (k < 64) lwp(p, l, OFF_DW2T)[n * 64 + k] = (bf16_t)f2bf(PIN(p, I_DW2)[((size_t)l * 64 + k) * AW + n]);
        else if (k < 128) lwp(p, l, OFF_IA2T)[n * 64 + (k - 64)] = (bf16_t)f2bf(PIN(p, I_IA2)[((size_t)l * 64 + (k - 64)) * AW + n]);
        else lwp(p, l, OFF_GG2T)[n * 160 + (k - 128)] = (bf16_t)f2bf(PIN(p, I_GG2)[((size_t)l * 160 + (k - 128)) * AW + n]);
    }
    float* rope = (float*)(p.ws + WS_ROPE);
    for (int idx = gtid; idx < (SEQ + DECS) * 32; idx += NGT) {
        const int slot = idx >> 5, i = idx & 31; const double pos = slot < SEQ ? (double)slot : (double)(PAST + slot - SEQ);
        const double ang = pos * ROPE_INV[i]; const double red = ang - TWO_PI * __builtin_rint(ang * (1.0 / TWO_PI));
        rope[2 * idx] = cosf((float)red); rope[2 * idx + 1] = sinf((float)red);
    }
}
DEV void x0_phase(const Params& p, int gw, int NGW, int lane, int gtid, int NGT) {
    bf16_t* XB = (bf16_t*)(p.ws + WS_H); float* SS = (float*)(p.ws + WS_SS);
    const float* xp = PIN(p, I_XP); const float* xs = PIN(p, I_XS);
    for (int m = gw; m < M; m += NGW) {
        const float* xr = m < SEQ ? xp + (size_t)m * DM : xs + (size_t)(m - SEQ) * DM;
        f32x4 v[DM / 256]; float ss = 0.f;
#pragma unroll
        for (int j = 0; j < DM / 256; ++j) { v[j] = *(const f32x4*)(xr + 4 * lane + 256 * j); ss += (v[j][0] * v[j][0] + v[j][1] * v[j][1]) + (v[j][2] * v[j][2] + v[j][3] * v[j][3]); }
#pragma unroll
        for (int j = 0; j < DM / 256; ++j) { u32x2 w; w.x = pk2(v[j][0], v[j][1]); w.y = pk2(v[j][2], v[j][3]); *(u32x2*)(XB + (size_t)m * DM + 4 * lane + 256 * j) = w; }
        ss = wave_sum(ss);
        if (lane < NSLOT) SS[(size_t)lane * M + m] = lane == 0 ? ss : 0.f;
    }
}


DEV void lact_phase(const Params& p, int l, int gtid, int NGT) {
    const bf16_t* PF = (const bf16_t*)(p.ws + WS_PF); const float* mu = PIN(p, I_MU) + (size_t)l * ACOLS; const float* ssh = PIN(p, I_SSH) + (size_t)l * DECB * ACOLS;
    bf16_t* LACT = (bf16_t*)(p.ws + WS_LACT);
#pragma unroll 1
    for (int idx = gtid; idx < M * 72; idx += NGT) {
        const int m = idx / 72, g = idx % 72, col = 4 * g;
        const int pc = col < 64 ? C_WLO + col : (col < 128 ? C_ALO + (col - 64) : C_GLO + (col - 128));
        const bf16_t* cur = PF + (size_t)m * FW; const f32x4 c4 = ldbf4(cur + pc), m4 = *(const f32x4*)(mu + pc);
        f32x4 p4 = (f32x4){0.f, 0.f, 0.f, 0.f};
        if (m < SEQ) { if (m > 0) p4 = ldbf4(cur - FW + pc); }
        else { const int s = m - SEQ; p4 = (s & 15) ? ldbf4(cur - FW + pc) : *(const f32x4*)(ssh + (size_t)(s >> 4) * ACOLS + pc); }
        float x[4];
#pragma unroll
        for (int e = 0; e < 4; ++e) { const float v = c4[e] + (p4[e] - c4[e]) * m4[e]; x[e] = col < 64 ? tanhf_(v) : (col < 128 ? v : sigmoidf_(v)); }
        u32x2 w; w.x = pk2(x[0], x[1]); w.y = pk2(x[2], x[3]);
        *(u32x2*)(LACT + (size_t)m * 288 + col) = w;
    }
}

constexpr int R1_RA = 3 * 64 * 65 * 4, R1_RB = 65536 + 64 * 65 * 4;
static_assert(R1_RA + R1_RB + 2304 <= LDS_CTL_OFF && 6 * 8192 <= R1_RA, "R1 LDS map");
#define R1IN_PARAMS bf16x8 (&Xbw)[2][2], bf16x8 (&Xba)[2][2], bf16x8 (&Xbg)[2][5], bf16x8 (&Xa1)[2], bf16x8 (&Xa2)[2], bf16x8 (&Xa3)[5], float (&Xcr8)[8], float (&Xck8)[8], float (&Xcv8)[8], float& Xpr0, float& Xpk0, float& Xpv0
#define R1IN_ARGS Xbw, Xba, Xbg, Xa1, Xa2, Xa3, Xcr8, Xck8, Xcv8, Xpr0, Xpk0, Xpv0
#define R1IN_DECL bf16x8 Xbw[2][2], Xba[2][2], Xbg[2][5], Xa1[2], Xa2[2], Xa3[5]; float Xcr8[8], Xck8[8], Xcv8[8], Xpr0, Xpk0, Xpv0
DEV void r1_fetch(const Params& p, int l, int u, R1IN_PARAMS, int lane, int wave) {
    const int r = lane & 15, g4 = lane >> 4, mt1 = wave & 3, nh = wave >> 2;
    const bool samp = u >= NUP;
    int c = 0, b = 0, h, ntok; size_t row0;
    if (!samp) { c = u / AH; h = u % AH; row0 = (size_t)64 * c; ntok = 64; } else { const int s = u - NUP; b = s / AH; h = s % AH; row0 = (size_t)SEQ + 16 * b; ntok = DECS; }
#pragma unroll
    for (int n = 0; n < 2; ++n) { const size_t wrow = (size_t)(64 * h + 16 * (2 * nh + n) + r);
#pragma unroll
        for (int ks = 0; ks < 2; ++ks) { Xbw[n][ks] = *(const bf16x8*)(lwp(p, l, OFF_DW2T) + wrow * 64 + 32 * ks + 8 * g4); Xba[n][ks] = *(const bf16x8*)(lwp(p, l, OFF_IA2T) + wrow * 64 + 32 * ks + 8 * g4); }
#pragma unroll
        for (int ks = 0; ks < 5; ++ks) Xbg[n][ks] = *(const bf16x8*)(lwp(p, l, OFF_GG2T) + wrow * 160 + 32 * ks + 8 * g4); }
    { const int tr = 16 * mt1 + r; const bf16_t* LA_ = (const bf16_t*)(p.ws + WS_LACT) + (row0 + (tr < ntok ? tr : ntok - 1)) * 288 + 8 * g4;
#pragma unroll
      for (int ks = 0; ks < 2; ++ks) { Xa1[ks] = *(const bf16x8*)(LA_ + 32 * ks); Xa2[ks] = *(const bf16x8*)(LA_ + 64 + 32 * ks); }
#pragma unroll
      for (int ks = 0; ks < 5; ++ks) Xa3[ks] = *(const bf16x8*)(LA_ + 128 + 32 * ks); }
    { const int ch_ = 64 * h + lane, t0 = 8 * wave; const bf16_t* PFb = (const bf16_t*)(p.ws + WS_PF);
      const bool use_ssh = t0 == 0 && samp; const float psc = (t0 > 0 ? (t0 - 1 < ntok) : (samp || c > 0)) ? 1.f : 0.f;
      const size_t prow = t0 > 0 ? row0 + (t0 - 1 < ntok ? t0 - 1 : ntok - 1) : (c > 0 ? row0 - 1 : row0);
      const bf16_t* pb = PFb + prow * FW; const float* pf = PIN(p, I_SSH) + ((size_t)l * DECB + (samp ? b : 0)) * ACOLS;
      const float br = bf2f(pb[C_R + ch_]), bk = bf2f(pb[C_K + ch_]), bv = bf2f(pb[C_V + ch_]), fr_ = pf[C_R + ch_], fk_ = pf[C_K + ch_], fv_ = pf[C_V + ch_];
      Xpr0 = (use_ssh ? fr_ : br) * psc; Xpk0 = (use_ssh ? fk_ : bk) * psc; Xpv0 = (use_ssh ? fv_ : bv) * psc;
#pragma unroll
      for (int tt = 0; tt < 8; ++tt) { const int t = t0 + tt; const bf16_t* cp = PFb + (row0 + (t < ntok ? t : ntok - 1)) * FW; Xcr8[tt] = bf2f(cp[C_R + ch_]); Xck8[tt] = bf2f(cp[C_K + ch_]); Xcv8[tt] = bf2f(cp[C_V + ch_]); } }
}
DEV void r1_unit(const Params& p, int l, int u, int unext, R1IN_PARAMS, LDSP lds, int tid) {
    const int lane = tid & 63, wave = WAVE_ID(tid), r = lane & 15, g4 = lane >> 4;
    const bool samp = u >= NUP;
    int c = 0, b = 0, h, ntok; size_t row0;
    if (!samp) { c = u / AH; h = u % AH; row0 = (size_t)64 * c; ntok = 64; } else { const int s = u - NUP; b = s / AH; h = s % AH; row0 = (size_t)SEQ + 16 * b; ntok = DECS; }
    const float* mu = PIN(p, I_MU) + (size_t)l * ACOLS;
    LDSP RA = lds, RB = lds + R1_RA;
    LAS float* DWf = (LAS float*)RA; LAS float* IAf = DWf + 64 * 65; LAS float* GGf = IAf + 64 * 65;
    LDSP B0 = RB, B1 = RB + 8192, B2 = RB + 16384, B3 = RB + 24576, B4 = RB + 32768, B5 = RB + 40960, B6 = RB + 49152, B7 = RB + 57344;
    LAS float* RtF = (LAS float*)(RB + 65536);
    LDSP A0 = RA, A1 = RA + 8192, A2 = RA + 16384, A3 = RA + 24576, A4 = RA + 32768, A5 = RA + 40960;
    LAS float* part = (LAS float*)(lds + R1_RA + R1_RB); LAS float* gam = part + 512;
    const int mt1 = wave & 3, nh = wave >> 2;
    if (16 * mt1 < ntok) {
        f32x4 aw[2], aa[2], ag[2];
#pragma unroll
        for (int n = 0; n < 2; ++n) { aw[n] = (f32x4){0.f, 0.f, 0.f, 0.f}; aa[n] = aw[n]; ag[n] = aw[n]; }
#pragma unroll
        for (int ks = 0; ks < 2; ++ks)
#pragma unroll
            for (int n = 0; n < 2; ++n) { aw[n] = MFMA16(Xa1[ks], Xbw[n][ks], aw[n]); aa[n] = MFMA16(Xa2[ks], Xba[n][ks], aa[n]); }
#pragma unroll
        for (int ks = 0; ks < 5; ++ks)
#pragma unroll
            for (int n = 0; n < 2; ++n) ag[n] = MFMA16(Xa3[ks], Xbg[n][ks], ag[n]);
#pragma unroll
        for (int n = 0; n < 2; ++n)
#pragma unroll
            for (int reg = 0; reg < 4; ++reg) { const int o = (16 * mt1 + 4 * g4 + reg) * 65 + 16 * (2 * nh + n) + r; DWf[o] = aw[n][reg]; IAf[o] = aa[n][reg]; GGf[o] = ag[n][reg]; }
    }
    WG_SYNC_LDS();
    {
        const int j = lane, tq = wave, ch = 64 * h + j;
        const float w0 = PIN(p, I_DW0)[(size_t)l * AW + ch], a0 = PIN(p, I_IA0)[(size_t)l * AW + ch], kkw = PIN(p, I_KK)[(size_t)l * AW + ch], kaw = PIN(p, I_KA)[(size_t)l * AW + ch], rkw = PIN(p, I_RK)[(size_t)l * AW + ch];
        const float mur = mu[C_R + ch], muk = mu[C_K + ch], muv = mu[C_V + ch];
        float pr = Xpr0, pk = Xpk0, pv = Xpv0;
        float rr[8], kq[8], kp[8], av[8], vv[8], ld[8], Lc[8], bs[8]; float Lacc = 0.f;
#pragma unroll
        for (int tt = 0; tt < 8; ++tt) {
            const int t = 8 * tq + tt; const bool valid = t < ntok;
            const float cr = valid ? Xcr8[tt] : 0.f, ck = valid ? Xck8[tt] : 0.f, cv = valid ? Xcv8[tt] : 0.f;
            float r_ = cr + (pr - cr) * mur, k_ = ck + (pk - ck) * muk, v_ = cv + (pv - cv) * muv; pr = cr; pk = ck; pv = cv;
            const float w = -softplusf_(-(w0 + DWf[t * 65 + j])) - 0.5f;
            float logd = -expf_(w);
            float a = sigmoidf_(a0 + IAf[t * 65 + j]);
            float kn = k_ * kkw; const float ss = wave_sum(kn * kn); kn = kn * RCPF(fmaxf(sqrtf(ss), 1e-12f));
            float kpp = k_ * (1.0f + (a - 1.0f) * kaw);
            float bsum = wave_sum(r_ * kpp * rkw);
            if (!valid) { logd = 0.f; kn = 0.f; kpp = 0.f; r_ = 0.f; v_ = 0.f; a = 0.f; bsum = 0.f; }
            Lacc += logd; ld[tt] = logd; Lc[tt] = Lacc; rr[tt] = r_; kq[tt] = kn; kp[tt] = kpp; av[tt] = a; vv[tt] = v_; bs[tt] = bsum;
        }
        part[tq * 64 + j] = Lacc;
        WG_SYNC_LDS();
        float off = 0.f;
#pragma unroll
        for (int q = 0; q < 8; ++q) if (q < tq) off += part[q * 64 + j];
        float fa[8], fb[8], fk[8], gt[8], bn[8];
#pragma unroll
        for (int tt = 0; tt < 8; ++tt) {
            const int t = 8 * tq + tt; const float L = Lc[tt] + off, Lm = L - ld[tt], eL = expf_(L), eLm = expf_(Lm), enL = expf_(-L);
            const float At = -kq[tt] * eLm, Bt = kq[tt] * av[tt] * enL, Kt = kp[tt] * enL, Rt = rr[tt] * eL;
            *(LAS bf16_t*)(B0 + swz(t, j)) = (bf16_t)f2bf(At); *(LAS bf16_t*)(B2 + swz(t, j)) = (bf16_t)f2bf(Bt); *(LAS bf16_t*)(B4 + swz(t, j)) = (bf16_t)f2bf(Kt); *(LAS bf16_t*)(B6 + swz(t, j)) = (bf16_t)f2bf(Rt);
            RtF[t * 65 + j] = Rt; fa[tt] = At; fb[tt] = Bt; fk[tt] = Kt; gt[tt] = GGf[t * 65 + j]; bn[tt] = bs[tt] * vv[tt];
            if (t == 63) gam[j] = eL;
        }
#define R1_PK8(a) ((u32x4){pk2(a[0], a[1]), pk2(a[2], a[3]), pk2(a[4], a[5]), pk2(a[6], a[7])})
        *(LAS u32x4*)(B1 + swz(j, 8 * tq)) = R1_PK8(fa); *(LAS u32x4*)(B3 + swz(j, 8 * tq)) = R1_PK8(fb); *(LAS u32x4*)(B5 + swz(j, 8 * tq)) = R1_PK8(fk); *(LAS u32x4*)(B7 + swz(j, 8 * tq)) = R1_PK8(vv);
        *(u32x4*)((bf16_t*)(p.ws + WS_GT) + (size_t)u * 4096 + j * 64 + 8 * tq) = R1_PK8(gt);
        *(u32x4*)((bf16_t*)(p.ws + WS_BNT) + (size_t)u * 4096 + j * 64 + 8 * tq) = R1_PK8(bn);
#undef R1_PK8
    }
    WG_SYNC_LDS();
    r1_fetch(p, l, unext, R1IN_ARGS, lane, wave);
    f32x4 accP[2];
    const f32x4 zero4 = (f32x4){0.f, 0.f, 0.f, 0.f};
#pragma unroll
    for (int q = 0; q < 2; ++q) {
        const int ti = 2 * wave + q, m0 = 16 * (ti >> 2), n0 = 16 * (ti & 3), t = m0 + r;
        f32x4 x = mm64(B2, n0, B0, m0, zero4, lane);
        f32x4 pI;
#pragma unroll
        for (int reg = 0; reg < 4; ++reg) { const int s = n0 + 4 * g4 + reg; if (!(t > s)) x[reg] = 0.f; pI[reg] = x[reg] + (t == s ? 1.f : 0.f); }
        st_tile_T(A0, n0, m0, x, lane); st_tile_T(A2, n0, m0, pI, lane); accP[q] = pI;
        f32x4 y = mm64(B0, m0, B2, n0, zero4, lane);
#pragma unroll
        for (int reg = 0; reg < 4; ++reg) { if (!(m0 + 4 * g4 + reg > n0 + r)) y[reg] = 0.f; }
        st_tile_T(A1, m0, n0, y, lane);
        x = mm64(B4, n0, B0, m0, zero4, lane);
#pragma unroll
        for (int reg = 0; reg < 4; ++reg) { if (!(t > n0 + 4 * g4 + reg)) x[reg] = 0.f; }
        st_tile_T(A3, n0, m0, x, lane);
        x = mm64(B2, n0, B6, m0, zero4, lane);
#pragma unroll
        for (int reg = 0; reg < 4; ++reg) { if (!(t >= n0 + 4 * g4 + reg)) x[reg] = 0.f; }
        st_tile_T(A4, n0, m0, x, lane);
        x = mm64(B4, n0, B6, m0, zero4, lane);
#pragma unroll
        for (int reg = 0; reg < 4; ++reg) { if (!(t >= n0 + 4 * g4 + reg)) x[reg] = 0.f; }
        st_tile_T(A5, n0, m0, x, lane);
    }
    WG_SYNC_LDS();
#define R1_STAGE_A(Ys, YTs, Yd, YTd) do { _Pragma("unroll") for (int q = 0; q < 2; ++q) { const int ti = 2 * wave + q, m0 = 16 * (ti >> 2), n0 = 16 * (ti & 3); \
        st_tile_T(Yd, n0, m0, mm64(YTs, n0, Ys, m0, zero4, lane), lane); st_tile_T(YTd, m0, n0, mm64(Ys, m0, YTs, n0, zero4, lane), lane); } } while (0)
#define R1_STAGE_B(Ps, YTn, Pd) do { _Pragma("unroll") for (int q = 0; q < 2; ++q) { const int ti = 2 * wave + q, m0 = 16 * (ti >> 2), n0 = 16 * (ti & 3); \
        accP[q] = mm64(YTn, n0, Ps, m0, accP[q], lane); st_tile_T(Pd, n0, m0, accP[q], lane); } } while (0)
    R1_STAGE_A(A0, A1, B0, B2);
    WG_SYNC_LDS();
#pragma unroll 1
    for (int it = 1; it <= 5; ++it) {
        const int nxt = it & 1;
        LDSP Ps = nxt ? A2 : B4, Pd = nxt ? B4 : A2, YTn = nxt ? B2 : A1;
        R1_STAGE_B(Ps, YTn, Pd);
        if (it < 5) { LDSP Ys = nxt ? B0 : A0, YTs = nxt ? B2 : A1, Yd = nxt ? A0 : B0, YTd = nxt ? A1 : B2; R1_STAGE_A(Ys, YTs, Yd, YTd); }
        WG_SYNC_LDS();
    }
#undef R1_STAGE_A
#undef R1_STAGE_B
#pragma unroll
    for (int q = 0; q < 2; ++q) {
        const int ti = 2 * wave + q, m0 = 16 * (ti >> 2), n0 = 16 * (ti & 3);
        st_tile_T(B6, n0, m0, mm64(B4, n0, B1, m0, zero4, lane), lane);
        st_tile_T(A0, n0, m0, mm64(A3, n0, B7, m0, zero4, lane), lane);
    }
    WG_SYNC_LDS();
#pragma unroll
    for (int q = 0; q < 2; ++q) {
        const int ti = 2 * wave + q, m0 = 16 * (ti >> 2), n0 = 16 * (ti & 3);
        st_tile_T(A1, n0, m0, mm64(B4, n0, A0, m0, zero4, lane), lane);
        f32x4 x = mm64(B6, m0, B3, n0, zero4, lane);
        { const int jp = n0 + r; const float gj = gam[jp]; u32x2 w;
          float y[4];
#pragma unroll
          for (int reg = 0; reg < 4; ++reg) y[reg] = (x[reg] + ((m0 + 4 * g4 + reg) == jp ? 1.f : 0.f)) * gj;
          w.x = pk2(y[0], y[1]); w.y = pk2(y[2], y[3]);
          *(u32x2*)((bf16_t*)(p.ws + WS_PCT) + (size_t)u * 4096 + jp * 64 + m0 + 4 * g4) = w; }
        x = mm64(B6, n0, A4, m0, zero4, lane);
        { const int t = m0 + r, j0 = n0 + 4 * g4; u32x2 w;
          w.x = pk2(x[0] + RtF[t * 65 + j0], x[1] + RtF[t * 65 + j0 + 1]); w.y = pk2(x[2] + RtF[t * 65 + j0 + 2], x[3] + RtF[t * 65 + j0 + 3]);
          *(u32x2*)((bf16_t*)(p.ws + WS_QTT) + (size_t)u * 4096 + t * 64 + j0) = w; }
    }
    WG_SYNC_LDS();
#pragma unroll
    for (int q = 0; q < 2; ++q) {
        const int ti = 2 * wave + q, m0 = 16 * (ti >> 2), n0 = 16 * (ti & 3);
        f32x4 x = mm64(B3, m0, A1, n0, zero4, lane); x = mm64(B5, m0, B7, n0, x, lane);
#pragma unroll
        for (int reg = 0; reg < 4; ++reg) x[reg] *= gam[m0 + 4 * g4 + reg];
        *(f32x4*)((float*)(p.ws + WS_UCS) + (size_t)u * 4096 + (n0 + r) * 64 + m0 + 4 * g4) = x;
        x = mm64(A4, m0, A1, n0, zero4, lane); x = mm64(A5, m0, B7, n0, x, lane);
        *(f32x4*)((float*)(p.ws + WS_YLT) + (size_t)u * 4096 + (ti * 64 + lane) * 4) = x;
    }
    WG_SYNC_LDS();
}

DEV void r2_chain(const Params& p, int l, int task, int lane) {
    const int h = task >> 2, q = task & 3, r = lane & 15, g4 = lane >> 4, i = 16 * q + r;
    const bf16_t* PCT = (const bf16_t*)(p.ws + WS_PCT); const float* UCS = (const float*)(p.ws + WS_UCS); bf16_t* SC = (bf16_t*)(p.ws + WS_SC);
    f32x4 S[4];
#pragma unroll
    for (int mt = 0; mt < 4; ++mt) S[mt] = (f32x4){0.f, 0.f, 0.f, 0.f};
    bf16x4 a0[4][2], a1[4][2]; f32x4 ci[4];
#define R2_LOAD(cc) do { const size_t u_ = (size_t)(cc) * AH + h; _Pragma("unroll") for (int mt = 0; mt < 4; ++mt) { ci[mt] = *(const f32x4*)(UCS + u_ * 4096 + i * 64 + 16 * mt + 4 * g4); \
        _Pragma("unroll") for (int ks = 0; ks < 2; ++ks) { a0[mt][ks] = *(const bf16x4*)(PCT + u_ * 4096 + (16 * mt + r) * 64 + 32 * ks + 4 * g4); a1[mt][ks] = *(const bf16x4*)(PCT + u_ * 4096 + (16 * mt + r) * 64 + 32 * ks + 16 + 4 * g4); } } } while (0)
    R2_LOAD(0);
#pragma unroll 1
    for (int c = 0; c < NCH; ++c) {
        const size_t u = (size_t)c * AH + h;
        bf16x8 pb[2];
#pragma unroll
        for (int ks = 0; ks < 2; ++ks) pb[ks] = pack8(S[2 * ks], S[2 * ks + 1]);
#pragma unroll
        for (int mt = 0; mt < 4; ++mt) { u32x2 w; w.x = pk2(S[mt][0], S[mt][1]); w.y = pk2(S[mt][2], S[mt][3]); *(u32x2*)(SC + u * 4096 + i * 64 + 16 * mt + 4 * g4) = w; }
        bf16x8 af[4][2]; f32x4 cc[4];
#pragma unroll
        for (int mt = 0; mt < 4; ++mt) { cc[mt] = ci[mt];
#pragma unroll
            for (int ks = 0; ks < 2; ++ks) af[mt][ks] = (bf16x8){a0[mt][ks][0], a0[mt][ks][1], a0[mt][ks][2], a0[mt][ks][3], a1[mt][ks][0], a1[mt][ks][1], a1[mt][ks][2], a1[mt][ks][3]}; }
        if (c + 1 < NCH) R2_LOAD(c + 1);
#pragma unroll
        for (int mt = 0; mt < 4; ++mt) { f32x4 x = MFMA16(af[mt][0], pb[0], cc[mt]); S[mt] = MFMA16(af[mt][1], pb[1], x); }
    }
#undef R2_LOAD
    float* o = p.out + O_PWKV + ((size_t)l * AH + h) * 4096;
#pragma unroll
    for (int mt = 0; mt < 4; ++mt) *(f32x4*)(o + i * 64 + 16 * mt + 4 * g4) = S[mt];
}

constexpr int R2_NSLOT = 12, R2_SLOTB = 12288, R2_FLAGS = R2_NSLOT * R2_SLOTB;
static_assert(R2_FLAGS + 128 <= LDS_CTL_OFF, "R2 ring");
DEV void r2_chain_ring(const Params& p, int l, int task, LDSP lds, int wave, int lane) {
    const int h = task >> 2, q = task & 3, r = lane & 15, g4 = lane >> 4, i = 16 * q + r;
    volatile LAS unsigned* full = (volatile LAS unsigned*)(lds + R2_FLAGS); volatile LAS unsigned* prog = full + 16;
    if (wave == 0 && lane < 32) full[lane] = 0u;
    WG_SYNC();
    if (wave > 0) {
        const unsigned char* PCT = p.ws + WS_PCT; const unsigned char* UCS = p.ws + WS_UCS;
#define R2_LOAD(V_, cc) do { const size_t u_ = (size_t)((cc) < NCH ? (cc) : NCH - 1) * AH + h; _Pragma("unroll") for (int k = 0; k < 8; ++k) V_[k] = *(const u32x4*)(PCT + u_ * 8192 + k * 1024 + lane * 16); \
        _Pragma("unroll") for (int k = 0; k < 4; ++k) V_[8 + k] = *(const u32x4*)(UCS + u_ * 16384 + (size_t)q * 4096 + k * 1024 + lane * 16); } while (0)
#define R2_PUT(V_, cc) do { if ((cc) < NCH) { const int slot = (cc) % R2_NSLOT; while ((int)*prog + R2_NSLOT <= (cc)) SPIN_WAIT(); COMPILER_FENCE(); \
        _Pragma("unroll") for (int k = 0; k < 8; ++k) { const int row = 8 * k + (lane >> 3); *(LAS u32x4*)(lds + slot * R2_SLOTB + row * 128 + (((lane & 7) ^ (row & 7)) << 4)) = V_[k]; } \
        _Pragma("unroll") for (int k = 0; k < 4; ++k) { const int row = 4 * k + (lane >> 4); *(LAS u32x4*)(lds + slot * R2_SLOTB + 8192 + row * 256 + (((lane & 15) ^ row) << 4)) = V_[8 + k]; } \
        LDS_DRAIN(); if (lane == 0) full[slot] = (unsigned)(cc) + 1u; } } while (0)
        u32x4 va[12], vb[12];
        int c = wave - 1;
        R2_LOAD(va, c);
#pragma unroll 1
        for (; c < NCH; c += 2 * (NWAVES - 1)) {
            R2_LOAD(vb, c + (NWAVES - 1));
            R2_PUT(va, c);
            R2_LOAD(va, c + 2 * (NWAVES - 1));
            R2_PUT(vb, c + (NWAVES - 1));
        }
#undef R2_LOAD
#undef R2_PUT
        return;
    }
    bf16_t* SC = (bf16_t*)(p.ws + WS_SC);
    f32x4 S[4];
#pragma unroll
    for (int mt = 0; mt < 4; ++mt) S[mt] = (f32x4){0.f, 0.f, 0.f, 0.f};
#pragma unroll 1
    for (int c = 0; c < NCH; ++c) {
        const size_t u = (size_t)c * AH + h; const int slot = c % R2_NSLOT;
        bf16x8 pb[2];
#pragma unroll
        for (int ks = 0; ks < 2; ++ks) pb[ks] = pack8(S[2 * ks], S[2 * ks + 1]);
#pragma unroll
        for (int mt = 0; mt < 4; ++mt) { u32x2 w; w.x = pk2(S[mt][0], S[mt][1]); w.y = pk2(S[mt][2], S[mt][3]); *(u32x2*)(SC + u * 4096 + i * 64 + 16 * mt + 4 * g4) = w; }
        while (full[slot] != (unsigned)c + 1u) SPIN_WAIT();
        COMPILER_FENCE();
        LDSP sl = lds + slot * R2_SLOTB;
        bf16x8 af[4][2]; f32x4 cc[4];
#pragma unroll
        for (int mt = 0; mt < 4; ++mt) { cc[mt] = *(const LAS f32x4*)(sl + 8192 + r * 256 + ((((4 * mt + g4) ^ r) & 15) << 4));
#pragma unroll
            for (int ks = 0; ks < 2; ++ks) { const int prow = 16 * mt + r, pch = 4 * ks + (g4 >> 1), pof = (g4 & 1) * 8;
                const bf16x4 lo = *(const LAS bf16x4*)(sl + prow * 128 + (((pch ^ prow) & 7) << 4) + pof), hi = *(const LAS bf16x4*)(sl + prow * 128 + ((((pch + 2) ^ prow) & 7) << 4) + pof);
                af[mt][ks] = (bf16x8){lo[0], lo[1], lo[2], lo[3], hi[0], hi[1], hi[2], hi[3]}; } }
        LDS_DRAIN();
        if (lane == 0) *prog = (unsigned)c + 1u;
#pragma unroll
        for (int mt = 0; mt < 4; ++mt) { f32x4 x = MFMA16(af[mt][0], pb[0], cc[mt]); S[mt] = MFMA16(af[mt][1], pb[1], x); }
    }
    float* o = p.out + O_PWKV + ((size_t)l * AH + h) * 4096;
#pragma unroll
    for (int mt = 0; mt < 4; ++mt) *(f32x4*)(o + i * 64 + 16 * mt + 4 * g4) = S[mt];
}
DEV void r2_sample(const Params& p, int l, int task, int lane) {
    const int q = task & 3, bh = task >> 2, r = lane & 15, g4 = lane >> 4, i = 16 * q + r;
    const size_t u = (size_t)NUP + bh;
    const bf16_t* PCT = (const bf16_t*)(p.ws + WS_PCT) + u * 4096; const float* UCS = (const float*)(p.ws + WS_UCS) + u * 4096;
    const float* S0 = PIN(p, I_SWKV) + ((size_t)l * DECB * AH + bh) * 4096;
    bf16x8 pb[2];
#pragma unroll
    for (int ks = 0; ks < 2; ++ks) { const f32x4 lo = *(const f32x4*)(S0 + i * 64 + 32 * ks + 8 * g4), hi = *(const f32x4*)(S0 + i * 64 + 32 * ks + 8 * g4 + 4); pb[ks] = pack8(lo, hi); }
    float* o = p.out + O_SWKV + ((size_t)l * DECB * AH + bh) * 4096;
#pragma unroll
    for (int mt = 0; mt < 4; ++mt) {
        f32x4 x = *(const f32x4*)(UCS + i * 64 + 16 * mt + 4 * g4);
#pragma unroll
        for (int ks = 0; ks < 2; ++ks) { const bf16x8 a = *(const bf16x8*)(PCT + (16 * mt + r) * 64 + 32 * ks + 8 * g4); x = MFMA16(a, pb[ks], x); }
        *(f32x4*)(o + i * 64 + 16 * mt + 4 * g4) = x;
    }
}

DEV void r3_work(const Params& p, int l, int u, int mt, int lane) {
    const bool samp = u >= NUP; int c = 0, b = 0, h;
    if (!samp) { c = u / AH; h = u % AH; } else { const int s = u - NUP; b = s / AH; h = s % AH; if (mt > 0) return; }
    const int r = lane & 15, g4 = lane >> 4;
    const bf16_t* Q = (const bf16_t*)(p.ws + WS_QTT) + (size_t)u * 4096;
    bf16x8 a[2];
#pragma unroll
    for (int ks = 0; ks < 2; ++ks) a[ks] = *(const bf16x8*)(Q + (16 * mt + r) * 64 + 32 * ks + 8 * g4);
    f32x4 acc[4];
#pragma unroll
    for (int nt = 0; nt < 4; ++nt) {
        acc[nt] = *(const f32x4*)((const float*)(p.ws + WS_YLT) + (size_t)u * 4096 + ((mt * 4 + nt) * 64 + lane) * 4);
#pragma unroll
        for (int ks = 0; ks < 2; ++ks) {
            bf16x8 bb;
            if (!samp) bb = *(const bf16x8*)((const bf16_t*)(p.ws + WS_SC) + (size_t)u * 4096 + (16 * nt + r) * 64 + 32 * ks + 8 * g4);
            else { const float* S0 = PIN(p, I_SWKV) + (((size_t)l * DECB + b) * AH + h) * 4096 + (16 * nt + r) * 64 + 32 * ks + 8 * g4; bb = pack8(*(const f32x4*)S0, *(const f32x4*)(S0 + 4)); }
            acc[nt] = MFMA16(a[ks], bb, acc[nt]);
        }
    }
    float mean[4], rs[4];
#pragma unroll
    for (int reg = 0; reg < 4; ++reg) {
        float s = (acc[0][reg] + acc[1][reg]) + (acc[2][reg] + acc[3][reg]);
        s = sum16(s);
        const float mn = s * (1.0f / 64.0f); float v = 0.f;
#pragma unroll
        for (int nt = 0; nt < 4; ++nt) { const float d = acc[nt][reg] - mn; v += d * d; }
        v = sum16(v);
        mean[reg] = mn; rs[reg] = RSQRTF(v * (1.0f / 64.0f) + GN_EPS);
    }
    bf16_t* YA = (bf16_t*)(p.ws + WS_YA);
#pragma unroll
    for (int nt = 0; nt < 4; ++nt) {
        const int i = 16 * nt + r; const float gain = PIN(p, I_GNG)[(size_t)l * AW + 64 * h + i], bias = PIN(p, I_GNB)[(size_t)l * AW + 64 * h + i];
        const u32x2 g2 = *(const u32x2*)((const bf16_t*)(p.ws + WS_GT) + (size_t)u * 4096 + i * 64 + 16 * mt + 4 * g4);
        const u32x2 b2 = *(const u32x2*)((const bf16_t*)(p.ws + WS_BNT) + (size_t)u * 4096 + i * 64 + 16 * mt + 4 * g4);
        const float gg[4] = {bf2f(g2.x & 0xffffu), bf2f(g2.x >> 16), bf2f(g2.y & 0xffffu), bf2f(g2.y >> 16)};
        const float bn[4] = {bf2f(b2.x & 0xffffu), bf2f(b2.x >> 16), bf2f(b2.y & 0xffffu), bf2f(b2.y >> 16)};
#pragma unroll
        for (int reg = 0; reg < 4; ++reg) {
            const int t = 16 * mt + 4 * g4 + reg; const size_t row = samp ? (size_t)SEQ + 16 * b + t : (size_t)64 * c + t;
            const float y = ((acc[nt][reg] - mean[reg]) * rs[reg] * gain + bias + bn[reg]) * gg[reg];
            YA[row * YLD + 64 * h + i] = (bf16_t)f2bf(y);
        }
    }
}

constexpr int AT_KB = 0, AT_VT = 24576, AT_QB = 49152;
constexpr float QSCALE = 0.125f * LOG2E;
DEV void attn_unit(const Params& p, int l, int au, LDSP lds, int tid) {
    const int lane = tid & 63, wave = WAVE_ID(tid), r = lane & 15, g4 = lane >> 4;
    const bool samp = au >= NAP; int c = 0, b = 0, kh, nk, kbase = 0, nq;
    if (!samp) { c = au / BKV; kh = au % BKV; nk = 64 * (c + 1 < 3 ? c + 1 : 3); kbase = 64 * (c > 2 ? c - 2 : 0); nq = 64 * GRP; }
    else { const int s = au - NAP; b = s / BKV; kh = s % BKV; nk = WIN + DECS; nq = DECS * GRP; }
    const bf16_t* PF = (const bf16_t*)(p.ws + WS_PF); const float* rope = (const float*)(p.ws + WS_ROPE);
    LDSP Kb = lds + AT_KB, Vt = lds + AT_VT, Qb = lds + AT_QB;
    const int sub = tid & 7, rowi = tid >> 3;
    f32x4 K1[3], K2[3], V1[3], V2[3], KC0[3], KC1[3];
#pragma unroll
    for (int pp = 0; pp < 3; ++pp) {
        const int kidx = pp * 64 + rowi;
        if (kidx < nk) {
            if (samp && kidx < WIN) {
                const size_t o = ((((size_t)l * DECB + b) * WIN + kidx) * BKV + kh) * 64; const float* ck = PIN(p, I_CK) + o; const float* cv = PIN(p, I_CV) + o;
                K1[pp] = *(const f32x4*)(ck + 4 * sub); K2[pp] = *(const f32x4*)(ck + 32 + 4 * sub); V1[pp] = *(const f32x4*)(cv + 4 * sub); V2[pp] = *(const f32x4*)(cv + 32 + 4 * sub);
            } else {
                const size_t tok = samp ? (size_t)SEQ + 16 * b + (kidx - WIN) : (size_t)kbase + kidx; const int slot = samp ? SEQ + (kidx - WIN) : (int)tok;
                const bf16_t* src = PF + tok * FW;
                K1[pp] = ldbf4(src + C_BK + 64 * kh + 4 * sub); K2[pp] = ldbf4(src + C_BK + 64 * kh + 32 + 4 * sub);
                V1[pp] = ldbf4(src + C_BV + 64 * kh + 4 * sub); V2[pp] = ldbf4(src + C_BV + 64 * kh + 32 + 4 * sub);
                KC0[pp] = *(const f32x4*)(rope + (size_t)slot * 64 + 8 * sub); KC1[pp] = *(const f32x4*)(rope + (size_t)slot * 64 + 8 * sub + 4);
            }
        }
    }
    f32x4 Q1[GRP], Q2[GRP], QC0[GRP], QC1[GRP];
#pragma unroll
    for (int pp = 0; pp < GRP; ++pp) {
        const int q = pp * 64 + rowi;
        if (q < nq) {
            const int g = samp ? q >> 4 : q >> 6, t = samp ? q & 15 : q & 63, head = kh * GRP + g;
            const size_t tok = samp ? (size_t)SEQ + 16 * b + t : (size_t)64 * c + t; const int slot = samp ? SEQ + t : (int)tok;
            const bf16_t* src = PF + tok * FW + C_Q + 64 * head;
            Q1[pp] = ldbf4(src + 4 * sub); Q2[pp] = ldbf4(src + 32 + 4 * sub);
            QC0[pp] = *(const f32x4*)(rope + (size_t)slot * 64 + 8 * sub); QC1[pp] = *(const f32x4*)(rope + (size_t)slot * 64 + 8 * sub + 4);
        }
    }
    const f32x4 kg1 = *(const f32x4*)(PIN(p, I_KN) + (size_t)l * 64 + 4 * sub), kg2 = *(const f32x4*)(PIN(p, I_KN) + (size_t)l * 64 + 32 + 4 * sub);
    const f32x4 qg1 = *(const f32x4*)(PIN(p, I_QN) + (size_t)l * 64 + 4 * sub), qg2 = *(const f32x4*)(PIN(p, I_QN) + (size_t)l * 64 + 32 + 4 * sub);
#pragma unroll
    for (int pp = 0; pp < 3; ++pp) {
        const int kidx = pp * 64 + rowi;
        if (kidx < nk) {
            f32x4 k1 = K1[pp], k2 = K2[pp]; const f32x4 v1 = V1[pp], v2 = V2[pp];
            if (!(samp && kidx < WIN)) {
                const size_t tok = samp ? (size_t)SEQ + 16 * b + (kidx - WIN) : (size_t)kbase + kidx;
                const f32x4 x1 = k1, x2 = k2;
                float ss = (x1[0] * x1[0] + x1[1] * x1[1]) + (x1[2] * x1[2] + x1[3] * x1[3]) + (x2[0] * x2[0] + x2[1] * x2[1]) + (x2[2] * x2[2] + x2[3] * x2[3]);
                ss = sum8(ss);
                const float rinv = RSQRTF(ss * (1.0f / 64.0f) + RMS_EPS);
                const float cc[4] = {KC0[pp][0], KC0[pp][2], KC1[pp][0], KC1[pp][2]}, sn[4] = {KC0[pp][1], KC0[pp][3], KC1[pp][1], KC1[pp][3]};
#pragma unroll
                for (int e = 0; e < 4; ++e) { const float y1 = x1[e] * rinv * kg1[e], y2 = x2[e] * rinv * kg2[e]; k1[e] = y1 * cc[e] - y2 * sn[e]; k2[e] = y2 * cc[e] + y1 * sn[e]; }
                if (samp) { const size_t o = ((((size_t)l * DECB + b) * DECS + (kidx - WIN)) * BKV + kh) * 64;
                    *(f32x4*)(p.out + O_SK + o + 4 * sub) = k1; *(f32x4*)(p.out + O_SK + o + 32 + 4 * sub) = k2; *(f32x4*)(p.out + O_SV + o + 4 * sub) = v1; *(f32x4*)(p.out + O_SV + o + 32 + 4 * sub) = v2; }
                else if (kidx >= nk - 64 && tok >= (size_t)(SEQ - WIN)) { const size_t o = (((size_t)l * WIN + (tok - (SEQ - WIN))) * BKV + kh) * 64;
                    *(f32x4*)(p.out + O_PK + o + 4 * sub) = k1; *(f32x4*)(p.out + O_PK + o + 32 + 4 * sub) = k2; *(f32x4*)(p.out + O_PV + o + 4 * sub) = v1; *(f32x4*)(p.out + O_PV + o + 32 + 4 * sub) = v2; }
            }
            u32x2 w; w.x = pk2(k1[0], k1[1]); w.y = pk2(k1[2], k1[3]); *(LAS u32x2*)(Kb + swz(kidx, 4 * sub)) = w;
            w.x = pk2(k2[0], k2[1]); w.y = pk2(k2[2], k2[3]); *(LAS u32x2*)(Kb + swz(kidx, 32 + 4 * sub)) = w;
#pragma unroll
            for (int e = 0; e < 4; ++e) { *(LAS bf16_t*)(Vt + swz192(4 * sub + e, kidx)) = (bf16_t)f2bf(v1[e]); *(LAS bf16_t*)(Vt + swz192(32 + 4 * sub + e, kidx)) = (bf16_t)f2bf(v2[e]); }
        } else if (kidx < ((nk + 31) & ~31)) {
#pragma unroll
            for (int e = 0; e < 4; ++e) { *(LAS bf16_t*)(Vt + swz192(4 * sub + e, kidx)) = 0; *(LAS bf16_t*)(Vt + swz192(32 + 4 * sub + e, kidx)) = 0; }
        }
    }
#pragma unroll
    for (int pp = 0; pp < GRP; ++pp) {
        const int q = pp * 64 + rowi;
        if (q < nq) {
            const f32x4 x1 = Q1[pp], x2 = Q2[pp];
            float ss = (x1[0] * x1[0] + x1[1] * x1[1]) + (x1[2] * x1[2] + x1[3] * x1[3]) + (x2[0] * x2[0] + x2[1] * x2[1]) + (x2[2] * x2[2] + x2[3] * x2[3]);
            ss = sum8(ss);
            const float rinv = RSQRTF(ss * (1.0f / 64.0f) + RMS_EPS) * QSCALE;
            const float cc[4] = {QC0[pp][0], QC0[pp][2], QC1[pp][0], QC1[pp][2]}, sn[4] = {QC0[pp][1], QC0[pp][3], QC1[pp][1], QC1[pp][3]};
            float o1[4], o2[4];
#pragma unroll
            for (int e = 0; e < 4; ++e) { const float y1 = x1[e] * rinv * qg1[e], y2 = x2[e] * rinv * qg2[e]; o1[e] = y1 * cc[e] - y2 * sn[e]; o2[e] = y2 * cc[e] + y1 * sn[e]; }
            u32x2 w; w.x = pk2(o1[0], o1[1]); w.y = pk2(o1[2], o1[3]); *(LAS u32x2*)(Qb + swz(q, 4 * sub)) = w;
            w.x = pk2(o2[0], o2[1]); w.y = pk2(o2[2], o2[3]); *(LAS u32x2*)(Qb + swz(q, 32 + 4 * sub)) = w;
        }
    }
    WG_SYNC_LDS();
    const int nqt = nq >> 4, nkt = nk >> 4;
    bf16_t* YB = (bf16_t*)(p.ws + WS_YA) + AW;
#pragma unroll 1
    for (int qt = wave; qt < nqt; qt += NWAVES) {
        const int g = samp ? qt : qt >> 2, head = kh * GRP + g;
        const float sink2 = PIN(p, I_SINK)[(size_t)l * BH + head] * LOG2E;
        bf16x8 bq[2];
#pragma unroll
        for (int ks = 0; ks < 2; ++ks) bq[ks] = *(const LAS bf16x8*)(Qb + swz(16 * qt + r, 32 * ks + 8 * g4));
        f32x4 s[12];
#pragma unroll
        for (int kt = 0; kt < 12; ++kt) { s[kt] = (f32x4){0.f, 0.f, 0.f, 0.f};
            if (kt < nkt) {
#pragma unroll
                for (int ks = 0; ks < 2; ++ks) { const bf16x8 a = *(const LAS bf16x8*)(Kb + swz(16 * kt + r, 32 * ks + 8 * g4)); s[kt] = MFMA16(a, bq[ks], s[kt]); } } }
        float mx = sink2;
#pragma unroll
        for (int kt = 0; kt < 12; ++kt) if (kt < nkt) mx = fmaxf(fmaxf(mx, fmaxf(s[kt][0], s[kt][1])), fmaxf(s[kt][2], s[kt][3]));
        mx = fmaxf(mx, SHFL_XOR(mx, 16)); mx = fmaxf(mx, SHFL_XOR(mx, 32));
        float sum = 0.f;
#pragma unroll
        for (int kt = 0; kt < 12; ++kt) if (kt < nkt) {
#pragma unroll
            for (int e = 0; e < 4; ++e) { s[kt][e] = EXP2F(s[kt][e] - mx); sum += s[kt][e]; } }
        sum += SHFL_XOR(sum, 16); sum += SHFL_XOR(sum, 32);
        const float rden = 1.0f / (sum + EXP2F(sink2 - mx));
        f32x4 o[4];
#pragma unroll
        for (int dt = 0; dt < 4; ++dt) o[dt] = (f32x4){0.f, 0.f, 0.f, 0.f};
#pragma unroll
        for (int s2 = 0; s2 < 6; ++s2) if (2 * s2 < nkt) {
            const bf16x8 pb = pack8(s[2 * s2], s[2 * s2 + 1]);
#pragma unroll
            for (int dt = 0; dt < 4; ++dt) {
                const bf16x4 lo = *(const LAS bf16x4*)(Vt + swz192(16 * dt + r, 32 * s2 + 4 * g4)), hi = *(const LAS bf16x4*)(Vt + swz192(16 * dt + r, 32 * s2 + 16 + 4 * g4));
                o[dt] = MFMA16(((bf16x8){lo[0], lo[1], lo[2], lo[3], hi[0], hi[1], hi[2], hi[3]}), pb, o[dt]);
            }
        }
        const int q = 16 * qt + r, t = samp ? q & 15 : q & 63; const size_t tok = samp ? (size_t)SEQ + 16 * b + t : (size_t)64 * c + t;
#pragma unroll
        for (int dt = 0; dt < 4; ++dt) { u32x2 w; w.x = pk2(o[dt][0] * rden, o[dt][1] * rden); w.y = pk2(o[dt][2] * rden, o[dt][3] * rden); *(u32x2*)(YB + tok * YLD + 64 * head + 16 * dt + 4 * g4) = w; }
    }
    WG_SYNC_LDS();
}

#ifndef EMU
#define XB_TMO      128
#define XB_XCNT(j)  (256  + 64 * (j))
#define XB_XSUB(j)  (1280 + 64 * (j))
#define XB_XGEN(j)  (2304 + 64 * (j))
#define XB_TOP      3328
#define XB_TOPGEN   3392
#define XCD_BAR_WORDS 3456
#define XB_SPIN_CAP (1u << 18)

__device__ __forceinline__ unsigned xb_ld(unsigned* p)              { return __hip_atomic_load(p, __ATOMIC_RELAXED, __HIP_MEMORY_SCOPE_AGENT); }
__device__ __forceinline__ unsigned xb_add(unsigned* p, unsigned v) { return __hip_atomic_fetch_add(p, v, __ATOMIC_RELAXED, __HIP_MEMORY_SCOPE_AGENT); }
__device__ __forceinline__ unsigned xb_xcc_id() { return (unsigned)__builtin_amdgcn_s_getreg((3 << 11) | 20) & 0xFu; }
#define XB_SPIN(cond, bar) do { unsigned _sp = 0; while (cond) { __builtin_amdgcn_s_sleep(1); \
    if ((++_sp & 255u) == 0u) { if (xb_ld(&(bar)[XB_TMO])) break; if (_sp > XB_SPIN_CAP) { atomicAdd(&(bar)[XB_TMO], 1u); break; } } } } while (0)

struct XcdBarrier {
    unsigned* bar; unsigned x;
    volatile LAS unsigned* st;
};

__device__ __forceinline__ XcdBarrier xcd_barrier_post(unsigned* bar, volatile LAS unsigned* st) {
    XcdBarrier b; b.bar = bar; b.x = xb_xcc_id(); b.st = st;
    if (threadIdx.x == 0) (void)xb_add(&bar[XB_XCNT(b.x)], 1u);
    return b;
}
__device__ __forceinline__ void xcd_barrier_complete(unsigned* bar, unsigned x, unsigned& nloc, unsigned& nx) {
    const unsigned G = gridDim.x * gridDim.y * gridDim.z;
    unsigned sum, cnt, mine, sp = 0u;
    for (;;) {
        sum = 0u; cnt = 0u; mine = 0u;
#pragma unroll
        for (unsigned j = 0; j < 16; ++j) { const unsigned c = xb_ld(&bar[XB_XCNT(j)]); sum += c; cnt += (c > 0u) ? 1u : 0u; mine = (j == x) ? c : mine; }
        if (sum == G) break;
        __builtin_amdgcn_s_sleep(1);
        if ((++sp & 255u) == 0u) { if (xb_ld(&bar[XB_TMO])) break; if (sp > XB_SPIN_CAP) { atomicAdd(&bar[XB_TMO], 1u); break; } }
    }
    nloc = mine > 0u ? mine : 1u; nx = cnt > 0u ? cnt : 1u;
}

__device__ __forceinline__ void xcd_barrier(const XcdBarrier& b) {
    asm volatile("s_waitcnt vmcnt(0)" ::: "memory");
    __syncthreads();
    if (threadIdx.x == 0) {
        unsigned* bar = b.bar;
        __builtin_amdgcn_s_waitcnt(0);
        unsigned nloc = b.st[0], nx = b.st[1];
        if (nloc == 0u) { xcd_barrier_complete(bar, b.x, nloc, nx); b.st[0] = nloc; b.st[1] = nx; }
        const unsigned old = xb_add(&bar[XB_XSUB(b.x)], 1u);
        const unsigned gen = old / nloc;
        if (old + 1u == (gen + 1u) * nloc) {
            __builtin_amdgcn_fence(__ATOMIC_RELEASE, "agent");
            asm volatile("s_waitcnt vmcnt(0)" ::: "memory");
            const unsigned og = xb_add(&bar[XB_TOP], 1u);
            const unsigned tg = og / nx;
            if (og + 1u == (tg + 1u) * nx) xb_add(&bar[XB_TOPGEN], 1u);
            else XB_SPIN(xb_ld(&bar[XB_TOPGEN]) == tg, bar);
            __builtin_amdgcn_fence(__ATOMIC_ACQUIRE, "agent");
            xb_add(&bar[XB_XGEN(b.x)], 1u);
            asm volatile("s_waitcnt vmcnt(0)" ::: "memory");
        } else {
            XB_SPIN(xb_ld(&bar[XB_XGEN(b.x)]) == gen, bar);
            __builtin_amdgcn_fence(__ATOMIC_ACQUIRE, "agent");
            asm volatile("s_waitcnt vmcnt(0)" ::: "memory");
        }
    }
    __syncthreads();
}
#endif

#ifndef REP_GU
#define REP_GU 1
#endif
#ifndef REP_DOWN
#define REP_DOWN 1
#endif
#ifndef REP_WIN
#define REP_WIN 1
#endif
#ifndef REP_UP
#define REP_UP 1
#endif
#ifndef REP_WO
#define REP_WO 1
#endif
#ifndef CONV_N_GU
#define CONV_N_GU 0
#endif
#ifndef CONV_N_WIN
#define CONV_N_WIN 0
#endif
#ifndef CONV_N_R2
#define CONV_N_R2 00
#endif
#ifndef CONV_N_GU
#define CONV_N_GU 0
#endif
#ifndef CONV_N_WIN
#define CONV_N_WIN 0
#endif
#ifndef CONV_N_R2
#define CONV_N_R2 0
#endif
#ifndef REP_PRO
#define REP_PRO 1
#endif
#ifndef REP_NORM
#define REP_NORM 1
#endif
#ifndef REP_R1
#define REP_R1 1
#endif
#ifndef REP_R2
#define REP_R2 1
#endif
#ifndef REP_R3
#define REP_R3 1
#endif

#ifndef EMU
#define GRID_BAR() do { XcdBarrier b_; b_.bar = (unsigned*)(P_WS() + WS_CTL) + CW_BAR; b_.x = xb_xcc_id(); b_.st = (volatile LAS unsigned*)(lds + LDS_CTL_OFF + 32); xcd_barrier(b_); } while (0)
constexpr int CW_BAR = 4096;
__global__ void __launch_bounds__(NTHR, 2) fwd(Params p) {
    extern __shared__ __attribute__((aligned(16))) unsigned char lds_raw[];
    LDSP lds = (LDSP)lds_raw;
    const int wave = __builtin_amdgcn_readfirstlane(TID() >> 6), G = GRID(), bid = BID();
    for (int u = TID(); u < (LDS_BYTES - LDS_CTL_OFF) / 4; u += NTHR) ((LAS unsigned*)(lds + LDS_CTL_OFF))[u] = 0u;
    __syncthreads();
    (void)xcd_barrier_post((unsigned*)(p.ws + WS_CTL) + CW_BAR, (volatile LAS unsigned*)(lds + LDS_CTL_OFF + 32));
#else
#define GRID_BAR() emu_grid_sync()
static void fwd(Params p) {
    g_emu_params = p;
    LDSP lds = emu_lds();
    const int wave = TID() >> 6, G = GRID(), bid = BID();
#endif
    const int gw = bid * NWAVES + wave, NGW = G * NWAVES, NGT = G * NTHR;
#define LANE_TID() const int lane = FRESH_LANE(), tid = wave * 64 + lane; (void)tid
    bf16_t* XB = (bf16_t*)(p.ws + WS_H);


#ifndef SKIP_PRO
    for (int rep_ = 0; rep_ < REP_PRO; ++rep_) { LANE_TID(); prologue(p, lds, gw, NGW, wave, lane, bid * NTHR + tid, NGT); x0_phase(p, gw, NGW, lane, bid * NTHR + tid, NGT); if (rep_ + 1 < REP_PRO) GRID_BAR(); }
    GRID_BAR();
#endif

#pragma unroll 1
    for (int it = 0; it < 2 * DEPTH; ++it) {
        const int l = it >> 1; const bool sec = (it & 1) != 0;
        const int Gq_ = OPAQUE_S(G), bq_ = OPAQUE_S(bid);
        const int nsi = 3 * l + (sec ? 2 : 0);

for (int rep_ = 0; rep_ < REP_GU; ++rep_) {
#ifndef SKIP_GU
        { pg8::Gemm g{XB, lwp(p, l, sec ? OFF_WGU2 : OFF_WGU1), M, 2 * DFF, DM}; pg8::StaticOrder S; S.init(M, 2 * DFF, Gq_, bq_);
          { LANE_TID(); rinv_table(S, nsi, lds, tid); }
          EpiSwiglu E{lds + LDS_RINV_OFF};
          pg8::gemm_phase<EpiSwiglu, pg8::StaticOrder, true, true>(lds, g, S, E, wave); }
        { constexpr int nwg_ = (M / 256) * (2 * DFF / 256); if (((nwg_ + G - 1) / G - 1) * G + bid >= nwg_) { LANE_TID(); conv_some(p, l + 1, CONV_N_GU, lds, wave, lane); } }
#endif

        GRID_BAR(); }

for (int rep_ = 0; rep_ < REP_DOWN; ++rep_) {
#ifndef SKIP_DOWN
        { pg8::Gemm g{(const bf16_t*)(p.ws + WS_G), lwp(p, l, sec ? OFF_WD2 : OFF_WD1), SEQ, DM, DFF}; pg8::StaticOrder S; S.init(SEQ, DM, Gq_, bq_);
          EpiResid E{0.5f / REP_DOWN, nsi + 1, it == 2 * DEPTH - 1 ? 1 : 0};
#pragma unroll 1
          for (int step = 0; step < 2; ++step) {
              if (((step ^ bid) & 1) == 0) pg8::gemm_phase<EpiResid, pg8::StaticOrder, true, true>(lds, g, S, E, wave);
              else {
#pragma unroll 1
                  for (int tile = bid; tile < (MS / 64) * (DM / 64); tile += G) { LANE_TID(); sgemm_tile(g.A, g.Bt, DFF, SEQ + 64 * (tile % (MS / 64)), 64 * (tile / (MS / 64)), lds, tid, E); } } } }
#endif
        if (rep_ + 1 < REP_DOWN) GRID_BAR(); }
        if (sec) { LANE_TID(); conv_some(p, l + 1, 1 << 30, lds, wave, lane); }

        if (it == 2 * DEPTH - 1) break;
        GRID_BAR();
        if (!sec) {


for (int rep_ = 0; rep_ < REP_WIN; ++rep_) {
#ifndef SKIP_WIN
            { pg8::Gemm g{XB, lwp(p, l, OFF_WIN), M, NIN, DM}; pg8::StaticOrder S; S.init(M, NIN, Gq_, bq_);
              { LANE_TID(); rinv_table(S, 3 * l + 1, lds, tid); }
              EpiWin E{lds + LDS_RINV_OFF};
              pg8::gemm_phase<EpiWin, pg8::StaticOrder, true, true>(lds, g, S, E, wave); }
            { constexpr int nwg_ = (M / 256) * (NIN / 256); if (((nwg_ + Gq_ - 1) / Gq_ - 1) * Gq_ + bq_ >= nwg_) { LANE_TID(); conv_some(p, l + 1, CONV_N_WIN, lds, wave, lane); } }
#endif

            GRID_BAR(); }

            for (int rep_ = 0; rep_ < REP_R1; ++rep_) {
#ifndef SKIP_R1
            { LANE_TID(); lact_phase(p, l, bq_ * NTHR + tid, NGT); }
            GRID_BAR();
            { LANE_TID(); R1IN_DECL; r1_fetch(p, l, bq_ < NU ? bq_ : 0, R1IN_ARGS, lane, wave);
#pragma unroll 1
              for (int u = bq_; u < NU; u += Gq_) r1_unit(p, l, u, u + Gq_ < NU ? u + Gq_ : u, R1IN_ARGS, lds, tid); }
#endif

            GRID_BAR(); }

            for (int rep_ = 0; rep_ < REP_R2; ++rep_) {
#ifndef SKIP_R2
            { constexpr int nchain = 4 * AH; LANE_TID();
              int a0, as_;
              if (Gq_ > nchain) {
                  if (bq_ < nchain) { r2_chain_ring(p, l, bq_, lds, wave, lane); a0 = 1 << 20; as_ = 1; }
                  else { a0 = bq_ - nchain; as_ = Gq_ - nchain; }
              } else {
#pragma unroll 1
                  for (int task = bq_; task < nchain; task += Gq_) r2_chain_ring(p, l, task, lds, wave, lane);
                  WG_SYNC();
                  a0 = bq_; as_ = Gq_;
              }
#pragma unroll 1
              for (int au = a0; au < NA; au += as_) attn_unit(p, l, au, lds, tid);
#pragma unroll 1
              for (int task = a0 * NWAVES + wave; task < 4 * NUS; task += as_ * NWAVES) r2_sample(p, l, task, lane);
              if (a0 < (1 << 20)) conv_some(p, l + 1, CONV_N_R2, lds, wave, lane);
            }
#endif

            GRID_BAR(); }

            for (int rep_ = 0; rep_ < REP_R3; ++rep_) {
#ifndef SKIP_R3
            { const int worker = bq_ * 2 + (wave >> 2), NW = 2 * Gq_; LANE_TID(); const int gtid = bq_ * NTHR + tid;
#pragma unroll 1
              for (int u = worker; u < NU; u += NW) r3_work(p, l, u, wave & 3, lane);
              const bf16_t* PF = (const bf16_t*)(p.ws + WS_PF);
              for (int idx = gtid; idx < (1 + DECB) * ACOLS; idx += NGT) { const int s = idx / ACOLS, col = idx % ACOLS;
                  if (s == 0) p.out[O_PSH + (size_t)l * ACOLS + col] = bf2f(PF[(size_t)(SEQ - 1) * FW + col]);
                  else p.out[O_SSH + ((size_t)l * DECB + (s - 1)) * ACOLS + col] = bf2f(PF[((size_t)SEQ + 16 * (s - 1) + 15) * FW + col]); } }
#endif

            GRID_BAR(); }

for (int rep_ = 0; rep_ < REP_UP; ++rep_) {
#ifndef SKIP_UPA
            { pg8::Gemm g{(const bf16_t*)(p.ws + WS_YA), lwp(p, l, OFF_WUA), SEQ, DM, YLD}; pg8::StaticOrder S; S.init(SEQ, DM, Gq_, bq_);
              EpiUp E{0};
              pg8::gemm_phase<EpiUp, pg8::StaticOrder, true, true>(lds, g, S, E, wave);
#pragma unroll 1
              for (int tile = bid; tile < (MS / 64) * (DM / 64); tile += G) { LANE_TID(); sgemm_tile(g.A, g.Bt, YLD, SEQ + 64 * (tile % (MS / 64)), 64 * (tile / (MS / 64)), lds, tid, E); } }
#endif

            GRID_BAR(); }
for (int rep_ = 0; rep_ < REP_WO; ++rep_) {
#ifndef SKIP_WO
            { pg8::Gemm g{(const bf16_t*)(p.ws + WS_MG), lwp(p, l, OFF_WO), SEQ, DM, DM}; pg8::StaticOrder S; S.init(SEQ, DM, Gq_, bq_);
              EpiResid E{1.0f / REP_WO, 3 * l + 2, 0};
              pg8::gemm_phase<EpiResid, pg8::StaticOrder, true, true>(lds, g, S, E, wave);
#pragma unroll 1
          for (int tile = bid; tile < (MS / 64) * (DM / 64); tile += G) { LANE_TID(); sgemm_tile(g.A, g.Bt, DM, SEQ + 64 * (tile % (MS / 64)), 64 * (tile / (MS / 64)), lds, tid, E); } }
#endif

            GRID_BAR(); }
        }
    }
}

#ifndef EMU
extern "C" void kernel_launch(void* const* d_in, const int* in_sizes, int n_in, void* d_out, int out_size, void* d_ws, size_t ws_size, hipStream_t stream) {
    static int grid = 0;
    if (grid == 0) {
        if (n_in != 33 || (size_t)out_size != O_END || ws_size < WS_END) { fprintf(stderr, "kernel_launch: unexpected shapes (n_in %d, out %d, ws %zu, need %zu)\n", n_in, out_size, ws_size, (size_t)WS_END); grid = -1; return; }
        int dev = 0, cus = 0, per_cu = 0;
        if (hipGetDevice(&dev) != hipSuccess || hipDeviceGetAttribute(&cus, hipDeviceAttributeMultiprocessorCount, dev) != hipSuccess) { grid = -1; return; }
        if (hipFuncSetAttribute((const void*)fwd, hipFuncAttributeMaxDynamicSharedMemorySize, LDS_BYTES) != hipSuccess) { fprintf(stderr, "kernel_launch: hipFuncSetAttribute failed\n"); grid = -1; return; }
        if (hipOccupancyMaxActiveBlocksPerMultiprocessor(&per_cu, (const void*)fwd, NTHR, LDS_BYTES) != hipSuccess || per_cu < 1) fprintf(stderr, "kernel_launch: occupancy query reports %d\n", per_cu);
        (void)hipGetLastError();
        grid = cus;
    }
    if (grid < 0) return;
    if (hipMemsetAsync((char*)d_ws + WS_CTL, 0, CTL_BYTES, stream) != hipSuccess) return;
    Params p{};
    for (int i = 0; i < 33; ++i) p.in[i] = (const float*)d_in[i];
    p.out = (float*)d_out; p.ws = (unsigned char*)d_ws;
    hipLaunchKernelGGL(fwd, dim3(grid), dim3(NTHR), LDS_BYTES, stream, p);
}
#endif
```
